# Optimizing an MI355X kernel written in HIP

```python
import math
import jax, jax.numpy as jnp
from jax import lax
import numpy as np

D_MODEL = 2048
BATCH = 2
SEQ = 8192
DEPTH = 4
DEC_BATCH = 16
DEC_SEQ = 2048
PAST_LEN = 128

HEAD_DIM = 128
D_FF = 5632
EPS = 1e-6
A_HEADS = 8
A_KV_HEADS = 2
WINDOW = 128
WIN_BLOCK = 128
T5_BUCKETS = 32
T5_MAX_DIST = 128
B_HEADS = 4
GRID_W = 64
NA_ROWS = 8
NA_COLS = 16
C_HEADS = 4
C_KEY_DIM = 128
C_VAL_DIM = 128
C_CHUNK = 64
A_Q = A_HEADS * HEAD_DIM
A_KV = A_KV_HEADS * HEAD_DIM
B_W = B_HEADS * HEAD_DIM
C_K = C_HEADS * C_KEY_DIM
C_V = C_HEADS * C_VAL_DIM
SPLIT_SIZES = (A_Q, A_KV, A_KV, B_W, B_W, B_W, C_K, C_K, C_V, C_K, C_V, D_MODEL, D_MODEL, D_MODEL)
PROJ_WIDTH = sum(SPLIT_SIZES)

kernel_name = "hybrid_bidir_gated_encoder"


def rmsnorm(x, gain):
    xf = x.astype(jnp.float32)
    y = xf * lax.rsqrt(jnp.mean(xf * xf, axis=-1, keepdims=True) + EPS)
    return (y * gain.astype(jnp.float32)).astype(x.dtype)


def swiglu(x, w_gate, w_up, w_down):
    return (jax.nn.silu(x @ w_gate) * (x @ w_up)) @ w_down


def t5_bucket(rel):
    nb = T5_BUCKETS // 2
    max_exact = nb // 2
    base = jnp.where(rel > 0, nb, 0)
    n = jnp.abs(rel)
    large = max_exact + (jnp.log(jnp.maximum(n, 1).astype(jnp.float32) / max_exact)
                         / math.log(T5_MAX_DIST / max_exact) * (nb - max_exact)).astype(jnp.int32)
    large = jnp.minimum(large, nb - 1)
    return base + jnp.where(n < max_exact, n, large)


def window_attention(q, k, v, sink, t5_bias):
    B, T = q.shape[0], q.shape[1]
    nb = T // WIN_BLOCK
    G = A_HEADS // A_KV_HEADS
    pad = ((0, 0), (WIN_BLOCK, WIN_BLOCK), (0, 0), (0, 0))

    def band(a):
        ap = jnp.pad(a, pad).reshape(B, nb + 2, WIN_BLOCK, A_KV_HEADS, HEAD_DIM)
        return jnp.concatenate([ap[:, :-2], ap[:, 1:-1], ap[:, 2:]], axis=2)

    kb, vb = band(k), band(v)
    qb = q.reshape(B, nb, WIN_BLOCK, A_KV_HEADS, G, HEAD_DIM)
    s = jnp.einsum('bnqkgd,bnskd->bnkgqs', qb, kb).astype(jnp.float32) * (HEAD_DIM ** -0.5)
    qi = jnp.arange(WIN_BLOCK)[:, None]
    si = jnp.arange(3 * WIN_BLOCK)[None, :]
    rel = si - WIN_BLOCK - qi
    bias = t5_bias.astype(jnp.float32)[t5_bucket(rel)]
    bias = bias.transpose(2, 0, 1).reshape(A_KV_HEADS, G, WIN_BLOCK, 3 * WIN_BLOCK)
    key_pos = jnp.arange(nb)[:, None] * WIN_BLOCK + si - WIN_BLOCK
    valid = (jnp.abs(rel) <= WINDOW)[None] & ((key_pos >= 0) & (key_pos < T))[:, None, :]
    s = jnp.where(valid[None, :, None, None], s + bias, -jnp.inf)
    sink_b = sink.astype(jnp.float32).reshape(A_KV_HEADS, G)[None, None, :, :, None, None]
    m = jnp.maximum(jnp.max(s, axis=-1, keepdims=True), sink_b)
    e = jnp.exp(s - m)
    p = e / (jnp.sum(e, axis=-1, keepdims=True) + jnp.exp(sink_b - m))
    o = jnp.einsum('bnkgqs,bnskd->bnqkgd', p.astype(v.dtype), vb)
    return o.reshape(B, T, A_Q)


def neighbourhood_attention(q, k, v, rel_table):
    B, T = q.shape[0], q.shape[1]
    rows = T // GRID_W
    kr = min(NA_ROWS, rows)
    r = jnp.arange(rows)
    row_start = jnp.clip(r - kr // 2, 0, rows - kr)
    row_idx = row_start[:, None] + jnp.arange(kr)[None, :]
    c = jnp.arange(GRID_W)
    col_start = jnp.clip(c - NA_COLS // 2, 0, GRID_W - NA_COLS)
    col_ok = (c[None, :] >= col_start[:, None]) & (c[None, :] < col_start[:, None] + NA_COLS)
    qg = q.reshape(B, rows, GRID_W, B_HEADS, HEAD_DIM)
    kg = k.reshape(B, rows, GRID_W, B_HEADS, HEAD_DIM)[:, row_idx].reshape(B, rows, kr * GRID_W, B_HEADS, HEAD_DIM)
    vg = v.reshape(B, rows, GRID_W, B_HEADS, HEAD_DIM)[:, row_idx].reshape(B, rows, kr * GRID_W, B_HEADS, HEAD_DIM)
    s = jnp.einsum('brqhd,brkhd->bhrqk', qg, kg).astype(jnp.float32) * (HEAD_DIM ** -0.5)
    dr = row_idx - r[:, None] + NA_ROWS - 1
    dc = jnp.clip(c[None, :] - c[:, None], -(NA_COLS - 1), NA_COLS - 1) + NA_COLS - 1
    bias = rel_table.astype(jnp.float32)[:, dr[:, None, :, None], dc[None, :, None, :]]
    bias = bias.reshape(B_HEADS, rows, GRID_W, kr * GRID_W)
    mask = jnp.broadcast_to(col_ok[:, None, :], (GRID_W, kr, GRID_W)).reshape(GRID_W, kr * GRID_W)
    s = jnp.where(mask, s + bias, -jnp.inf)
    p = jax.nn.softmax(s, axis=-1)
    o = jnp.einsum('bhrqk,brkhd->brqhd', p.astype(v.dtype), vg)
    return o.reshape(B, T, B_W)


def chunk_gated_recurrence(q, k, v, log_f):
    B, T, H, DK = q.shape
    DV = v.shape[-1]
    n = T // C_CHUNK

    def to_chunks(a):
        return a.reshape(B, n, C_CHUNK, H, a.shape[-1]).transpose(1, 0, 3, 2, 4)

    lower = jnp.tril(jnp.ones((C_CHUNK, C_CHUNK), dtype=bool))

    def step(S, inp):
        qc, kc, vc, gc = inp
        b = jnp.cumsum(gc, axis=2)
        diff = b[:, :, :, None, :] - b[:, :, None, :, :]
        decay = jnp.exp(jnp.where(lower[:, :, None], diff, -jnp.inf))
        A = jnp.einsum('bhtd,bhsd,bhtsd->bhts', qc, kc, decay)
        o = jnp.einsum('bhts,bhse->bhte', A, vc) + jnp.einsum('bhtd,bhde->bhte', qc * jnp.exp(b), S)
        b_last = b[:, :, -1:, :]
        S = jnp.exp(b_last[:, :, 0, :])[..., None] * S + jnp.einsum('bhsd,bhse->bhde', kc * jnp.exp(b_last - b), vc)
        return S, o

    S0 = jnp.zeros((B, H, DK, DV), jnp.float32)
    _, o = lax.scan(step, S0, (to_chunks(q), to_chunks(k), to_chunks(v), to_chunks(log_f)))
    return o.transpose(1, 0, 3, 2, 4).reshape(B, T, H, DV)


def hgrn2_bidirectional(f_fwd, f_bwd, i, q, g, lb_fwd, lb_bwd, norm_gain):
    B, T = q.shape[0], q.shape[1]

    def heads(a):
        return a.reshape(B, T, C_HEADS, -1).astype(jnp.float32)

    def forget(z, lb):
        lb = lb.reshape(C_HEADS, C_KEY_DIM)
        f = lb + (1.0 - lb) * jax.nn.sigmoid(heads(z))
        return jnp.log(f), 1.0 - f

    qh = heads(q) * (C_KEY_DIM ** -0.5)
    vh = heads(i)
    lf_f, k_f = forget(f_fwd, lb_fwd)
    lf_b, k_b = forget(f_bwd, lb_bwd)
    o_f = chunk_gated_recurrence(qh, k_f, vh, lf_f)
    flip = lambda a: jnp.flip(a, axis=1)
    o_b = flip(chunk_gated_recurrence(flip(qh), flip(k_b), flip(vh), flip(lf_b)))
    o = rmsnorm(o_f + o_b, norm_gain.reshape(C_HEADS, C_VAL_DIM)) * jax.nn.silu(heads(g))
    return o.reshape(B, T, C_V).astype(q.dtype)


def trunk(x, ffn1_norm, ffn1_w_gate, ffn1_w_up, ffn1_w_down, mix_norm, w_in, attn_sink, t5_bias,
          na_bias, hgrn_lb_logits, hgrn_norm, w_branch_a, w_branch_b, w_branch_c, w_out,
          ffn2_norm, ffn2_w_gate, ffn2_w_up, ffn2_w_down, final_norm):
    B, T = x.shape[0], x.shape[1]
    lb_p = jax.nn.softmax(hgrn_lb_logits.astype(jnp.float32), axis=1)
    lower_bounds = jnp.cumsum(lb_p, axis=1) - lb_p[:, :1]
    offsets = [int(o) for o in np.cumsum(SPLIT_SIZES)[:-1]]
    for l in range(DEPTH):
        h = x + 0.5 * swiglu(rmsnorm(x, ffn1_norm[l]), ffn1_w_gate[l], ffn1_w_up[l], ffn1_w_down[l])
        u = rmsnorm(h, mix_norm[l])
        (a_q, a_k, a_v, b_q, b_k, b_v, c_ff, c_fb, c_i, c_q, c_g,
         gate_a, gate_b, gate_c) = jnp.split(u @ w_in[l], offsets, axis=-1)
        y_a = window_attention(a_q.reshape(B, T, A_HEADS, HEAD_DIM),
                               a_k.reshape(B, T, A_KV_HEADS, HEAD_DIM),
                               a_v.reshape(B, T, A_KV_HEADS, HEAD_DIM), attn_sink[l], t5_bias)
        y_b = neighbourhood_attention(b_q.reshape(B, T, B_HEADS, HEAD_DIM),
                                      b_k.reshape(B, T, B_HEADS, HEAD_DIM),
                                      b_v.reshape(B, T, B_HEADS, HEAD_DIM), na_bias[l])
        y_c = hgrn2_bidirectional(c_ff, c_fb, c_i, c_q, c_g, lower_bounds[0, l], lower_bounds[1, l], hgrn_norm[l])
        merged = (jax.nn.sigmoid(gate_a) * (y_a @ w_branch_a[l])
                  + jax.nn.sigmoid(gate_b) * (y_b @ w_branch_b[l])
                  + jax.nn.sigmoid(gate_c) * (y_c @ w_branch_c[l]))
        h = h + merged @ w_out[l]
        x = h + 0.5 * swiglu(rmsnorm(h, ffn2_norm[l]), ffn2_w_gate[l], ffn2_w_up[l], ffn2_w_down[l])
    return rmsnorm(x, final_norm)


def setup_inputs(seed: int = 0) -> dict:
    key = jax.random.key(seed)
    ks = jax.random.split(key, 24)
    f32 = jnp.float32
    nrm = lambda k, shape, scale: jax.random.normal(k, shape, f32) * scale
    gain = lambda k, shape: 1.0 + 0.02 * jax.random.normal(k, shape, f32)
    return {
        "x_prompt": jax.random.normal(ks[0], (BATCH, SEQ, D_MODEL), f32),
        "x_sample": jax.random.normal(ks[1], (DEC_BATCH, DEC_SEQ, D_MODEL), f32),
        "ffn1_norm": gain(ks[2], (DEPTH, D_MODEL)),
        "ffn1_w_gate": nrm(ks[3], (DEPTH, D_MODEL, D_FF), D_MODEL ** -0.5),
        "ffn1_w_up": nrm(ks[4], (DEPTH, D_MODEL, D_FF), D_MODEL ** -0.5),
        "ffn1_w_down": nrm(ks[5], (DEPTH, D_FF, D_MODEL), D_FF ** -0.5),
        "mix_norm": gain(ks[6], (DEPTH, D_MODEL)),
        "w_in": nrm(ks[7], (DEPTH, D_MODEL, PROJ_WIDTH), D_MODEL ** -0.5),
        "attn_sink": nrm(ks[8], (DEPTH, A_HEADS), 0.5),
        "t5_bias": nrm(ks[9], (T5_BUCKETS, A_HEADS), 0.1),
        "na_bias": nrm(ks[10], (DEPTH, B_HEADS, 2 * NA_ROWS - 1, 2 * NA_COLS - 1), 0.1),
        "hgrn_lb_logits": nrm(ks[11], (2, DEPTH, C_K), 0.1),
        "hgrn_norm": gain(ks[12], (DEPTH, C_V)),
        "w_branch_a": nrm(ks[13], (DEPTH, A_Q, D_MODEL), A_Q ** -0.5),
        "w_branch_b": nrm(ks[14], (DEPTH, B_W, D_MODEL), B_W ** -0.5),
        "w_branch_c": nrm(ks[15], (DEPTH, C_V, D_MODEL), C_V ** -0.5),
        "w_out": nrm(ks[16], (DEPTH, D_MODEL, D_MODEL), D_MODEL ** -0.5),
        "ffn2_norm": gain(ks[17], (DEPTH, D_MODEL)),
        "ffn2_w_gate": nrm(ks[18], (DEPTH, D_MODEL, D_FF), D_MODEL ** -0.5),
        "ffn2_w_up": nrm(ks[19], (DEPTH, D_MODEL, D_FF), D_MODEL ** -0.5),
        "ffn2_w_down": nrm(ks[20], (DEPTH, D_FF, D_MODEL), D_FF ** -0.5),
        "final_norm": gain(ks[21], (D_MODEL,)),
    }


def reference(x_prompt, x_sample, ffn1_norm, ffn1_w_gate, ffn1_w_up, ffn1_w_down, mix_norm, w_in,
              attn_sink, t5_bias, na_bias, hgrn_lb_logits, hgrn_norm, w_branch_a, w_branch_b,
              w_branch_c, w_out, ffn2_norm, ffn2_w_gate, ffn2_w_up, ffn2_w_down, final_norm):
    y_prompt = trunk(x_prompt, ffn1_norm, ffn1_w_gate, ffn1_w_up, ffn1_w_down, mix_norm, w_in, attn_sink,
                     t5_bias, na_bias, hgrn_lb_logits, hgrn_norm, w_branch_a, w_branch_b, w_branch_c,
                     w_out, ffn2_norm, ffn2_w_gate, ffn2_w_up, ffn2_w_down, final_norm)
    y_sample = trunk(x_sample, ffn1_norm, ffn1_w_gate, ffn1_w_up, ffn1_w_down, mix_norm, w_in, attn_sink,
                     t5_bias, na_bias, hgrn_lb_logits, hgrn_norm, w_branch_a, w_branch_b, w_branch_c,
                     w_out, ffn2_norm, ffn2_w_gate, ffn2_w_up, ffn2_w_down, final_norm)
    return (y_prompt, y_sample)
```

```cpp
#include <hip/hip_runtime.h>
#include <cstdio>
#include <cstdint>

#ifndef MK_ONE_LAUNCH
#define MK_ONE_LAUNCH 1
#endif

#define GAS __attribute__((address_space(1)))
#define LAS __attribute__((address_space(3)))
typedef unsigned short bf16;
typedef unsigned v4u __attribute__((ext_vector_type(4)));
typedef unsigned v2u __attribute__((ext_vector_type(2)));
typedef float f32x4 __attribute__((ext_vector_type(4)));
typedef float f32x2 __attribute__((ext_vector_type(2)));
typedef short bf16x8 __attribute__((ext_vector_type(8)));
typedef GAS unsigned gu32;

constexpr int DM = 2048, DFF = 5632, PW = 11776, NLAYER = 4;
constexpr int MS = 16384, NSLICE = 3, MTOT = 49152;
constexpr float EPS = 1e-6f;
constexpr float LOG2E = 1.4426950408889634f, LN2 = 0.6931471805599453f;
constexpr float QSCALE = 0.08838834764831845f * LOG2E;
constexpr float CQSCALE = 0.08838834764831845f;
constexpr int O_AQ = 0, O_AK = 1024, O_AV = 1280, O_BQ = 1536, O_BK = 2048, O_BV = 2560, O_CFF = 3072, O_CFB = 3584, O_CI = 4096, O_CQ = 4608, O_CG = 5120, O_GA = 5632, O_GB = 7680, O_GC = 9728;

constexpr size_t MiB = 1u << 20;
constexpr size_t WS_CTL = 0, CTL_ZERO_BYTES = 1 * MiB;
constexpr size_t WS_TAB = 1 * MiB;
constexpr size_t WS_W = 2 * MiB;
constexpr size_t E_WGU = (size_t)2 * DFF * DM, E_WD = (size_t)DM * DFF, E_WIN = (size_t)PW * DM, E_WBR = (size_t)DM * DM, E_WOUT = (size_t)DM * DM;
constexpr size_t EO_WGU1 = 0, EO_WD1 = EO_WGU1 + E_WGU, EO_WIN = EO_WD1 + E_WD, EO_WBR = EO_WIN + E_WIN, EO_WOUT = EO_WBR + E_WBR, EO_WGU2 = EO_WOUT + E_WOUT, EO_WD2 = EO_WGU2 + E_WGU, E_LAYER = EO_WD2 + E_WD;
static_assert(E_LAYER * 2 == 194 * MiB, "weights per layer");
constexpr size_t WS_XN = WS_W + 4 * 194 * MiB;
constexpr size_t WS_PROJ = WS_XN + 64 * MiB;
constexpr size_t WS_Y = WS_PROJ + 368 * MiB;
constexpr size_t WS_OC = WS_Y + 64 * MiB;
constexpr size_t WS_MG = WS_OC + 128 * MiB;
constexpr size_t WS_SSQ = WS_MG + 64 * MiB;
constexpr size_t WS_WQ = WS_SSQ + 2 * MiB;
constexpr size_t WQ_LAYER = 13 * MiB, WQ_SCALE = 12 * MiB;
constexpr size_t WS_END = WS_WQ + 4 * WQ_LAYER;
constexpr size_t XQ_SCALE = 32 * MiB;
constexpr size_t WGUQ_SCALE = 22 * MiB;
static_assert(8 * E_WGU * 2 <= 368 * MiB && (size_t)2 * DFF * DM <= WGUQ_SCALE, "gate|up temporaries / int8 slot");
constexpr int CW_RMAX = 65536;
constexpr int CW_PCNT = 2048;
constexpr int CW_QCNT = 1024;
constexpr int TAB_T5 = 0, TAB_LB = 8 * 260;
constexpr int CW_TMO = 0, CW_CODE = 1, CW_BAR = 4096;

constexpr int RING_OFF = 0, RING_BYTES = 131072;
constexpr int LDSCTL_OFF = RING_BYTES, MISC_OFF = LDSCTL_OFF + 320;
constexpr int LDS_BYTES = 147456;

#define LDS_WAIT() asm volatile("s_waitcnt lgkmcnt(0)" ::: "memory")
#define VM_WAIT() asm volatile("s_waitcnt vmcnt(0)" ::: "memory")
__device__ __forceinline__ unsigned f2bf(float f) { unsigned u = __builtin_bit_cast(unsigned, f); return (u + 0x7fffu + ((u >> 16) & 1u)) >> 16; }
__device__ __forceinline__ unsigned pk2(float lo, float hi) { return f2bf(lo) | (f2bf(hi) << 16); }
__device__ __forceinline__ float bflo(unsigned w) { return __builtin_bit_cast(float, w << 16); }
__device__ __forceinline__ float bfhi(unsigned w) { return __builtin_bit_cast(float, w & 0xffff0000u); }
__device__ __forceinline__ float bf2f(bf16 b) { return __builtin_bit_cast(float, ((unsigned)b) << 16); }
__device__ __forceinline__ void v8(const v4u w, float (&o)[8]) { o[0] = bflo(w.x); o[1] = bfhi(w.x); o[2] = bflo(w.y); o[3] = bfhi(w.y); o[4] = bflo(w.z); o[5] = bfhi(w.z); o[6] = bflo(w.w); o[7] = bfhi(w.w); }
__device__ __forceinline__ float fexp2(float x) { return __builtin_amdgcn_exp2f(x); }
__device__ __forceinline__ float frcp(float x) { return __builtin_amdgcn_rcpf(x); }
__device__ __forceinline__ float sigmoidf_(float x) { return frcp(1.0f + fexp2(-x * LOG2E)); }
__device__ __forceinline__ float wave_sum(float v) {
#pragma unroll
    for (int o = 1; o < 64; o <<= 1) v += __shfl_xor(v, o);
    return v;
}
__device__ __forceinline__ float wave_max(float v) {
#pragma unroll
    for (int o = 1; o < 64; o <<= 1) v = fmaxf(v, __shfl_xor(v, o));
    return v;
}

__device__ __forceinline__ int opq_v(int x) { asm volatile("" : "+v"(x)); return x; }
__device__ __forceinline__ int opq_s(int x) { asm volatile("" : "+s"(x)); return x; }
__device__ __forceinline__ int lane_id() { const unsigned m = (unsigned)opq_s(-1); return (int)__builtin_amdgcn_mbcnt_hi(m, __builtin_amdgcn_mbcnt_lo(m, 0u)); }

namespace pg8 {
#define PG8_LAS __attribute__((address_space(3)))
typedef unsigned short bf16_t;
typedef unsigned u32x4 __attribute__((ext_vector_type(4)));
typedef unsigned u32x2 __attribute__((ext_vector_type(2)));
typedef int i32x4 __attribute__((ext_vector_type(4)));
typedef unsigned short u16x2 __attribute__((ext_vector_type(2)));
constexpr int BM = 256, BK = 64, HALF = 128, HTB = HALF * BK * 2, STAGE_BYTES = 8 * HTB, NXCD = 8, WGM = 4;
__host__ __device__ __forceinline__ int lds_byte(int r, int c) { const int st = (r >> 4) * 2 + (c >> 5), rr = r & 15, cc = c & 31, ob = rr * 64 + cc * 2; return st * 1024 + (ob ^ (((ob >> 9) & 1) << 5)); }
__host__ __device__ __forceinline__ void stage_rc(int b, int& R, int& C) { const int st = b / 1024, sb = b % 1024, swz = sb ^ (((sb >> 9) & 1) << 5); R = (st >> 1) * 16 + swz / 64; C = (st & 1) * 32 + (swz % 64) / 2; }
__host__ __device__ __forceinline__ int perm32(int rho) { const int n = rho >> 4, i = rho & 15; return 8 * (i >> 2) + 4 * n + (i & 3); }
struct Unit { int pm, pn, sub; };
struct Gemm { const bf16_t* A; const bf16_t* Bt; int M, N, K, lda, ldb; };
struct StaticOrder {
    int nM, nN, nwg, G, c;
    __host__ __device__ void init(int M, int N, int G_, int c_) { nM = M / BM; nN = N / BM; nwg = nM * nN; G = G_; c = c_; }
    __host__ __device__ bool next(int i, Unit& u) const { const long L = (long)i * G + c; if (L >= nwg) return false; at(L, u); return true; }
    __host__ __device__ void at(long L, Unit& u) const {
        int wgid = (int)L; { const int q = nwg / NXCD, r = nwg % NXCD, xcd = wgid % NXCD, off = wgid / NXCD; wgid = (xcd < r ? xcd * (q + 1) : r * (q + 1) + (xcd - r) * q) + off; }
        const int nig = WGM * nN, gid = wgid / nig, fm = gid * WGM, gsz = (nM - fm) < WGM ? (nM - fm) : WGM;
        u.pm = fm + ((wgid % nig) % gsz); u.pn = (wgid % nig) / gsz; u.sub = 0;
    }
    __device__ __forceinline__ void a_ready(const Unit&) const {}
    __device__ __forceinline__ void done(const Unit&) const {}
};
struct GateOrder : StaticOrder {
    __host__ __device__ bool next(int i, Unit& u) const {
        if (G != 256 || nwg != 1536) return StaticOrder::next(i, u);
        if (i < 5) { at((long)i * 256 + c, u); return true; }
        if (c < 128 || i > 6) return false;
        at((long)(1280 + 2 * (c - 128) + (i - 5)), u); return true;
    }
};
struct SubOrder : StaticOrder {
    __device__ __forceinline__ bool next(int i, Unit& u) const { const int t3 = i / 3; if (!StaticOrder::next(t3, u)) return false; u.sub = i - 3 * t3; return true; }
};
typedef __bf16 bf16x2_t __attribute__((ext_vector_type(2)));
__device__ __forceinline__ unsigned cvt_pk_bf16(float lo, float hi) { const f32x2 v = {lo, hi}; const bf16x2_t b = __builtin_convertvector(v, bf16x2_t); return __builtin_bit_cast(unsigned, b); }
typedef f32x4 Acc[2][2][4][2];

__device__ __forceinline__ float silu_(float x) { return x * frcp(1.0f + fexp2(-x * LOG2E)); }

__device__ __forceinline__ void row_rstd(const PG8_LAS float* rsl, int ui, int wr, int fr, float (&rs)[2][4]) {
#pragma unroll
    for (int ai = 0; ai < 2; ++ai)
#pragma unroll
        for (int m = 0; m < 4; ++m) rs[ai][m] = rsl[ui * 256 + ai * HALF + wr * 64 + m * 16 + fr];
}
struct EpiSwiGLU {
    static constexpr bool PERM = true, AFTER_DRAIN = false;
    bf16_t* O; int ldc; const PG8_LAS float* rsl;
    __device__ __forceinline__ void operator()(const Acc& acc, const Unit& u, int ui, int wr, int wc, int fr, int fq) const {
        const int row0 = u.pm * BM + wr * 64 + fr, col0 = u.pn * HALF + wc * 32 + 8 * fq;
        float rs[2][4]; row_rstd(rsl, ui, wr, fr, rs);
#pragma unroll
        for (int ai = 0; ai < 2; ++ai)
#pragma unroll
            for (int m = 0; m < 4; ++m) {
                bf16_t* rowp = O + (size_t)(row0 + ai * HALF + m * 16) * ldc + col0; const float r = rs[ai][m];
                const f32x4 g0 = acc[ai][0][m][0] * r, g1 = acc[ai][0][m][1] * r, u0 = acc[ai][1][m][0] * r, u1 = acc[ai][1][m][1] * r;
                u32x4 w;
                w.x = cvt_pk_bf16(silu_(g0[0]) * u0[0], silu_(g0[1]) * u0[1]); w.y = cvt_pk_bf16(silu_(g0[2]) * u0[2], silu_(g0[3]) * u0[3]);
                w.z = cvt_pk_bf16(silu_(g1[0]) * u1[0], silu_(g1[1]) * u1[1]); w.w = cvt_pk_bf16(silu_(g1[2]) * u1[2], silu_(g1[3]) * u1[3]);
                *(GAS u32x4*)rowp = w;
            }
    }
};
struct EpiSwiGLUQ {
    static constexpr bool PERM = true, AFTER_DRAIN = false;
    bf16_t* O; int ldc; const float* wsc; const PG8_LAS float* rsl;
    __device__ __forceinline__ void operator()(const Acc& acc, const Unit& u, int ui, int wr, int wc, int fr, int fq) const {
        const int row0 = u.pm * BM + wr * 64 + fr, col0 = u.pn * HALF + wc * 32 + 8 * fq;
        float rs[2][4]; row_rstd(rsl, ui, wr, fr, rs);
        const float* sp = wsc + u.pn * BM + wc * 32 + 8 * fq;
        const f32x4 cg0 = *(const GAS f32x4*)sp * -LOG2E, cg1 = *(const GAS f32x4*)(sp + 4) * -LOG2E, cu0 = *(const GAS f32x4*)(sp + HALF) * -LN2, cu1 = *(const GAS f32x4*)(sp + HALF + 4) * -LN2;
#pragma unroll
        for (int ai = 0; ai < 2; ++ai)
#pragma unroll
            for (int m = 0; m < 4; ++m) {
                bf16_t* rowp = O + (size_t)(row0 + ai * HALF + m * 16) * ldc + col0; const float r = rs[ai][m];
                const f32x4 g0 = __builtin_convertvector(__builtin_bit_cast(i32x4, acc[ai][0][m][0]), f32x4) * cg0 * r, g1 = __builtin_convertvector(__builtin_bit_cast(i32x4, acc[ai][0][m][1]), f32x4) * cg1 * r;
                const f32x4 u0 = __builtin_convertvector(__builtin_bit_cast(i32x4, acc[ai][1][m][0]), f32x4) * cu0 * r, u1 = __builtin_convertvector(__builtin_bit_cast(i32x4, acc[ai][1][m][1]), f32x4) * cu1 * r;
                float y0[4], y1[4];
#pragma unroll
                for (int i = 0; i < 4; ++i) { y0[i] = g0[i] * frcp(1.0f + fexp2(g0[i])) * u0[i]; y1[i] = g1[i] * frcp(1.0f + fexp2(g1[i])) * u1[i]; }
                u32x4 w;
                w.x = cvt_pk_bf16(y0[0], y0[1]); w.y = cvt_pk_bf16(y0[2], y0[3]); w.z = cvt_pk_bf16(y1[0], y1[1]); w.w = cvt_pk_bf16(y1[2], y1[3]);
                *(GAS u32x4*)rowp = w;
            }
    }
};
struct EpiResid {
    static constexpr bool PERM = true, AFTER_DRAIN = false;
    bf16_t* x; int ldc; float scale; float* ssq;
    unsigned* ctl; unsigned target; unsigned char* xq; float* xsc; PG8_LAS unsigned* scr;
    __device__ __forceinline__ void operator()(const Acc& acc, const Unit& u, int ui, int wr, int wc, int fr, int fq) const {
        const int row0 = u.pm * BM + wr * 64 + fr, col0 = u.pn * BM + wc * 32 + 8 * fq;
        bf16_t* const x = this->x; float* const ssq = this->ssq; const float scale = this->scale; const int ldc = this->ldc;
        u32x4 wk[2][4][2];
        unsigned mxr[2][4];
#pragma unroll
        for (int ai = 0; ai < 2; ++ai) {
            u32x4 xv[4][2];
#pragma unroll
            for (int m = 0; m < 4; ++m)
#pragma unroll
                for (int bj = 0; bj < 2; ++bj) xv[m][bj] = *(const GAS u32x4*)(x + (size_t)(row0 + ai * HALF + m * 16) * ldc + col0 + bj * HALF);
            asm volatile("" ::: "memory");
#pragma unroll
            for (int m = 0; m < 4; ++m) {
                const size_t off = (size_t)(row0 + ai * HALF + m * 16) * ldc + col0; float s = 0.f; u16x2 mx2 = {0, 0};
#pragma unroll
                for (int bj = 0; bj < 2; ++bj) {
                    const u32x4 w0 = xv[m][bj]; const f32x4 a0 = acc[ai][bj][m][0] * scale, a1 = acc[ai][bj][m][1] * scale;
                    const float v0 = bflo(w0.x) + a0[0], v1 = bfhi(w0.x) + a0[1], v2 = bflo(w0.y) + a0[2], v3 = bfhi(w0.y) + a0[3];
                    const float v4 = bflo(w0.z) + a1[0], v5 = bfhi(w0.z) + a1[1], v6 = bflo(w0.w) + a1[2], v7 = bfhi(w0.w) + a1[3];
                    u32x4 w; w.x = cvt_pk_bf16(v0, v1); w.y = cvt_pk_bf16(v2, v3); w.z = cvt_pk_bf16(v4, v5); w.w = cvt_pk_bf16(v6, v7);
                    *(GAS u32x4*)(x + off + bj * HALF) = w; wk[ai][m][bj] = w;
#pragma unroll
                    for (int e2 = 0; e2 < 4; ++e2) mx2 = __builtin_elementwise_max(mx2, __builtin_bit_cast(u16x2, w[e2] & 0x7fff7fffu));
                    s += ((v0 * v0 + v1 * v1) + (v2 * v2 + v3 * v3)) + ((v4 * v4 + v5 * v5) + (v6 * v6 + v7 * v7));
                }
                s += __shfl_xor(s, 16); s += __shfl_xor(s, 32);
                if (fq == 0) ssq[(size_t)(row0 + ai * HALF + m * 16) * 32 + u.pn * 4 + wc] = s;
                unsigned mh = mx2.x > mx2.y ? (unsigned)mx2.x : (unsigned)mx2.y;
                { const unsigned o = (unsigned)__shfl_xor((int)mh, 16); mh = o > mh ? o : mh; } { const unsigned o = (unsigned)__shfl_xor((int)mh, 32); mh = o > mh ? o : mh; }
                mxr[ai][m] = mh;
            }
            asm volatile("" ::: "memory");
        }
        {
            const int wave = wr * 4 + wc, lane = fq * 16 + fr, tid = wave * 64 + lane;
            PG8_LAS unsigned* const PM = this->scr; PG8_LAS float* const SC = (PG8_LAS float*)(this->scr + 1024);
            const unsigned tg = this->target; unsigned* const cur = this->ctl + CW_RMAX + ((tg >> 3) & 1u) * 16384 + u.pm * BM; unsigned* const nxt = this->ctl + CW_RMAX + (((tg >> 3) & 1u) ^ 1u) * 16384 + u.pm * BM;
            if (fq == 0) {
#pragma unroll
                for (int ai = 0; ai < 2; ++ai)
#pragma unroll
                    for (int m = 0; m < 4; ++m) PM[wc * 256 + ai * HALF + wr * 64 + m * 16 + fr] = mxr[ai][m];
            }
            __syncthreads();
            if (tid < 256) { const unsigned a = PM[tid], b = PM[256 + tid], c = PM[512 + tid], d = PM[768 + tid]; const unsigned ab = a > b ? a : b, cd = c > d ? c : d;
                (void)__hip_atomic_fetch_max(cur + tid, (ab > cd ? ab : cd) << 16, __ATOMIC_RELAXED, __HIP_MEMORY_SCOPE_AGENT); }
            asm volatile("s_waitcnt vmcnt(0)" ::: "memory"); __builtin_amdgcn_s_barrier();
            if (tid == 0) { unsigned* const pc = this->ctl + CW_PCNT + u.pm;
                (void)__hip_atomic_fetch_add(pc, 1u, __ATOMIC_RELAXED, __HIP_MEMORY_SCOPE_AGENT);
                unsigned sp = 0u; while (__hip_atomic_load(pc, __ATOMIC_RELAXED, __HIP_MEMORY_SCOPE_AGENT) < tg && ++sp < (1u << 22)) __builtin_amdgcn_s_sleep(1); }
            __builtin_amdgcn_s_barrier();
            if (tid < 256) { const unsigned mb = __hip_atomic_load(cur + tid, __ATOMIC_RELAXED, __HIP_MEMORY_SCOPE_AGENT);
                const float sc = mb ? __builtin_bit_cast(float, mb) * (1.0f / 127.0f) : 1.0f; SC[tid] = sc;
                if (u.pn == 0) this->xsc[u.pm * BM + tid] = sc;
                __hip_atomic_store(nxt + tid, 0u, __ATOMIC_RELAXED, __HIP_MEMORY_SCOPE_AGENT); }
            __syncthreads();
            unsigned char* const xq = this->xq;
#pragma unroll
            for (int ai = 0; ai < 2; ++ai)
#pragma unroll
                for (int m = 0; m < 4; ++m) {
                    const int rl = ai * HALF + wr * 64 + m * 16 + fr; const float inv = 1.0f / SC[rl];
                    unsigned char* const rp = xq + (size_t)(u.pm * BM + rl) * 2048 + col0;
#pragma unroll
                    for (int bj = 0; bj < 2; ++bj) {
                        const u32x4 w = wk[ai][m][bj]; u32x2 q;
#pragma unroll
                        for (int h = 0; h < 2; ++h) {
                            const unsigned a = w[2 * h], b = w[2 * h + 1];
                            const unsigned t0 = __builtin_bit_cast(unsigned, __builtin_fmaf(bflo(a), inv, 12582912.0f)), t1 = __builtin_bit_cast(unsigned, __builtin_fmaf(bfhi(a), inv, 12582912.0f));
                            const unsigned t2 = __builtin_bit_cast(unsigned, __builtin_fmaf(bflo(b), inv, 12582912.0f)), t3 = __builtin_bit_cast(unsigned, __builtin_fmaf(bfhi(b), inv, 12582912.0f));
                            q[h] = __builtin_amdgcn_perm(__builtin_amdgcn_perm(t3, t2, 0x0c0c0400u), __builtin_amdgcn_perm(t1, t0, 0x0c0c0400u), 0x05040100u);
                        }
                        *(GAS u32x2*)(rp + bj * HALF) = q;
                    }
                }
        }
    }
};
struct EpiProj {
    static constexpr bool PERM = true, AFTER_DRAIN = false;
    bf16_t* O; int ldc; const float* lb0; const float* lb1; const PG8_LAS float* rsl;
    template <int MODE> __device__ __forceinline__ void tile(const Acc& acc, const Unit& u, int ui, int wr, int wc, int fr, int fq, float scale, const float* lb) const {
        const int row0 = u.pm * BM + wr * 64 + fr, col0 = u.pn * BM + wc * 32 + 8 * fq;
        float rs[2][4]; row_rstd(rsl, ui, wr, fr, rs);
        f32x4 l[2][2];
        if (MODE == 1) {
#pragma unroll
            for (int bj = 0; bj < 2; ++bj)
#pragma unroll
                for (int n = 0; n < 2; ++n) l[bj][n] = *(const GAS f32x4*)(lb + bj * HALF + wc * 32 + 8 * fq + 4 * n);
        }
#pragma unroll
        for (int ai = 0; ai < 2; ++ai)
#pragma unroll
            for (int m = 0; m < 4; ++m) {
                bf16_t* rowp = O + (size_t)(row0 + ai * HALF + m * 16) * ldc + col0;
#pragma unroll
                for (int bj = 0; bj < 2; ++bj) {
                    f32x4 v[2] = {acc[ai][bj][m][0] * rs[ai][m], acc[ai][bj][m][1] * rs[ai][m]};
#pragma unroll
                    for (int n = 0; n < 2; ++n)
#pragma unroll
                        for (int i = 0; i < 4; ++i) {
                            float x = v[n][i];
                            if (MODE == 0) x *= scale;
                            if (MODE == 1) { const float lbv = l[bj][n][i]; x = __builtin_amdgcn_logf(lbv + (1.0f - lbv) * sigmoidf_(x)); }
                            if (MODE == 2) x = silu_(x);
                            if (MODE == 3) x = sigmoidf_(x);
                            v[n][i] = x;
                        }
                    if (MODE == 3) {
                        unsigned q[2][4];
#pragma unroll
                        for (int n = 0; n < 2; ++n)
#pragma unroll
                            for (int i = 0; i < 4; ++i) { const unsigned t = (unsigned)(v[n][i] * 256.0f); q[n][i] = t < 255u ? t : 255u; }
                        u32x2 w; w.x = q[0][0] | (q[0][1] << 8) | (q[0][2] << 16) | (q[0][3] << 24); w.y = q[1][0] | (q[1][1] << 8) | (q[1][2] << 16) | (q[1][3] << 24);
                        *(GAS u32x2*)((unsigned char*)(rowp - col0 + O_GA) + (col0 - O_GA) + bj * HALF) = w;
                    } else {
                        u32x4 w; w.x = cvt_pk_bf16(v[0][0], v[0][1]); w.y = cvt_pk_bf16(v[0][2], v[0][3]); w.z = cvt_pk_bf16(v[1][0], v[1][1]); w.w = cvt_pk_bf16(v[1][2], v[1][3]);
                        *(GAS u32x4*)(rowp + bj * HALF) = w;
                    }
                }
            }
    }
    __device__ __forceinline__ void operator()(const Acc& acc, const Unit& u, int ui, int wr, int wc, int fr, int fq) const {
        const int pn = u.pn;
        if (pn >= 22) tile<3>(acc, u, ui, wr, wc, fr, fq, 1.f, nullptr);
        else if (pn >= 20) tile<2>(acc, u, ui, wr, wc, fr, fq, 1.f, nullptr);
        else if (pn >= 12 && pn < 16) tile<1>(acc, u, ui, wr, wc, fr, fq, 1.f, (pn < 14 ? lb0 : lb1) + (pn & 1) * BM);
        else { const float s = (pn < 4 || pn == 6 || pn == 7) ? QSCALE : ((pn == 18 || pn == 19) ? CQSCALE : 1.0f); tile<0>(acc, u, ui, wr, wc, fr, fq, s, nullptr); }
    }
};
struct EpiGateQ {
    static constexpr bool PERM = true, AFTER_DRAIN = false;
    unsigned char* G8; int ldg; const float* wsc; const PG8_LAS float* rsl;
    __device__ __forceinline__ void operator()(const Acc& acc, const Unit& u, int ui, int wr, int wc, int fr, int fq) const {
        const int row0 = u.pm * BM + wr * 64 + fr, col0 = u.pn * BM + wc * 32 + 8 * fq;
        float rs[2][4]; row_rstd(rsl, ui, wr, fr, rs);
        f32x4 cs[2][2];
#pragma unroll
        for (int bj = 0; bj < 2; ++bj)
#pragma unroll
            for (int n = 0; n < 2; ++n) cs[bj][n] = *(const GAS f32x4*)(wsc + col0 + bj * HALF + 4 * n) * -LOG2E;
#pragma unroll
        for (int ai = 0; ai < 2; ++ai)
#pragma unroll
            for (int m = 0; m < 4; ++m) {
                unsigned char* rowp = G8 + (size_t)(row0 + ai * HALF + m * 16) * ldg + col0;
#pragma unroll
                for (int bj = 0; bj < 2; ++bj) {
                    unsigned q[2][4];
#pragma unroll
                    for (int n = 0; n < 2; ++n) {
                        const i32x4 iv = __builtin_bit_cast(i32x4, acc[ai][bj][m][n]);
#pragma unroll
                        for (int i = 0; i < 4; ++i) {
                            const float z = (float)iv[i] * rs[ai][m] * cs[bj][n][i];
                            const unsigned t = (unsigned)frcp(__builtin_fmaf(fexp2(z), 1.0f / 256.0f, 1.0f / 256.0f)); q[n][i] = t < 255u ? t : 255u;
                        }
                    }
                    u32x2 w; w.x = q[0][0] | (q[0][1] << 8) | (q[0][2] << 16) | (q[0][3] << 24); w.y = q[1][0] | (q[1][1] << 8) | (q[1][2] << 16) | (q[1][3] << 24);
                    *(GAS u32x2*)(rowp + bj * HALF) = w;
                }
            }
    }
};
template <int MODE> struct EpiGate {
    static constexpr bool PERM = true, AFTER_DRAIN = false;
    const bf16_t* Gt; int ldg; bf16_t* O; int ldc;
    __device__ __forceinline__ void operator()(const Acc& acc, const Unit& u, int ui, int wr, int wc, int fr, int fq) const {
        const int row0 = u.pm * BM + wr * 64 + fr, col0 = u.pn * BM + wc * 32 + 8 * fq;
#pragma unroll
        for (int ai = 0; ai < 2; ++ai)
#pragma unroll
            for (int m = 0; m < 4; ++m) {
                const size_t r = (size_t)(row0 + ai * HALF + m * 16);
#pragma unroll
                for (int bj = 0; bj < 2; ++bj) {
                    const u32x4 c = *(const GAS u32x4*)(Gt + r * ldg + col0 + bj * HALF);
                    f32x4 v0 = acc[ai][bj][m][0], v1 = acc[ai][bj][m][1];
                    v0[0] *= bflo(c.x); v0[1] *= bfhi(c.x); v0[2] *= bflo(c.y); v0[3] *= bfhi(c.y); v1[0] *= bflo(c.z); v1[1] *= bfhi(c.z); v1[2] *= bflo(c.w); v1[3] *= bfhi(c.w);
                    if (MODE) { const u32x4 o = *(const GAS u32x4*)(O + r * ldc + col0 + bj * HALF);
                        v0[0] += bflo(o.x); v0[1] += bfhi(o.x); v0[2] += bflo(o.y); v0[3] += bfhi(o.y); v1[0] += bflo(o.z); v1[1] += bfhi(o.z); v1[2] += bflo(o.w); v1[3] += bfhi(o.w); }
                    u32x4 w; w.x = cvt_pk_bf16(v0[0], v0[1]); w.y = cvt_pk_bf16(v0[2], v0[3]); w.z = cvt_pk_bf16(v1[0], v1[1]); w.w = cvt_pk_bf16(v1[2], v1[3]);
                    *(GAS u32x4*)(O + r * ldc + col0 + bj * HALF) = w;
                }
                if (m & 1) asm volatile("" ::: "memory");
            }
    }
};

struct EpiMerged {
    static constexpr bool PERM = true, AFTER_DRAIN = false;
    const bf16_t* P; int ldp; bf16_t* O; int ldc;
    __device__ __forceinline__ void operator()(Acc& acc, const Unit& u, int ui, int wr, int wc, int fr, int fq) const {
        const int row0 = u.pm * BM + wr * 64 + fr, col0 = u.pn * BM + wc * 32 + 8 * fq;
        const GAS unsigned char* g8 = (const GAS unsigned char*)((const GAS bf16_t*)P + (size_t)row0 * ldp + O_GA) + (col0 - 0);
        const size_t rstep = (size_t)ldp * 2;
        if (u.sub < 2) {
            const GAS unsigned char* rp = g8 + u.sub * 2048;
#pragma unroll
            for (int ai = 0; ai < 2; ++ai) {
                u32x2 ga[4][2], gb[4][2];
#pragma unroll
                for (int m = 0; m < 4; ++m) {
                    const GAS unsigned char* rowp = rp + (size_t)(ai * HALF + m * 16) * rstep;
#pragma unroll
                    for (int bj = 0; bj < 2; ++bj) { ga[m][bj] = *(const GAS u32x2*)(rowp + bj * HALF); gb[m][bj] = *(const GAS u32x2*)(rowp + 2048 + bj * HALF); }
                }
                asm volatile("" ::: "memory");
#pragma unroll
                for (int m = 0; m < 4; ++m)
#pragma unroll
                    for (int bj = 0; bj < 2; ++bj) {
                        const u32x2 a = ga[m][bj], b = gb[m][bj];
                        f32x4 r0, r1;
#pragma unroll
                        for (int i = 0; i < 4; ++i) {
                            r0[i] = ((float)((a.x >> (8 * i)) & 255u) + 0.5f) * frcp((float)((b.x >> (8 * i)) & 255u) + 0.5f);
                            r1[i] = ((float)((a.y >> (8 * i)) & 255u) + 0.5f) * frcp((float)((b.y >> (8 * i)) & 255u) + 0.5f);
                        }
                        acc[ai][bj][m][0] *= r0; acc[ai][bj][m][1] *= r1;
                    }
                asm volatile("" ::: "memory");
            }
        } else {
#pragma unroll
            for (int ai = 0; ai < 2; ++ai)
#pragma unroll
                for (int m = 0; m < 4; ++m) {
                    const size_t r = (size_t)(row0 + ai * HALF + m * 16);
#pragma unroll
                    for (int bj = 0; bj < 2; ++bj) {
                        const u32x2 c = *(const GAS u32x2*)(g8 + (size_t)(ai * HALF + m * 16) * rstep + 4096 + bj * HALF);
                        const f32x4 v0 = acc[ai][bj][m][0], v1 = acc[ai][bj][m][1];
                        float s0[4], s1[4];
#pragma unroll
                        for (int i = 0; i < 4; ++i) { s0[i] = ((float)((c.x >> (8 * i)) & 255u) + 0.5f) * (1.0f / 256.0f); s1[i] = ((float)((c.y >> (8 * i)) & 255u) + 0.5f) * (1.0f / 256.0f); }
                        u32x4 w; w.x = cvt_pk_bf16(v0[0] * s0[0], v0[1] * s0[1]); w.y = cvt_pk_bf16(v0[2] * s0[2], v0[3] * s0[3]);
                        w.z = cvt_pk_bf16(v1[0] * s1[0], v1[1] * s1[1]); w.w = cvt_pk_bf16(v1[2] * s1[2], v1[3] * s1[3]);
                        *(GAS u32x4*)(O + r * ldc + col0 + bj * HALF) = w;
                    }
                    if (m & 1) asm volatile("" ::: "memory");
                }
        }
    }
};

template <class Epi, class Sched, bool ALIGN_EPI = false, bool SP2 = false, bool SUBK = false, bool I8 = false>
__device__ __forceinline__ void gemm_phase(PG8_LAS unsigned char* lds, const Gemm g, const Sched S, const Epi E, int wave) {
    const int wid = wave, lane = lane_id(), tid = wid * 64 + lane, wr = wid >> 2, wc = wid & 3, fr = lane & 15, fq = lane >> 4;
    const int K = g.K, nt = K / BK;
#define PG8_KOFF(u) (SUBK ? ((u).sub == 0 ? 0 : ((u).sub == 1 ? 2048 : 3072)) : 0)
#define PG8_NT(u) (SUBK ? ((u).sub == 0 ? 16 : 8) : nt)
    unsigned voffA[2], voffB[2];
#pragma unroll
    for (int i = 0; i < 2; ++i) { int R, C; stage_rc(tid * 16 + i * 8192, R, C); const int Rb = Epi::PERM ? ((R & ~31) + perm32(R & 31)) : R;
        voffA[i] = (unsigned)(R * g.lda + C) * 2u; voffB[i] = (unsigned)(Rb * g.ldb + C) * 2u; }
    const size_t kstep = (size_t)(BK * 2);
    const size_t hstepA = (size_t)HALF * g.lda * 2, hstepB = (size_t)HALF * g.ldb * 2;
    const size_t tstepA = 2 * hstepA, tstepB = 2 * hstepB;
    const unsigned ldsw = (unsigned)wid * 1024u;
    const int aoff = lds_byte(wr * 64 + fr, fq * 8), boff = lds_byte(wc * 32 + fr, fq * 8);
#define PG8_SA(b, h) (((b) * 2 + (h)) * HTB)
#define PG8_SB(b, h) ((4 + (b) * 2 + (h)) * HTB)
#define PG8_STAGE(bufoff, gbase, voff) do { _Pragma("unroll") for (int _i = 0; _i < 2; ++_i) \
        __builtin_amdgcn_global_load_lds((const unsigned*)((const char*)(gbase) + (voff)[_i]), (PG8_LAS unsigned*)(lds + (bufoff) + ldsw + _i * 8192), 16, 0, 0); } while (0)
#define PG8_LDA(dst, b, h) do { _Pragma("unroll") for (int m = 0; m < 4; ++m) _Pragma("unroll") for (int k = 0; k < 2; ++k) dst[m][k] = *(const PG8_LAS bf16x8*)(lds + PG8_SA(b, h) + aoff + m * 2048 + k * 1024); } while (0)
#define PG8_LDB(dst, b, h) do { _Pragma("unroll") for (int n = 0; n < 2; ++n) _Pragma("unroll") for (int k = 0; k < 2; ++k) dst[n][k] = *(const PG8_LAS bf16x8*)(lds + PG8_SB(b, h) + boff + n * 2048 + k * 1024); } while (0)
#define PG8_MMA(ai, bj, At, Bt) do { __builtin_amdgcn_s_setprio(1); _Pragma("unroll") for (int m = 0; m < 4; ++m) _Pragma("unroll") for (int n = 0; n < 2; ++n) _Pragma("unroll") for (int k = 0; k < 2; ++k) \
        { if constexpr (I8) acc[ai][bj][m][n] = __builtin_bit_cast(f32x4, __builtin_amdgcn_mfma_i32_16x16x64_i8(__builtin_bit_cast(i32x4, Bt[n][k]), __builtin_bit_cast(i32x4, At[m][k]), __builtin_bit_cast(i32x4, acc[ai][bj][m][n]), 0, 0, 0)); \
          else acc[ai][bj][m][n] = __builtin_amdgcn_mfma_f32_16x16x32_bf16(Bt[n][k], At[m][k], acc[ai][bj][m][n], 0, 0, 0); } __builtin_amdgcn_s_setprio(0); } while (0)
#define PG8_WAIT_V(n) asm volatile("s_waitcnt vmcnt(" #n ")" ::: "memory")
#define PG8_WAIT_L(n) asm volatile("s_waitcnt lgkmcnt(" #n ")" ::: "memory")
#define PG8_BAR __builtin_amdgcn_s_barrier()
#define PG8_SCHED __builtin_amdgcn_sched_barrier(0)
    Unit cur, nxt; int ui = 0;
    if (!S.next(0, cur)) return;
    f32x4 acc[2][2][4][2];
#pragma unroll
    for (int a = 0; a < 2; ++a)
#pragma unroll
        for (int b = 0; b < 2; ++b)
#pragma unroll
            for (int m = 0; m < 4; ++m)
#pragma unroll
                for (int n = 0; n < 2; ++n) acc[a][b][m][n] = (f32x4){0.f, 0.f, 0.f, 0.f};
    bf16x8 At[4][2], B0[2][2], B1[2][2];
    const char* cA = (const char*)g.A + (size_t)cur.pm * tstepA + PG8_KOFF(cur); const char* cB = (const char*)g.Bt + (size_t)cur.pn * tstepB + PG8_KOFF(cur);
    S.a_ready(cur);
    if constexpr (SP2) {
        PG8_STAGE(PG8_SB(0, 0), cB, voffB); PG8_STAGE(PG8_SB(0, 1), cB + hstepB, voffB); PG8_STAGE(PG8_SA(0, 0), cA, voffA); PG8_STAGE(PG8_SA(0, 1), cA + hstepA, voffA);
        if (wr == 1) PG8_BAR;
        PG8_WAIT_V(2); PG8_BAR;
        PG8_STAGE(PG8_SB(1, 0), cB + kstep, voffB); PG8_STAGE(PG8_SA(1, 0), cA + kstep, voffA); PG8_STAGE(PG8_SB(1, 1), cB + hstepB + kstep, voffB);
        PG8_WAIT_V(6); PG8_BAR;
    } else {
        PG8_STAGE(PG8_SB(0, 0), cB, voffB); PG8_STAGE(PG8_SA(0, 0), cA, voffA); PG8_STAGE(PG8_SB(0, 1), cB + hstepB, voffB); PG8_STAGE(PG8_SA(0, 1), cA + hstepA, voffA);
        if (wr == 1) PG8_BAR;
        PG8_WAIT_V(4); PG8_BAR;
        PG8_STAGE(PG8_SB(1, 0), cB + kstep, voffB); PG8_STAGE(PG8_SA(1, 0), cA + kstep, voffA); PG8_STAGE(PG8_SB(1, 1), cB + hstepB + kstep, voffB);
        PG8_WAIT_V(6); PG8_BAR;
    }
    for (;;) {
        const bool has_next = S.next(ui + 1, nxt);
        const char* nA = has_next ? (const char*)g.A + (size_t)nxt.pm * tstepA + PG8_KOFF(nxt) : cA; const char* nB = has_next ? (const char*)g.Bt + (size_t)nxt.pn * tstepB + PG8_KOFF(nxt) : cB;
        const int ntc = PG8_NT(cur);
        for (int t = 0; t < ntc; t += 2) {
            const bool last = (t == ntc - 2);
            const char* a1 = cA + (size_t)(t + 1) * kstep;
            const char* a2 = last ? nA : cA + (size_t)(t + 2) * kstep; const char* b2 = last ? nB : cB + (size_t)(t + 2) * kstep;
            const char* a3 = a2 + kstep; const char* b3 = b2 + kstep;
            if (last && has_next) S.a_ready(nxt);
            if constexpr (SP2) {
            PG8_LDB(B0, 0, 0); PG8_LDB(B1, 0, 1); PG8_SCHED; PG8_LDA(At, 0, 0); PG8_STAGE(PG8_SA(1, 1), a1 + hstepA, voffA);
            PG8_WAIT_V(8); PG8_WAIT_L(0); PG8_BAR; PG8_MMA(0, 0, At, B0); PG8_MMA(0, 1, At, B1); PG8_BAR; PG8_SCHED;
            PG8_LDA(At, 0, 1); PG8_STAGE(PG8_SB(0, 0), b2, voffB); PG8_STAGE(PG8_SB(0, 1), b2 + hstepB, voffB); PG8_STAGE(PG8_SA(0, 0), a2, voffA);
            PG8_WAIT_V(8); PG8_WAIT_L(0); PG8_BAR; PG8_MMA(1, 0, At, B0); PG8_MMA(1, 1, At, B1); PG8_BAR; PG8_SCHED;
            PG8_LDB(B0, 1, 0); PG8_LDB(B1, 1, 1); PG8_SCHED; PG8_LDA(At, 1, 0); PG8_STAGE(PG8_SA(0, 1), a2 + hstepA, voffA);
            PG8_WAIT_V(8); PG8_WAIT_L(0); PG8_BAR; PG8_MMA(0, 0, At, B0); PG8_MMA(0, 1, At, B1); PG8_BAR; PG8_SCHED;
            PG8_LDA(At, 1, 1); PG8_STAGE(PG8_SB(1, 0), b3, voffB); PG8_STAGE(PG8_SB(1, 1), b3 + hstepB, voffB); PG8_STAGE(PG8_SA(1, 0), a3, voffA);
            PG8_WAIT_V(8); PG8_WAIT_L(0); PG8_BAR; PG8_MMA(1, 0, At, B0); PG8_MMA(1, 1, At, B1); PG8_BAR; PG8_SCHED;
            } else {
            PG8_LDB(B0, 0, 0); PG8_SCHED; PG8_LDA(At, 0, 0); PG8_STAGE(PG8_SA(1, 1), a1 + hstepA, voffA);
            PG8_WAIT_L(8); PG8_BAR; PG8_WAIT_L(0); PG8_MMA(0, 0, At, B0); PG8_BAR; PG8_SCHED;
            PG8_LDB(B1, 0, 1); PG8_STAGE(PG8_SB(0, 0), b2, voffB);
            PG8_BAR; PG8_WAIT_L(0); PG8_MMA(0, 1, At, B1); PG8_BAR;
            PG8_LDA(At, 0, 1); PG8_STAGE(PG8_SA(0, 0), a2, voffA);
            PG8_BAR; PG8_WAIT_L(0); PG8_MMA(1, 0, At, B0); PG8_BAR; PG8_SCHED;
            PG8_STAGE(PG8_SB(0, 1), b2 + hstepB, voffB);
            PG8_WAIT_V(6); PG8_BAR; PG8_MMA(1, 1, At, B1); PG8_BAR;
            PG8_LDB(B0, 1, 0); PG8_SCHED; PG8_LDA(At, 1, 0); PG8_STAGE(PG8_SA(0, 1), a2 + hstepA, voffA);
            PG8_WAIT_L(8); PG8_BAR; PG8_WAIT_L(0); PG8_MMA(0, 0, At, B0); PG8_BAR; PG8_SCHED;
            PG8_LDB(B1, 1, 1); PG8_STAGE(PG8_SB(1, 0), b3, voffB);
            PG8_BAR; PG8_WAIT_L(0); PG8_MMA(0, 1, At, B1); PG8_BAR;
            PG8_LDA(At, 1, 1); PG8_STAGE(PG8_SA(1, 0), a3, voffA);
            PG8_BAR; PG8_WAIT_L(0); PG8_MMA(1, 0, At, B0); PG8_BAR; PG8_SCHED;
            PG8_STAGE(PG8_SB(1, 1), b3 + hstepB, voffB);
            PG8_WAIT_V(6); PG8_BAR; PG8_MMA(1, 1, At, B1); PG8_BAR;
            }
        }
        if constexpr (ALIGN_EPI) { if (wr == 0) PG8_BAR; }
        E(acc, cur, ui, wr, wc, fr, fq); S.done(cur);
        if (!has_next) break;
        if (!SUBK || nxt.sub == 0) {
#pragma unroll
        for (int a = 0; a < 2; ++a)
#pragma unroll
            for (int b = 0; b < 2; ++b)
#pragma unroll
                for (int m = 0; m < 4; ++m)
#pragma unroll
                    for (int n = 0; n < 2; ++n) acc[a][b][m][n] = (f32x4){0.f, 0.f, 0.f, 0.f};
        }
        cur = nxt; cA = nA; cB = nB; ++ui;
        if constexpr (ALIGN_EPI) { if (wr == 1) PG8_BAR; }
    }
    PG8_WAIT_V(0);
    if constexpr (!ALIGN_EPI) { if (wr == 0) PG8_BAR; }
    PG8_BAR;
#undef PG8_KOFF
#undef PG8_NT
#undef PG8_SA
#undef PG8_SB
#undef PG8_STAGE
#undef PG8_LDA
#undef PG8_LDB
#undef PG8_MMA
#undef PG8_WAIT_V
#undef PG8_WAIT_L
#undef PG8_BAR
#undef PG8_SCHED
}
}

#define XB_TMO      128
#define XB_XCNT(j)  (256  + 64 * (j))
#define XB_XSUB(j)  (1280 + 64 * (j))
#define XB_XGEN(j)  (2304 + 64 * (j))
#define XB_TOP      3328
#define XB_TOPGEN   3392
#define XCD_BAR_WORDS 3456
#define XB_SPIN_CAP (1u << 24)
__device__ __forceinline__ unsigned xb_ld(unsigned* p)              { return __hip_atomic_load(p, __ATOMIC_RELAXED, __HIP_MEMORY_SCOPE_AGENT); }
__device__ __forceinline__ unsigned xb_add(unsigned* p, unsigned v) { return __hip_atomic_fetch_add(p, v, __ATOMIC_RELAXED, __HIP_MEMORY_SCOPE_AGENT); }
__device__ __forceinline__ unsigned xb_xcc_id() { return (unsigned)__builtin_amdgcn_s_getreg((3 << 11) | 20) & 0xFu; }
#define XB_SPIN(cond, bar) do { unsigned _sp = 0; while (cond) { __builtin_amdgcn_s_sleep(1); \
    if ((++_sp & 255u) == 0u) { if (xb_ld(&(bar)[XB_TMO])) break; if (_sp > XB_SPIN_CAP) { atomicAdd(&(bar)[XB_TMO], 1u); break; } } } } while (0)
struct XcdBarrier { unsigned* bar; unsigned x; volatile LAS unsigned* st; };
__device__ __forceinline__ XcdBarrier xcd_barrier_post(unsigned* bar, volatile LAS unsigned* st, bool t0) {
    XcdBarrier b; b.bar = bar; b.x = xb_xcc_id(); b.st = st;
    if (t0) (void)xb_add(&bar[XB_XCNT(b.x)], 1u);
    return b;
}
__device__ __forceinline__ void xcd_barrier_complete(unsigned* bar, unsigned x, unsigned& nloc, unsigned& nx) {
    const unsigned G = gridDim.x * gridDim.y * gridDim.z;
    unsigned sum, cnt, mine, sp = 0u;
    for (;;) {
        sum = 0u; cnt = 0u; mine = 0u;
#pragma unroll
        for (unsigned j = 0; j < 16; ++j) { const unsigned c = xb_ld(&bar[XB_XCNT(j)]); sum += c; cnt += (c > 0u) ? 1u : 0u; mine = (j == x) ? c : mine; }
        if (sum == G) break;
        __builtin_amdgcn_s_sleep(1);
        if ((++sp & 255u) == 0u) { if (xb_ld(&bar[XB_TMO])) break; if (sp > XB_SPIN_CAP) { atomicAdd(&bar[XB_TMO], 1u); break; } }
    }
    nloc = mine > 0u ? mine : 1u; nx = cnt > 0u ? cnt : 1u;
}
__device__ __forceinline__ void xcd_barrier(const XcdBarrier& b, bool t0) {
    asm volatile("s_waitcnt vmcnt(0)" ::: "memory");
    __syncthreads();
    if (t0) {
        unsigned* bar = b.bar;
        __builtin_amdgcn_s_waitcnt(0);
        unsigned nloc = b.st[0], nx = b.st[1];
        if (nloc == 0u) { xcd_barrier_complete(bar, b.x, nloc, nx); b.st[0] = nloc; b.st[1] = nx; }
        const unsigned old = xb_add(&bar[XB_XSUB(b.x)], 1u);
        const unsigned gen = old / nloc;
        if (old + 1u == (gen + 1u) * nloc) {
            __builtin_amdgcn_fence(__ATOMIC_RELEASE, "agent");
            asm volatile("s_waitcnt vmcnt(0)" ::: "memory");
            const unsigned og = xb_add(&bar[XB_TOP], 1u);
            const unsigned tg = og / nx;
            if (og + 1u == (tg + 1u) * nx) xb_add(&bar[XB_TOPGEN], 1u);
            else XB_SPIN(xb_ld(&bar[XB_TOPGEN]) == tg, bar);
            __builtin_amdgcn_fence(__ATOMIC_ACQUIRE, "agent");
            xb_add(&bar[XB_XGEN(b.x)], 1u);
            asm volatile("s_waitcnt vmcnt(0)" ::: "memory");
        } else {
            XB_SPIN(xb_ld(&bar[XB_XGEN(b.x)]) == gen, bar);
            __builtin_amdgcn_fence(__ATOMIC_ACQUIRE, "agent");
            asm volatile("s_waitcnt vmcnt(0)" ::: "memory");
        }
    }
    __syncthreads();
}

struct Args {
    const float* in[22]; float* out; unsigned char* ws;
    int l_lo, l_hi, s_lo, s_hi, ph_lo, ph_hi, do_pro, do_fin, use_bar, pad;
};
struct Frame {
    LAS unsigned char* lds;
    int wave, G, gw, NGW;
};
enum { I_XP = 0, I_XS, I_F1N, I_F1G, I_F1U, I_F1D, I_MN, I_WIN, I_SINK, I_T5, I_NAB, I_LBL, I_HN, I_WA, I_WB, I_WC, I_WO, I_F2N, I_F2G, I_F2U, I_F2D, I_FN };

__device__ __forceinline__ void tr_item(const float* W, int K, int N, bf16* WT, int ld, int koff, int rowmode, LAS float* scr, int item, int lane, const float* gain) {
    const int nblk = N / 32, kb = item / nblk, nb = item % nblk, k0 = 64 * kb, n0 = 32 * nb;
#pragma unroll 8
    for (int i = 0; i < 32; ++i) { const int kk = 2 * i + (lane >> 5); scr[kk * 33 + (lane & 31)] = W[(size_t)(k0 + kk) * N + n0 + (lane & 31)]; }
    LDS_WAIT(); asm volatile("" ::: "memory");
    const int c = lane & 7;
    f32x4 g0 = (f32x4){1.f, 1.f, 1.f, 1.f}, g1 = g0;
    if (gain) { g0 = *(const GAS f32x4*)(gain + k0 + 8 * c); g1 = *(const GAS f32x4*)(gain + k0 + 8 * c + 4); }
#pragma unroll
    for (int j = 0; j < 4; ++j) { const int n = (lane >> 3) + 8 * j; const LAS float* s = scr + (8 * c) * 33 + n;
        v4u o; o.x = pk2(s[0 * 33] * g0[0], s[1 * 33] * g0[1]); o.y = pk2(s[2 * 33] * g0[2], s[3 * 33] * g0[3]); o.z = pk2(s[4 * 33] * g1[0], s[5 * 33] * g1[1]); o.w = pk2(s[6 * 33] * g1[2], s[7 * 33] * g1[3]);
        const int nn = n0 + n; const int drow = rowmode == 0 ? nn : ((nn >> 7) * 256 + (nn & 127) + (rowmode == 2 ? 128 : 0));
        *(GAS v4u*)(WT + (size_t)drow * ld + koff + k0 + 8 * c) = o; }
    LDS_WAIT(); asm volatile("" ::: "memory");
}
__device__ __forceinline__ void tr_matrix(Frame& F, const float* W, int K, int N, bf16* WT, int ld, int koff, int rowmode, const float* gain = nullptr) {
    LAS float* scr = (LAS float*)(F.lds + RING_OFF + F.wave * 16384);
    const int nitems = (K / 64) * (N / 32);
    const int lane = lane_id();
    for (int it = F.gw; it < nitems; it += F.NGW) tr_item(W, K, N, WT, ld, koff, rowmode, scr, it, lane, gain);
}
__device__ __forceinline__ int t5_bucket(int rel) {
    const int n = rel < 0 ? -rel : rel; int b = rel > 0 ? 16 : 0;
    if (n < 8) return b + n;
    int lg = 2 + (31 - __builtin_clz((unsigned)(n * n)));
    if (lg > 15) lg = 15;
    return b + lg;
}
__device__ __forceinline__ void prologue(Frame& F, const __attribute__((address_space(4))) Args* ap) {
    bf16* W = (bf16*)(ap->ws + WS_W);
    for (int l = 0; l < NLAYER; ++l) {
        bf16* Wl = W + (size_t)l * E_LAYER;
        bf16* const T1 = (bf16*)(ap->ws + WS_PROJ) + (size_t)(2 * l) * E_WGU; bf16* const T2 = T1 + E_WGU;
        tr_matrix(F, ap->in[I_F1G] + (size_t)l * DM * DFF, DM, DFF, T1, DM, 0, 1, ap->in[I_F1N] + l * DM);
        tr_matrix(F, ap->in[I_F1U] + (size_t)l * DM * DFF, DM, DFF, T1, DM, 0, 2, ap->in[I_F1N] + l * DM);
        tr_matrix(F, ap->in[I_F1D] + (size_t)l * DFF * DM, DFF, DM, Wl + EO_WD1, DFF, 0, 0);
        tr_matrix(F, ap->in[I_WIN] + (size_t)l * DM * PW, DM, PW, Wl + EO_WIN, DM, 0, 0, ap->in[I_MN] + l * DM);
        tr_matrix(F, ap->in[I_WA] + (size_t)l * 1024 * DM, 1024, DM, Wl + EO_WBR, DM, 0, 0);
        tr_matrix(F, ap->in[I_WB] + (size_t)l * 512 * DM, 512, DM, Wl + EO_WBR, DM, 1024, 0);
        tr_matrix(F, ap->in[I_WC] + (size_t)l * 512 * DM, 512, DM, Wl + EO_WBR, DM, 1536, 0);
        tr_matrix(F, ap->in[I_WO] + (size_t)l * DM * DM, DM, DM, Wl + EO_WOUT, DM, 0, 0);
        tr_matrix(F, ap->in[I_F2G] + (size_t)l * DM * DFF, DM, DFF, T2, DM, 0, 1, ap->in[I_F2N] + l * DM);
        tr_matrix(F, ap->in[I_F2U] + (size_t)l * DM * DFF, DM, DFF, T2, DM, 0, 2, ap->in[I_F2N] + l * DM);
        tr_matrix(F, ap->in[I_F2D] + (size_t)l * DFF * DM, DFF, DM, Wl + EO_WD2, DFF, 0, 0);
    }
    float* tab = (float*)(ap->ws + WS_TAB);
    const int gt = blockIdx.x * 512 + F.wave * 64 + lane_id(), NT = F.G * 512;
    for (int i = gt; i < 8 * 260; i += NT) { const int h = i / 260, j = i % 260; tab[TAB_T5 + i] = j <= 256 ? ap->in[I_T5][t5_bucket(j - 128) * 8 + h] * LOG2E : -1e30f; }
    for (int i = gt; i < 2 * 512; i += NT) {
        const int dir = i / 512, c = i % 512; const float* lg = ap->in[I_LBL] + (size_t)dir * NLAYER * 512 + c;
        float mx = lg[0]; for (int l = 1; l < NLAYER; ++l) mx = fmaxf(mx, lg[l * 512]);
        float e[NLAYER], s = 0.f; for (int l = 0; l < NLAYER; ++l) { e[l] = expf(lg[l * 512] - mx); s += e[l]; }
        float cum = 0.f; for (int l = 0; l < NLAYER; ++l) { cum += e[l] / s; tab[TAB_LB + (dir * NLAYER + l) * 512 + c] = cum - e[0] / s; }
    }
}
__device__ __forceinline__ void quant_rows(Frame& F, const bf16* src, unsigned char* dst, float* scl, int nrows) {
    const int lane = lane_id();
    for (int r0 = F.gw; r0 < nrows; r0 += 4 * F.NGW) {
        pg8::u32x4 v[4][4];
#pragma unroll
        for (int u = 0; u < 4; ++u) { const int r = r0 + u * F.NGW;
            if (r < nrows) { const GAS pg8::u32x4* p = (const GAS pg8::u32x4*)(src + (size_t)r * 2048) + lane * 4;
#pragma unroll
                for (int j = 0; j < 4; ++j) v[u][j] = p[j]; } }
        asm volatile("" ::: "memory");
#pragma unroll
        for (int u = 0; u < 4; ++u) { const int r = r0 + u * F.NGW;
            if (r < nrows) {
                float mx = 0.f;
#pragma unroll
                for (int j = 0; j < 4; ++j)
#pragma unroll
                    for (int e = 0; e < 4; ++e) mx = fmaxf(mx, fmaxf(fabsf(bflo(v[u][j][e])), fabsf(bfhi(v[u][j][e]))));
#pragma unroll
                for (int o = 32; o > 0; o >>= 1) mx = fmaxf(mx, __shfl_xor(mx, o));
                const float sc = mx > 0.f ? mx * (1.0f / 127.0f) : 1.0f, inv = 1.0f / sc;
                pg8::u32x4 w[2];
#pragma unroll
                for (int j = 0; j < 4; ++j)
#pragma unroll
                    for (int h = 0; h < 2; ++h) {
                        const unsigned a = v[u][j][2 * h], b = v[u][j][2 * h + 1];
                        const int q0 = (int)rintf(bflo(a) * inv), q1 = (int)rintf(bfhi(a) * inv), q2 = (int)rintf(bflo(b) * inv), q3 = (int)rintf(bfhi(b) * inv);
                        w[j >> 1][(j & 1) * 2 + h] = (unsigned)(q0 & 255) | ((unsigned)(q1 & 255) << 8) | ((unsigned)(q2 & 255) << 16) | ((unsigned)(q3 & 255) << 24);
                    }
                GAS pg8::u32x4* d = (GAS pg8::u32x4*)(dst + (size_t)r * 2048) + lane * 2;
                d[0] = w[0]; d[1] = w[1];
                if (lane == 0) scl[r] = sc;
            } }
    }
}
__device__ __forceinline__ void quant_gate_weights(Frame& F, const __attribute__((address_space(4))) Args* ap) {
    for (int l = 0; l < NLAYER; ++l) {
        unsigned char* wq = ap->ws + WS_WQ + (size_t)l * WQ_LAYER;
        quant_rows(F, (const bf16*)(ap->ws + WS_W) + (size_t)l * E_LAYER + EO_WIN + (size_t)O_GA * DM, wq, (float*)(wq + WQ_SCALE), 3 * DM);
        for (int j = 0; j < 2; ++j) { unsigned char* d = (unsigned char*)((bf16*)(ap->ws + WS_W) + (size_t)l * E_LAYER + (j ? EO_WGU2 : EO_WGU1));
            quant_rows(F, (const bf16*)(ap->ws + WS_PROJ) + (size_t)(2 * l + j) * E_WGU, d, (float*)(d + WGUQ_SCALE), 2 * DFF); }
    }
}
template <bool OUT_F32> __device__ __forceinline__ void norm_rows(Frame& F, const float* x, const float* gain, void* out, int M) {
    const int lane = lane_id();
    const GAS f32x4* gr = (const GAS f32x4*)gain + lane;
    for (int m = F.gw; m < M; m += F.NGW) {
        const GAS f32x4* xr = (const GAS f32x4*)(x + (size_t)m * DM) + lane;
        f32x4 v[8]; float s = 0.f;
#pragma unroll
        for (int j = 0; j < 8; ++j) { v[j] = xr[64 * j]; s += (v[j].x * v[j].x + v[j].y * v[j].y) + (v[j].z * v[j].z + v[j].w * v[j].w); }
        const float rstd = 1.0f / sqrtf(wave_sum(s) * (1.0f / DM) + EPS);
#pragma unroll
        for (int j = 0; j < 8; ++j) { const f32x4 g = gr[64 * j]; const f32x4 o = v[j] * rstd * g;
            if (OUT_F32) ((GAS f32x4*)((float*)out + (size_t)m * DM) + lane)[64 * j] = o;
            else { v2u w; w.x = pk2(o.x, o.y); w.y = pk2(o.z, o.w); ((GAS v2u*)((bf16*)out + (size_t)m * DM) + lane)[64 * j] = w; } }
    }
}

__device__ __forceinline__ void cast_rows(Frame& F, const float* x, bf16* xb, float* ssq, int M) {
    const int lane = lane_id();
    for (int m = F.gw; m < M; m += F.NGW) {
        const GAS f32x4* xr = (const GAS f32x4*)(x + (size_t)m * DM) + lane; float s = 0.f;
#pragma unroll
        for (int j = 0; j < 8; ++j) { const f32x4 v = xr[64 * j]; s += (v.x * v.x + v.y * v.y) + (v.z * v.z + v.w * v.w);
            v2u w; w.x = pk2(v.x, v.y); w.y = pk2(v.z, v.w); ((GAS v2u*)(xb + (size_t)m * DM) + lane)[64 * j] = w; }
        s = wave_sum(s);
        if (lane < 32) ssq[(size_t)m * 32 + lane] = lane == 0 ? s : 0.f;
    }
}
__device__ __forceinline__ void final_rows(Frame& F, const bf16* xb, const float* gain, float* out, int M) {
    const int lane = lane_id();
    const GAS f32x4* gr = (const GAS f32x4*)gain;
    for (int m = F.gw; m < M; m += F.NGW) {
        const GAS v4u* xr = (const GAS v4u*)(xb + (size_t)m * DM) + lane;
        float v[4][8]; float s = 0.f;
#pragma unroll
        for (int j = 0; j < 4; ++j) { v8(xr[64 * j], v[j]);
#pragma unroll
            for (int k = 0; k < 8; ++k) s += v[j][k] * v[j][k]; }
        const float rstd = 1.0f / sqrtf(wave_sum(s) * (1.0f / DM) + EPS);
#pragma unroll
        for (int j = 0; j < 4; ++j) { const f32x4 g0 = gr[2 * (64 * j + lane)], g1 = gr[2 * (64 * j + lane) + 1];
            GAS f32x4* o = (GAS f32x4*)(out + (size_t)m * DM) + 2 * (64 * j + lane);
            o[0] = (f32x4){v[j][0] * rstd * g0[0], v[j][1] * rstd * g0[1], v[j][2] * rstd * g0[2], v[j][3] * rstd * g0[3]};
            o[1] = (f32x4){v[j][4] * rstd * g1[0], v[j][5] * rstd * g1[1], v[j][6] * rstd * g1[2], v[j][7] * rstd * g1[3]}; }
    }
}
__device__ __forceinline__ void mixA_naive(Frame& F, const bf16* P, bf16* Y, const float* tab, const float* sink, int Ts) {
    LAS float* ql = (LAS float*)(F.lds + RING_OFF + 65536 + F.wave * 2048);
    LAS float* pl = ql + 128;
    const int lane = lane_id();
    for (int it = F.gw; it < MS * 8; it += F.NGW) {
        const int row = it >> 3, h = it & 7, kvh = h >> 2, t = row & (Ts - 1), rb = row - t;
        { const unsigned w = *(const GAS unsigned*)(P + (size_t)row * PW + O_AQ + h * 128 + 2 * lane); ql[2 * lane] = bflo(w); ql[2 * lane + 1] = bfhi(w); }
        LDS_WAIT(); asm volatile("" ::: "memory");
        float sc[5]; float mx = sink[h] * LOG2E;
#pragma unroll
        for (int p = 0; p < 5; ++p) {
            const int j = lane + 64 * p, kpos = t + j - 128; float s = -1e30f;
            if (j <= 256 && kpos >= 0 && kpos < Ts) {
                const GAS v4u* kr = (const GAS v4u*)(P + (size_t)(rb + kpos) * PW + O_AK + kvh * 128); float a = 0.f;
#pragma unroll 4
                for (int d8 = 0; d8 < 16; ++d8) { const v4u w = kr[d8]; const LAS float* q = ql + d8 * 8;
                    a += q[0] * bflo(w.x) + q[1] * bfhi(w.x) + q[2] * bflo(w.y) + q[3] * bfhi(w.y) + q[4] * bflo(w.z) + q[5] * bfhi(w.z) + q[6] * bflo(w.w) + q[7] * bfhi(w.w); }
                s = a + tab[TAB_T5 + h * 260 + j];
            }
            sc[p] = s; mx = fmaxf(mx, s);
        }
        mx = wave_max(mx);
        float sum = 0.f;
#pragma unroll
        for (int p = 0; p < 5; ++p) { const float e = fexp2(sc[p] - mx); pl[lane + 64 * p] = e; sum += e; }
        sum = wave_sum(sum) + fexp2(sink[h] * LOG2E - mx);
        LDS_WAIT(); asm volatile("" ::: "memory");
        float o0 = 0.f, o1 = 0.f;
        const int jlo = t >= 128 ? 0 : 128 - t, jhi = (t + 128 < Ts) ? 256 : (Ts - 1 - t + 128);
        for (int j = jlo; j <= jhi; ++j) { const float pj = pl[j]; const unsigned w = *(const GAS unsigned*)(P + (size_t)(rb + t + j - 128) * PW + O_AV + kvh * 128 + 2 * lane); o0 += pj * bflo(w); o1 += pj * bfhi(w); }
        const float inv = 1.0f / sum;
        *(GAS unsigned*)(Y + (size_t)row * DM + h * 128 + 2 * lane) = pk2(o0 * inv, o1 * inv);
        LDS_WAIT(); asm volatile("" ::: "memory");
    }
}
__device__ __forceinline__ void mixB_naive(Frame& F, const bf16* P, bf16* Y, const float* nab, int Ts) {
    LAS float* ql = (LAS float*)(F.lds + RING_OFF + 65536 + F.wave * 2048);
    LAS float* pl = ql + 128;
    const int lane = lane_id(), rows = Ts >> 6;
    for (int it = F.gw; it < MS * 4; it += F.NGW) {
        const int row = it >> 2, h = it & 3, t = row & (Ts - 1), rb = row - t, r = t >> 6, c = t & 63;
        int rs = r - 4; rs = rs < 0 ? 0 : (rs > rows - 8 ? rows - 8 : rs);
        int cs = c - 8; cs = cs < 0 ? 0 : (cs > 48 ? 48 : cs);
        { const unsigned w = *(const GAS unsigned*)(P + (size_t)row * PW + O_BQ + h * 128 + 2 * lane); ql[2 * lane] = bflo(w); ql[2 * lane + 1] = bfhi(w); }
        LDS_WAIT(); asm volatile("" ::: "memory");
        float sc[2]; float mx = -1e30f;
#pragma unroll
        for (int p = 0; p < 2; ++p) {
            const int i = lane + 64 * p, kr_ = rs + (i >> 4), kc = cs + (i & 15);
            const GAS v4u* kr = (const GAS v4u*)(P + (size_t)(rb + kr_ * 64 + kc) * PW + O_BK + h * 128); float a = 0.f;
#pragma unroll 4
            for (int d8 = 0; d8 < 16; ++d8) { const v4u w = kr[d8]; const LAS float* q = ql + d8 * 8;
                a += q[0] * bflo(w.x) + q[1] * bfhi(w.x) + q[2] * bflo(w.y) + q[3] * bfhi(w.y) + q[4] * bflo(w.z) + q[5] * bfhi(w.z) + q[6] * bflo(w.w) + q[7] * bfhi(w.w); }
            int dc = kc - c; dc = dc < -15 ? -15 : (dc > 15 ? 15 : dc);
            sc[p] = a + nab[(h * 15 + (kr_ - r + 7)) * 31 + dc + 15] * LOG2E; mx = fmaxf(mx, sc[p]);
        }
        mx = wave_max(mx);
        float sum = 0.f;
#pragma unroll
        for (int p = 0; p < 2; ++p) { const float e = fexp2(sc[p] - mx); pl[lane + 64 * p] = e; sum += e; }
        sum = wave_sum(sum);
        LDS_WAIT(); asm volatile("" ::: "memory");
        float o0 = 0.f, o1 = 0.f;
        for (int i = 0; i < 128; ++i) { const float pj = pl[i]; const unsigned w = *(const GAS unsigned*)(P + (size_t)(rb + (rs + (i >> 4)) * 64 + cs + (i & 15)) * PW + O_BV + h * 128 + 2 * lane); o0 += pj * bflo(w); o1 += pj * bfhi(w); }
        const float inv = 1.0f / sum;
        *(GAS unsigned*)(Y + (size_t)row * DM + 1024 + h * 128 + 2 * lane) = pk2(o0 * inv, o1 * inv);
        LDS_WAIT(); asm volatile("" ::: "memory");
    }
}
typedef float f32x16 __attribute__((ext_vector_type(16)));
typedef short s16x4 __attribute__((ext_vector_type(4)));
#define KSWZ(row, colB) ((row) * 256 + ((colB) ^ (((row) & 7) << 4)))
__device__ __forceinline__ int crow(int r, int hi) { return (r & 3) + 8 * (r >> 2) + 4 * hi; }
__device__ __forceinline__ int v_st(int k, int c) { const int kk = (k & ~0xC) | ((k & 4) << 1) | ((k & 8) >> 1); return ((kk >> 3) * 4 + (c >> 5)) * 512 + ((kk & 7) * 32 + (c & 31)) * 2; }
__device__ __forceinline__ int v_rd_base(int lane) { return ((lane & 3) << 3) | (((lane >> 2) & 3) << 6) | (((lane >> 4) & 1) << 5) | (((lane >> 5) & 1) << 8); }
constexpr int v_rd_off(int d0, int ks, int half) { return d0 * 512 + ks * 4096 + half * 2048; }
template <int OFF> __device__ __forceinline__ s16x4 tr_read(int vb) { s16x4 r; asm volatile("ds_read_b64_tr_b16 %0, %1 offset:%2" : "=&v"(r) : "v"(vb), "i"(OFF) : "memory"); return r; }
template <int D0> __device__ __forceinline__ void pv_one(f32x16& od, int vb, bf16x8 pa0, bf16x8 pa1, bf16x8 pa2, bf16x8 pa3) {
    const s16x4 l0 = tr_read<v_rd_off(D0, 0, 0)>(vb), h0 = tr_read<v_rd_off(D0, 0, 1)>(vb), l1 = tr_read<v_rd_off(D0, 1, 0)>(vb), h1 = tr_read<v_rd_off(D0, 1, 1)>(vb);
    const s16x4 l2 = tr_read<v_rd_off(D0, 2, 0)>(vb), h2 = tr_read<v_rd_off(D0, 2, 1)>(vb), l3 = tr_read<v_rd_off(D0, 3, 0)>(vb), h3 = tr_read<v_rd_off(D0, 3, 1)>(vb);
    asm volatile("s_waitcnt lgkmcnt(0)" ::: "memory"); __builtin_amdgcn_sched_barrier(0);
#define PKV(L, H) (bf16x8){L[0], L[1], L[2], L[3], H[0], H[1], H[2], H[3]}
    od = __builtin_amdgcn_mfma_f32_32x32x16_bf16(pa0, PKV(l0, h0), od, 0, 0, 0);
    od = __builtin_amdgcn_mfma_f32_32x32x16_bf16(pa1, PKV(l1, h1), od, 0, 0, 0);
    od = __builtin_amdgcn_mfma_f32_32x32x16_bf16(pa2, PKV(l2, h2), od, 0, 0, 0);
    od = __builtin_amdgcn_mfma_f32_32x32x16_bf16(pa3, PKV(l3, h3), od, 0, 0, 0);
#undef PKV
}
constexpr int AT_K = 0, AT_V = 32768, AT_TAB = 65536, AT_WS = 65536 + 8192, AT_KV = 16384;
__device__ __forceinline__ void attn_tile_update(f32x16& p0, f32x16& p1, f32x16 (&o)[4], float& m_reg, float& l_reg, int vb, LAS float* al_l, int r32, int hi) {
    float pmax = p0[0];
#pragma unroll
    for (int r = 1; r < 16; ++r) pmax = fmaxf(pmax, p0[r]);
#pragma unroll
    for (int r = 0; r < 16; ++r) pmax = fmaxf(pmax, p1[r]);
    pmax = fmaxf(pmax, __shfl_xor(pmax, 32));
    const float mn = fmaxf(m_reg, pmax), alpha = fexp2(m_reg - mn);
    m_reg = mn;
    if (__any(alpha < 1.f)) {
        if (hi == 0) al_l[r32] = alpha;
        asm volatile("s_waitcnt lgkmcnt(0)" ::: "memory");
#pragma unroll
        for (int r = 0; r < 16; ++r) { const float a = al_l[crow(r, hi)];
#pragma unroll
            for (int d = 0; d < 4; ++d) o[d][r] *= a; }
        asm volatile("s_waitcnt lgkmcnt(0)" ::: "memory");
    }
    float ps = 0.f;
#pragma unroll
    for (int r = 0; r < 16; ++r) { p0[r] = fexp2(p0[r] - mn); p1[r] = fexp2(p1[r] - mn); ps += p0[r] + p1[r]; }
    ps += __shfl_xor(ps, 32);
    l_reg = l_reg * alpha + ps;
    bf16x8 pa0, pa1, pa2, pa3;
#define PK4(P, BASE, OUT) do { const unsigned a0 = pg8::cvt_pk_bf16(P[BASE + 0], P[BASE + 1]), a1 = pg8::cvt_pk_bf16(P[BASE + 2], P[BASE + 3]);   \
    const unsigned b0 = pg8::cvt_pk_bf16(P[BASE + 4], P[BASE + 5]), b1 = pg8::cvt_pk_bf16(P[BASE + 6], P[BASE + 7]);                              \
    auto r0 = __builtin_amdgcn_permlane32_swap(a0, b0, false, false); auto r1 = __builtin_amdgcn_permlane32_swap(a1, b1, false, false); \
    v4u wv = {r0[0], r1[0], r0[1], r1[1]}; OUT = __builtin_bit_cast(bf16x8, wv); } while (0)
    PK4(p0, 0, pa0); PK4(p0, 8, pa1); PK4(p1, 0, pa2); PK4(p1, 8, pa3);
#undef PK4
    pv_one<0>(o[0], vb, pa0, pa1, pa2, pa3); pv_one<1>(o[1], vb, pa0, pa1, pa2, pa3); pv_one<2>(o[2], vb, pa0, pa1, pa2, pa3); pv_one<3>(o[3], vb, pa0, pa1, pa2, pa3);
}
__device__ __forceinline__ void attn_qkt(f32x16& p0, f32x16& p1, const LAS unsigned char* Ks, const bf16x8 (&qr)[8], int r32, int hi) {
    p0 = (f32x16){}; p1 = (f32x16){};
#pragma unroll
    for (int d0 = 0; d0 < 8; ++d0) { const int cb = (d0 * 16 + hi * 8) * 2;
        const bf16x8 b0 = *(const LAS bf16x8*)(Ks + KSWZ(r32, cb)), b1 = *(const LAS bf16x8*)(Ks + KSWZ(32 + r32, cb));
        p0 = __builtin_amdgcn_mfma_f32_32x32x16_bf16(b0, qr[d0], p0, 0, 0, 0);
        p1 = __builtin_amdgcn_mfma_f32_32x32x16_bf16(b1, qr[d0], p1, 0, 0, 0); }
}
struct KVStage { v4u k0, k1, v0, v1; };
__device__ __forceinline__ void kv_load(KVStage& st, const bf16* Kp, const bf16* Vp, int row0, int sr, int sc) {
    st.k0 = *(const GAS v4u*)(Kp + (size_t)(row0 + sr) * PW + sc); st.k1 = *(const GAS v4u*)(Kp + (size_t)(row0 + 32 + sr) * PW + sc);
    st.v0 = *(const GAS v4u*)(Vp + (size_t)(row0 + sr) * PW + sc); st.v1 = *(const GAS v4u*)(Vp + (size_t)(row0 + 32 + sr) * PW + sc);
}
__device__ __forceinline__ void kv_write(const KVStage& st, LAS unsigned char* Kb, LAS unsigned char* Vb, int sr, int sc) {
    *(LAS v4u*)(Kb + KSWZ(sr, sc * 2)) = st.k0; *(LAS v4u*)(Kb + KSWZ(32 + sr, sc * 2)) = st.k1;
    *(LAS v4u*)(Vb + v_st(sr, sc)) = st.v0; *(LAS v4u*)(Vb + v_st(32 + sr, sc)) = st.v1;
}
__device__ __forceinline__ void attn_store(const f32x16 (&o)[4], float l_reg, LAS float* li_l, bf16* Yrow0  , int r32, int hi) {
    if (hi == 0) li_l[r32] = l_reg;
    asm volatile("s_waitcnt lgkmcnt(0)" ::: "memory");
#pragma unroll
    for (int r = 0; r < 16; ++r) { const int orow = crow(r, hi); const float rl = frcp(li_l[orow]);
#pragma unroll
        for (int d0 = 0; d0 < 4; ++d0) Yrow0[(size_t)orow * DM + d0 * 32 + r32] = (bf16)f2bf(o[d0][r] * rl); }
    asm volatile("s_waitcnt lgkmcnt(0)" ::: "memory");
}
__device__ __forceinline__ void mixA_mfma(Frame& F, const bf16* P, bf16* Y, const float* tab, const float* sink, int Ts) {
    const int lane = lane_id(), w = F.wave, tid = w * 64 + lane, r32 = lane & 31, hi = lane >> 5, sr = tid >> 4, sc = (tid & 15) * 8;
    LAS unsigned char* const L = F.lds + RING_OFF;
    LAS float* const TB = (LAS float*)(L + AT_TAB);
    LAS float* const wsf = (LAS float*)(L + AT_WS) + w * 64;
    const int nqb = Ts >> 7, nitems = (MS >> 7) * 4;
    for (int item = blockIdx.x; item < nitems; item += F.G) {
        const int hp = item & 1, kvh = (item >> 1) & 1, qblk = item >> 2, n = qblk & (nqb - 1), rb = (qblk - n) << 7;
        const int h = kvh * 4 + hp * 2 + (w >> 2), q0 = 128 * n + 32 * (w & 3);
        __syncthreads();
        for (int e = tid; e < 2 * 448; e += 512) { const int hl = e / 448, idx = e % 448 - 96; TB[e] = (idx >= 0 && idx <= 256) ? tab[TAB_T5 + (kvh * 4 + hp * 2 + hl) * 260 + idx] : -1e30f; }
        bf16x8 qr[8];
        { const bf16* qp = P + (size_t)(rb + q0 + r32) * PW + O_AQ + h * 128 + hi * 8;
#pragma unroll
          for (int d0 = 0; d0 < 8; ++d0) qr[d0] = *(const GAS bf16x8*)(qp + d0 * 16); }
        f32x16 o[4] = {}; float m_reg = sink[h] * LOG2E, l_reg = 1.0f;
        const int kt0 = n == 0 ? 0 : 2 * n - 2, kt1 = (n == nqb - 1) ? 2 * n + 2 : 2 * n + 4;
        const bf16* Kp = P + (size_t)rb * PW + O_AK + kvh * 128; const bf16* Vp = P + (size_t)rb * PW + O_AV + kvh * 128;
        KVStage st0, st1; kv_load(st0, Kp, Vp, 64 * kt0, sr, sc);
        if (kt0 + 1 < kt1) kv_load(st1, Kp, Vp, 64 * (kt0 + 1), sr, sc);
        kv_write(st0, L + AT_K, L + AT_V, sr, sc);
        __syncthreads();
        const LAS float* tbh = TB + (w >> 2) * 448;
#define MIXA_STEP(kt, STN, STW) do { const int b = ((kt) - kt0) & 1; \
            if ((kt) + 2 < kt1) kv_load(STN, Kp, Vp, 64 * ((kt) + 2), sr, sc); \
            const int k0 = 64 * (kt); \
            if (k0 + 63 >= q0 - 128 && k0 <= q0 + 31 + 128) { \
                f32x16 p0, p1; attn_qkt(p0, p1, L + AT_K + b * AT_KV, qr, r32, hi); \
                const LAS float* tl = tbh + (k0 - q0 - r32 + 4 * hi + 224); \
                _Pragma("unroll") for (int r = 0; r < 16; ++r) { p0[r] += tl[(r & 3) + 8 * (r >> 2)]; p1[r] += tl[32 + (r & 3) + 8 * (r >> 2)]; } \
                attn_tile_update(p0, p1, o, m_reg, l_reg, (int)(uintptr_t)(L + AT_V + b * AT_KV) + v_rd_base(lane), wsf, r32, hi); } \
            if ((kt) + 1 < kt1) kv_write(STW, L + AT_K + (b ^ 1) * AT_KV, L + AT_V + (b ^ 1) * AT_KV, sr, sc); \
            __syncthreads(); } while (0)
        for (int kt = kt0; kt < kt1; kt += 2) {
            MIXA_STEP(kt, st0, st1);
            MIXA_STEP(kt + 1, st1, st0);
        }
#undef MIXA_STEP
        { bf16* Yq = Y; asm volatile("" : "+s"(Yq)); attn_store(o, l_reg, wsf, Yq + (size_t)(rb + q0) * DM + h * 128, r32, hi); }
    }
    __syncthreads();
}
__device__ __forceinline__ void mixB_mfma(Frame& F, const bf16* P, bf16* Y, const float* nab, int Ts) {
    const int lane = lane_id(), w = F.wave, tid = w * 64 + lane, r32 = lane & 31, hi = lane >> 5, sr = tid >> 4, sc = (tid & 15) * 8;
    LAS unsigned char* const L = F.lds + RING_OFF;
    LAS float* const TB = (LAS float*)(L + AT_TAB);
    LAS float* const wsf = (LAS float*)(L + AT_WS) + w * 64;
    const int rows = Ts >> 6, ngrp = rows >> 2, nitems = (MS >> 8) * 4;
    for (int item = blockIdx.x; item < nitems; item += F.G) {
        const int h = item & 3, g = item >> 2, gi = g & (ngrp - 1), rb = (g - gi) << 8, r0 = 4 * gi, r = r0 + (w >> 1), c = 32 * (w & 1) + r32;
        __syncthreads();
        for (int e = tid; e < 15 * 128; e += 512) { const int dr = e >> 7, dci = (e & 127) - 48; TB[e] = (dci >= 0 && dci <= 30) ? nab[(h * 15 + dr) * 31 + dci] * LOG2E : -1e30f; }
        bf16x8 qr[8];
        { const bf16* qp = P + (size_t)(rb + r * 64 + c) * PW + O_BQ + h * 128 + hi * 8;
#pragma unroll
          for (int d0 = 0; d0 < 8; ++d0) qr[d0] = *(const GAS bf16x8*)(qp + d0 * 16); }
        f32x16 o[4] = {}; float m_reg = -1e30f, l_reg = 0.0f;
        int rs = r - 4; rs = rs < 0 ? 0 : (rs > rows - 8 ? rows - 8 : rs);
        int t0 = r0 - 4; t0 = t0 < 0 ? 0 : (t0 > rows - 8 ? rows - 8 : t0);
        int t1 = r0 + 3 - 4; t1 = (t1 < 0 ? 0 : (t1 > rows - 8 ? rows - 8 : t1)) + 8;
        int cs = c - 8; cs = cs < 0 ? 0 : (cs > 48 ? 48 : cs);
        const unsigned long long vm = (0xFFFFull << cs) >> (4 * hi);
        const unsigned mlo = (unsigned)vm, mhi = (unsigned)(vm >> 32);
        const bf16* Kp = P + (size_t)rb * PW + O_BK + h * 128; const bf16* Vp = P + (size_t)rb * PW + O_BV + h * 128;
        KVStage st0, st1; kv_load(st0, Kp, Vp, 64 * t0, sr, sc);
        if (t0 + 1 < t1) kv_load(st1, Kp, Vp, 64 * (t0 + 1), sr, sc);
        kv_write(st0, L + AT_K, L + AT_V, sr, sc);
        __syncthreads();
#define MIXB_STEP(kr, STN, STW) do { const int b = ((kr) - t0) & 1; \
            if ((kr) + 2 < t1) kv_load(STN, Kp, Vp, 64 * ((kr) + 2), sr, sc); \
            if ((kr) >= rs && (kr) < rs + 8) { \
                f32x16 p0, p1; attn_qkt(p0, p1, L + AT_K + b * AT_KV, qr, r32, hi); \
                const LAS float* tl = TB + ((kr) - r + 7) * 128 + (4 * hi - c + 63); \
                _Pragma("unroll") for (int q = 0; q < 16; ++q) { const int kc = (q & 3) + 8 * (q >> 2); \
                    p0[q] = ((mlo >> kc) & 1u) ? p0[q] + tl[kc] : -1e30f; p1[q] = ((mhi >> kc) & 1u) ? p1[q] + tl[32 + kc] : -1e30f; } \
                attn_tile_update(p0, p1, o, m_reg, l_reg, (int)(uintptr_t)(L + AT_V + b * AT_KV) + v_rd_base(lane), wsf, r32, hi); } \
            if ((kr) + 1 < t1) kv_write(STW, L + AT_K + (b ^ 1) * AT_KV, L + AT_V + (b ^ 1) * AT_KV, sr, sc); \
            __syncthreads(); } while (0)
        for (int kr = t0; kr < t1; kr += 2) {
            MIXB_STEP(kr, st0, st1);
            if (kr + 1 < t1) MIXB_STEP(kr + 1, st1, st0);
        }
#undef MIXB_STEP
        { bf16* Yq = Y; asm volatile("" : "+s"(Yq)); attn_store(o, l_reg, wsf, Yq + (size_t)(rb + r * 64 + 32 * (w & 1)) * DM + 1024 + h * 128, r32, hi); }
    }
    __syncthreads();
}

typedef float f32x4v __attribute__((ext_vector_type(4)));
constexpr int HG_VS = 288;
constexpr int HG_KL = 272;
constexpr int ST_ITEM = 2 * 128 * 128;
template <int SH> __device__ __forceinline__ float dpp_shr(float v) { return __builtin_bit_cast(float, __builtin_amdgcn_update_dpp(0, __builtin_bit_cast(int, v), 0x110 + SH, 0xf, 0xf, true)); }
template <int SH> __device__ __forceinline__ float dpp_shl(float v) { return __builtin_bit_cast(float, __builtin_amdgcn_update_dpp(0, __builtin_bit_cast(int, v), 0x100 + SH, 0xf, 0xf, true)); }
__device__ __forceinline__ float row_scan(float v, int dir) {
    if (dir == 0) { v += dpp_shr<1>(v); v += dpp_shr<2>(v); v += dpp_shr<4>(v); v += dpp_shr<8>(v); }
    else          { v += dpp_shl<1>(v); v += dpp_shl<2>(v); v += dpp_shl<4>(v); v += dpp_shl<8>(v); }
    return v;
}
__device__ __forceinline__ void ld32bf(const bf16* p, float (&o)[32]) {
#pragma unroll
    for (int m = 0; m < 4; ++m) { const v4u w = *(const GAS v4u*)(p + 8 * m);
        o[8 * m + 0] = bflo(w.x); o[8 * m + 1] = bfhi(w.x); o[8 * m + 2] = bflo(w.y); o[8 * m + 3] = bfhi(w.y); o[8 * m + 4] = bflo(w.z); o[8 * m + 5] = bfhi(w.z); o[8 * m + 6] = bflo(w.w); o[8 * m + 7] = bfhi(w.w); }
}
#define HG_PREP(VS_OFF, TOT_OFF) \
    const int lane = lane_id(), tl = lane & 15, kq = lane >> 4, w = F.wave, dir = w >> 2, i = w & 3, tid = w * 64 + lane; \
    LAS unsigned char* const vs = F.lds + RING_OFF + (VS_OFF); LAS float* const TOT = (LAS float*)(F.lds + RING_OFF + (TOT_OFF));
constexpr int HG_TS = 144;
__device__ __forceinline__ void hg_h1(Frame& F, const bf16* P, bf16* ST, float* DEC) {
    const int lane = lane_id(), tl = lane & 15, kq = lane >> 4, w = F.wave, dir = w >> 2, i = w & 3, tid = w * 64 + lane;
    LAS unsigned char* const KT = F.lds + RING_OFF;
    LAS unsigned char* const VT = F.lds + RING_OFF + 36864;
    LAS float* const TOT = (LAS float*)(F.lds + RING_OFF + 55296);
    for (int item = blockIdx.x; item < MS / 64 * 4; item += F.G) {
        const int chunk = item >> 2, h = item & 3, r0 = chunk * 64;
        __syncthreads();
#pragma unroll
        for (int k2 = 0; k2 < 2; ++k2) { const int idx = tid + 512 * k2, row = idx >> 4, c16 = idx & 15;
            const v4u vv = *(const GAS v4u*)(P + (size_t)(r0 + row) * PW + O_CI + h * 128 + 8 * c16);
            LAS unsigned char* vp = VT + (8 * c16) * HG_TS + 2 * row;
            *(LAS unsigned short*)(vp) = (unsigned short)vv.x; *(LAS unsigned short*)(vp + HG_TS) = (unsigned short)(vv.x >> 16);
            *(LAS unsigned short*)(vp + 2 * HG_TS) = (unsigned short)vv.y; *(LAS unsigned short*)(vp + 3 * HG_TS) = (unsigned short)(vv.y >> 16);
            *(LAS unsigned short*)(vp + 4 * HG_TS) = (unsigned short)vv.z; *(LAS unsigned short*)(vp + 5 * HG_TS) = (unsigned short)(vv.z >> 16);
            *(LAS unsigned short*)(vp + 6 * HG_TS) = (unsigned short)vv.w; *(LAS unsigned short*)(vp + 7 * HG_TS) = (unsigned short)(vv.w >> 16); }
        float g[32];
        ld32bf(P + (size_t)(r0 + 16 * i + tl) * PW + O_CFF + dir * 512 + h * 128 + 32 * kq, g);
        float kl[32];
#pragma unroll
        for (int s = 0; s < 32; ++s) { const float c = row_scan(g[s], dir), rc = row_scan(g[s], 1 - dir) - g[s];
            if (tl == (dir == 0 ? 15 : 0)) TOT[(dir * 4 + i) * 128 + 32 * kq + s] = c;
            kl[s] = (1.0f - fexp2(g[s])) * fexp2(rc); if ((s & 3) == 3) asm volatile("" ::: "memory"); }
        __syncthreads();
#pragma unroll
        for (int s4 = 0; s4 < 8; ++s4) {
            f32x4v tv[4];
#pragma unroll
            for (int m = 0; m < 4; ++m) tv[m] = *(const LAS f32x4v*)(TOT + (dir * 4 + m) * 128 + 32 * kq + 4 * s4);
            f32x4v a = (f32x4v){0.f, 0.f, 0.f, 0.f};
#pragma unroll
            for (int m = 0; m < 4; ++m) if (dir == 0 ? m > i : m < i) a += tv[m];
            LAS unsigned char* kp = KT + (dir * 128 + 32 * kq + 4 * s4) * HG_TS + 2 * (16 * i + tl);
#pragma unroll
            for (int k = 0; k < 4; ++k) *(LAS unsigned short*)(kp + k * HG_TS) = (unsigned short)f2bf(kl[4 * s4 + k] * fexp2(a[k]));
            if (i == 0 && tl == 0) { const f32x4v all = (tv[0] + tv[1]) + (tv[2] + tv[3]);
                *(GAS f32x4v*)(DEC + ((size_t)item * 2 + dir) * 128 + 32 * kq + 4 * s4) = (f32x4v){fexp2(all[0]), fexp2(all[1]), fexp2(all[2]), fexp2(all[3])}; }
            asm volatile("" ::: "memory");
        }
        __syncthreads();
        f32x4v acc[2][8];
#pragma unroll
        for (int a = 0; a < 2; ++a)
#pragma unroll
            for (int T = 0; T < 8; ++T) acc[a][T] = (f32x4v){0.f, 0.f, 0.f, 0.f};
#pragma unroll
        for (int m = 0; m < 2; ++m) {
            const bf16x8 a0 = *(const LAS bf16x8*)(KT + (dir * 128 + 32 * i + tl) * HG_TS + 64 * m + 16 * kq), a1 = *(const LAS bf16x8*)(KT + (dir * 128 + 32 * i + 16 + tl) * HG_TS + 64 * m + 16 * kq);
#pragma unroll
            for (int T = 0; T < 8; ++T) { const bf16x8 bv = *(const LAS bf16x8*)(VT + (16 * T + tl) * HG_TS + 64 * m + 16 * kq);
                acc[0][T] = __builtin_amdgcn_mfma_f32_16x16x32_bf16(a0, bv, acc[0][T], 0, 0, 0); acc[1][T] = __builtin_amdgcn_mfma_f32_16x16x32_bf16(a1, bv, acc[1][T], 0, 0, 0); }
        }
        bf16* sp = ST + (size_t)item * ST_ITEM + (size_t)dir * 16384;
#pragma unroll
        for (int a = 0; a < 2; ++a)
#pragma unroll
            for (int T = 0; T < 8; ++T) { v2u wv; wv.x = pk2(acc[a][T][0], acc[a][T][1]); wv.y = pk2(acc[a][T][2], acc[a][T][3]);
                *(GAS v2u*)(sp + (size_t)(16 * T + tl) * 128 + 32 * i + 16 * a + 4 * kq) = wv; }
    }
    __syncthreads();
}
__device__ __forceinline__ void hg_scan(Frame& F, bf16* ST, const float* DEC, int nseq, int nchunk) {
    const int gt = blockIdx.x * 512 + F.wave * 64 + lane_id(), NT = F.G * 512, total = nseq * 16384;
    for (int idx = gt; idx < total; idx += NT) {
        const int d8 = idx & 15, e = (idx >> 4) & 127, dir = (idx >> 11) & 1, h = (idx >> 12) & 3, sq = idx >> 14;
        float S[8];
#pragma unroll
        for (int k = 0; k < 8; ++k) S[k] = 0.f;
#pragma unroll 8
        for (int st = 0; st < nchunk; ++st) {
            const int c = dir == 0 ? st : nchunk - 1 - st; const size_t it2 = ((size_t)(sq * nchunk + c) * 4 + h) * 2 + dir;
            GAS v4u* p = (GAS v4u*)(ST + it2 * 16384 + (size_t)e * 128 + 8 * d8);
            const v4u dl = *p; const f32x4 dc0 = *(const GAS f32x4*)(DEC + it2 * 128 + 8 * d8), dc1 = *(const GAS f32x4*)(DEC + it2 * 128 + 8 * d8 + 4);
            v4u wv; wv.x = pk2(S[0], S[1]); wv.y = pk2(S[2], S[3]); wv.z = pk2(S[4], S[5]); wv.w = pk2(S[6], S[7]);
            *p = wv;
            float df[8]; v8(dl, df);
            S[0] = S[0] * dc0[0] + df[0]; S[1] = S[1] * dc0[1] + df[1]; S[2] = S[2] * dc0[2] + df[2]; S[3] = S[3] * dc0[3] + df[3];
            S[4] = S[4] * dc1[0] + df[4]; S[5] = S[5] * dc1[1] + df[5]; S[6] = S[6] * dc1[2] + df[6]; S[7] = S[7] * dc1[3] + df[7];
        }
    }
}
__device__ __forceinline__ void hg_h3(Frame& F, const bf16* P, const bf16* ST, bf16* Y, const float* gain) {
    HG_PREP(34816, 53248)
    LAS unsigned char* const KL = F.lds + RING_OFF;
    LAS float* const TR = (LAS float*)(F.lds + RING_OFF + 57344) + w * 320;
    LAS float* const OX = (LAS float*)(F.lds + RING_OFF);
    for (int item = blockIdx.x; item < MS / 64 * 4; item += F.G) {
        const int chunk = item >> 2, h = item & 3, r0 = chunk * 64, row = r0 + 16 * i + tl;
        const bf16* sp = ST + (size_t)item * ST_ITEM + (size_t)dir * 16384 + (size_t)(8 * tl) * 128 + 32 * kq;
        v4u sa[8], sb[8];
#define HG_LDS(buf, m_) do { _Pragma("unroll") for (int T_ = 0; T_ < 8; ++T_) buf[T_] = *(const GAS v4u*)(sp + T_ * 128 + 8 * (m_)); } while (0)
#define HG_MMS(buf, m_) do { v4u aw_; aw_.x = pg8::cvt_pk_bf16(qd[8 * (m_)], qd[8 * (m_) + 1]); aw_.y = pg8::cvt_pk_bf16(qd[8 * (m_) + 2], qd[8 * (m_) + 3]); \
        aw_.z = pg8::cvt_pk_bf16(qd[8 * (m_) + 4], qd[8 * (m_) + 5]); aw_.w = pg8::cvt_pk_bf16(qd[8 * (m_) + 6], qd[8 * (m_) + 7]); const bf16x8 af_ = __builtin_bit_cast(bf16x8, aw_); \
        _Pragma("unroll") for (int T_ = 0; T_ < 8; ++T_) o[T_] = __builtin_amdgcn_mfma_f32_16x16x32_bf16(af_, __builtin_bit_cast(bf16x8, buf[T_]), o[T_], 0, 0, 0); } while (0)
        HG_LDS(sa, 0); HG_LDS(sb, 1);
        __syncthreads();
#pragma unroll
        for (int k2 = 0; k2 < 2; ++k2) { const int idx = tid + 512 * k2, rw = idx >> 4, c16 = idx & 15;
            *(LAS v4u*)(vs + rw * HG_VS + c16 * 16) = *(const GAS v4u*)(P + (size_t)(r0 + rw) * PW + O_CI + h * 128 + 8 * c16); }
        float qd[32]; bf16x8 kdp[4];
        { float g[32];
          ld32bf(P + (size_t)row * PW + O_CFF + dir * 512 + h * 128 + 32 * kq, g);
          ld32bf(P + (size_t)row * PW + O_CQ + h * 128 + 32 * kq, qd);
#pragma unroll
          for (int m = 0; m < 4; ++m) { float kd8[8];
#pragma unroll
              for (int j = 0; j < 8; ++j) { const int s = 8 * m + j;
                  const float c = row_scan(g[s], dir), rc = row_scan(g[s], 1 - dir) - g[s];
                  if (tl == (dir == 0 ? 15 : 0)) TOT[(dir * 4 + i) * 128 + 32 * kq + s] = c;
                  const float k = 1.0f - fexp2(g[s]);
                  g[s] = k * fexp2(rc);
                  qd[s] *= fexp2(c); kd8[j] = k * fexp2(fminf(-c, 120.0f)); }
              v4u wv; wv.x = pg8::cvt_pk_bf16(g[8 * m], g[8 * m + 1]); wv.y = pg8::cvt_pk_bf16(g[8 * m + 2], g[8 * m + 3]); wv.z = pg8::cvt_pk_bf16(g[8 * m + 4], g[8 * m + 5]); wv.w = pg8::cvt_pk_bf16(g[8 * m + 6], g[8 * m + 7]);
              *(LAS v4u*)(KL + (dir * 64 + 16 * i + tl) * HG_KL + (32 * kq + 8 * m) * 2) = wv;
              v4u kv; kv.x = pg8::cvt_pk_bf16(kd8[0], kd8[1]); kv.y = pg8::cvt_pk_bf16(kd8[2], kd8[3]); kv.z = pg8::cvt_pk_bf16(kd8[4], kd8[5]); kv.w = pg8::cvt_pk_bf16(kd8[6], kd8[7]);
              kdp[m] = __builtin_bit_cast(bf16x8, kv);
              asm volatile("" ::: "memory"); } }
        __syncthreads();
        f32x4v o[8];
#pragma unroll
        for (int T = 0; T < 8; ++T) o[T] = (f32x4v){0.f, 0.f, 0.f, 0.f};
#define HG_PACK8(x, m_) __builtin_bit_cast(bf16x8, (v4u){pg8::cvt_pk_bf16(x[8 * (m_)], x[8 * (m_) + 1]), pg8::cvt_pk_bf16(x[8 * (m_) + 2], x[8 * (m_) + 3]), pg8::cvt_pk_bf16(x[8 * (m_) + 4], x[8 * (m_) + 5]), pg8::cvt_pk_bf16(x[8 * (m_) + 6], x[8 * (m_) + 7])})
        { f32x4v a4 = (f32x4v){0.f, 0.f, 0.f, 0.f};
#pragma unroll
          for (int m = 0; m < 4; ++m) a4 = __builtin_amdgcn_mfma_f32_16x16x32_bf16(HG_PACK8(qd, m), kdp[m], a4, 0, 0, 0);
#pragma unroll
          for (int r = 0; r < 4; ++r) { const int t = 4 * kq + r; const bool keep = dir == 0 ? (tl <= t) : (tl >= t); TR[t * 20 + tl] = keep ? a4[r] : 0.f; }
          LDS_WAIT(); asm volatile("" ::: "memory");
#pragma unroll
          for (int m = 0; m < 4; ++m) { const float a = TR[tl * 20 + 4 * m + kq]; float vf[8]; v8(*(const LAS v4u*)(vs + (16 * i + 4 * m + kq) * HG_VS + tl * 16), vf);
#pragma unroll
              for (int T = 0; T < 8; ++T) o[T] = __builtin_amdgcn_mfma_f32_16x16x4f32(a, vf[T], o[T], 0, 0, 0); }
          LDS_WAIT(); asm volatile("" ::: "memory"); }
        const int nblk = dir == 0 ? i : 3 - i;
        for (int jj = 1; jj <= nblk; ++jj) {
            const int j = dir == 0 ? i - jj : i + jj;
            if (jj >= 2) { const LAS float* tp = TOT + (dir * 4 + (dir == 0 ? j + 1 : j - 1)) * 128 + 32 * kq;
#pragma unroll
                for (int s4 = 0; s4 < 8; ++s4) { const f32x4v t4 = *(const LAS f32x4v*)(tp + 4 * s4); qd[4 * s4] *= fexp2(t4[0]); qd[4 * s4 + 1] *= fexp2(t4[1]); qd[4 * s4 + 2] *= fexp2(t4[2]); qd[4 * s4 + 3] *= fexp2(t4[3]); } }
            f32x4v a4 = (f32x4v){0.f, 0.f, 0.f, 0.f};
            { const LAS unsigned char* kp = KL + (dir * 64 + 16 * j + tl) * HG_KL + 64 * kq;
#pragma unroll
              for (int m = 0; m < 4; ++m) a4 = __builtin_amdgcn_mfma_f32_16x16x32_bf16(HG_PACK8(qd, m), *(const LAS bf16x8*)(kp + 16 * m), a4, 0, 0, 0); }
#pragma unroll
            for (int r = 0; r < 4; ++r) TR[(4 * kq + r) * 20 + tl] = a4[r];
            LDS_WAIT(); asm volatile("" ::: "memory");
#pragma unroll
            for (int m = 0; m < 4; ++m) { const float a = TR[tl * 20 + 4 * m + kq]; float vf[8]; v8(*(const LAS v4u*)(vs + (16 * j + 4 * m + kq) * HG_VS + tl * 16), vf);
#pragma unroll
                for (int T = 0; T < 8; ++T) o[T] = __builtin_amdgcn_mfma_f32_16x16x4f32(a, vf[T], o[T], 0, 0, 0); }
            LDS_WAIT(); asm volatile("" ::: "memory");
        }
        if (nblk >= 1) { const LAS float* tp = TOT + (dir * 4 + (dir == 0 ? 0 : 3)) * 128 + 32 * kq;
#pragma unroll
            for (int s4 = 0; s4 < 8; ++s4) { const f32x4v t4 = *(const LAS f32x4v*)(tp + 4 * s4); qd[4 * s4] *= fexp2(t4[0]); qd[4 * s4 + 1] *= fexp2(t4[1]); qd[4 * s4 + 2] *= fexp2(t4[2]); qd[4 * s4 + 3] *= fexp2(t4[3]); } }
        HG_MMS(sa, 0); HG_LDS(sa, 2); HG_MMS(sb, 1); HG_LDS(sb, 3); HG_MMS(sa, 2); HG_MMS(sb, 3);
#undef HG_LDS
#undef HG_MMS
#undef HG_PACK8
        __syncthreads();
        if (dir == 1) {
#pragma unroll
            for (int r = 0; r < 4; ++r) { LAS float* q = OX + (i * 16 + 4 * kq + r) * 128 + 8 * tl;
                *(LAS f32x4v*)q = (f32x4v){o[0][r], o[1][r], o[2][r], o[3][r]}; *(LAS f32x4v*)(q + 4) = (f32x4v){o[4][r], o[5][r], o[6][r], o[7][r]}; } }
        __syncthreads();
        if (dir == 0) {
            const f32x4v g0 = *(const GAS f32x4v*)(gain + h * 128 + 8 * tl), g1 = *(const GAS f32x4v*)(gain + h * 128 + 8 * tl + 4);
#pragma unroll
            for (int r = 0; r < 4; ++r) { const LAS float* q = OX + (i * 16 + 4 * kq + r) * 128 + 8 * tl;
                const f32x4v x0 = *(const LAS f32x4v*)q, x1 = *(const LAS f32x4v*)(q + 4);
                float v[8] = {o[0][r] + x0[0], o[1][r] + x0[1], o[2][r] + x0[2], o[3][r] + x0[3], o[4][r] + x1[0], o[5][r] + x1[1], o[6][r] + x1[2], o[7][r] + x1[3]};
                float ss = 0.f;
#pragma unroll
                for (int T = 0; T < 8; ++T) ss += v[T] * v[T];
                ss += __shfl_xor(ss, 1); ss += __shfl_xor(ss, 2); ss += __shfl_xor(ss, 4); ss += __shfl_xor(ss, 8);
                const float rstd = 1.0f / sqrtf(ss * (1.0f / 128.0f) + EPS);
                const size_t orow = (size_t)(r0 + 16 * i + 4 * kq + r);
                float sg[8]; v8(*(const GAS v4u*)(P + orow * PW + O_CG + h * 128 + 8 * tl), sg);
                v4u wv; wv.x = pk2(v[0] * rstd * g0[0] * sg[0], v[1] * rstd * g0[1] * sg[1]); wv.y = pk2(v[2] * rstd * g0[2] * sg[2], v[3] * rstd * g0[3] * sg[3]);
                wv.z = pk2(v[4] * rstd * g1[0] * sg[4], v[5] * rstd * g1[1] * sg[5]); wv.w = pk2(v[6] * rstd * g1[2] * sg[6], v[7] * rstd * g1[3] * sg[7]);
                *(GAS v4u*)(Y + orow * DM + 1536 + h * 128 + 8 * tl) = wv; }
        }
    }
    __syncthreads();
}

constexpr int RS_OFF = MISC_OFF + 128;
static_assert(RS_OFF + 13 * 256 * 4 <= LDS_BYTES, "rstd table");
template <class Sched> __device__ __forceinline__ void rstd_prepass(Frame& F, const Sched& S, const float* ssq, int ubase = 0, const float* rowscale = nullptr) {
    const int lane = lane_id(), tid = F.wave * 64 + lane, row = tid >> 1, half = tid & 1;
    LAS float* RS = (LAS float*)(F.lds + RS_OFF) + ubase * 256;
    pg8::Unit u;
    for (int i = 0; S.next(i, u); ++i) {
        const float* p = ssq + (size_t)(u.pm * 256 + row) * 32 + 16 * half;
        const f32x4 a = *(const GAS f32x4*)p, b = *(const GAS f32x4*)(p + 4), c = *(const GAS f32x4*)(p + 8), d = *(const GAS f32x4*)(p + 12);
        float s = (((a[0] + a[1]) + (a[2] + a[3])) + ((b[0] + b[1]) + (b[2] + b[3]))) + (((c[0] + c[1]) + (c[2] + c[3])) + ((d[0] + d[1]) + (d[2] + d[3])));
        s += __shfl_xor(s, 1);
        if (half == 0) RS[i * 256 + row] = (1.0f / sqrtf(s * (1.0f / 2048.0f) + EPS)) * (rowscale ? rowscale[u.pm * 256 + row] : 1.0f);
    }
    __syncthreads();
}
constexpr int NPH = 12;
typedef const __attribute__((address_space(4))) Args* ArgP;
__device__ __forceinline__ ArgP argp() { ArgP p = (ArgP)__builtin_amdgcn_kernarg_segment_ptr(); asm volatile("" : "+s"(p)); return p; }
#define PH_BEGIN const ArgP A = argp(); const int lq = opq_s(l), sq = opq_s(s); unsigned char* const ws = A->ws; \
    const bf16* const Wl = (const bf16*)(ws + WS_W) + (size_t)lq * E_LAYER; float* const xs = A->out + (size_t)sq * MS * DM; \
    bf16* const XN = (bf16*)(ws + WS_XN); bf16* const PROJ = (bf16*)(ws + WS_PROJ); bf16* const ACT = (bf16*)(ws + WS_PROJ); bf16* const Y = (bf16*)(ws + WS_Y); \
    float* const OC = (float*)(ws + WS_OC); const float* const tab = (const float*)(ws + WS_TAB); const int Ts = sq == 0 ? 8192 : 2048; \
    bf16* const MG = (bf16*)(ws + WS_MG); float* const SSQ = (float*)(ws + WS_SSQ); \
    (void)Wl; (void)xs; (void)XN; (void)PROJ; (void)ACT; (void)Y; (void)OC; (void)tab; (void)Ts; (void)MG; (void)SSQ;
__global__ void __launch_bounds__(512, 2) fwd(Args args_unused) {
    extern __shared__ __attribute__((aligned(16))) unsigned char lds[];
    Frame F;
    F.lds = (LAS unsigned char*)lds;
    F.wave = __builtin_amdgcn_readfirstlane(threadIdx.x >> 6);
    F.G = gridDim.x; F.gw = blockIdx.x * 8 + F.wave; F.NGW = F.G * 8;
    volatile LAS unsigned* MISC = (volatile LAS unsigned*)(F.lds + MISC_OFF);
    for (int u = F.wave * 64 + lane_id(); u < (LDS_BYTES - LDSCTL_OFF) / 4; u += 512) ((LAS unsigned*)(F.lds + LDSCTL_OFF))[u] = 0u;
    __syncthreads();
    const ArgP A0 = argp();
    const int use_bar = A0->use_bar;
    XcdBarrier bar; bar.bar = (unsigned*)(A0->ws + WS_CTL) + CW_BAR; bar.x = 0; bar.st = nullptr;
    if (use_bar) bar = xcd_barrier_post((unsigned*)(A0->ws + WS_CTL) + CW_BAR, MISC + 8, F.wave == 0 && lane_id() == 0);
#define GRID_BAR() do { if (opq_s(use_bar)) xcd_barrier(bar, F.wave == 0 && lane_id() == 0); } while (0)
    LAS unsigned char* ring = F.lds + RING_OFF;

    if (A0->do_pro) { prologue(F, A0); GRID_BAR(); quant_gate_weights(F, A0); GRID_BAR(); }

    const int plo = A0->ph_lo, phi = A0->ph_hi, l_lo = A0->l_lo, l_hi = A0->l_hi, s_hi = A0->s_hi;
#define IN(k) (opq_s(plo) <= (k) && (k) < opq_s(phi))
    for (int s = A0->s_lo; s < s_hi; ++s) {
        for (int l = l_lo; l < l_hi; ++l) {
            if (IN(0)) { PH_BEGIN if (lq == 0) { const float* xin = sq == 0 ? A->in[I_XP] : A->in[I_XS] + (size_t)(sq - 1) * MS * DM; cast_rows(F, xin, XN, SSQ, MS); GRID_BAR(); } }
            if (IN(1)) { PH_BEGIN
                if (lq == 0) { quant_rows(F, XN, ws + WS_OC, (float*)(ws + WS_OC + XQ_SCALE), MS); GRID_BAR(); }
                const unsigned char* wq = (const unsigned char*)(Wl + EO_WGU1);
                pg8::Gemm g{(const pg8::bf16_t*)(ws + WS_OC), (const pg8::bf16_t*)wq, MS, 2 * DFF, DM / 2, DM / 2, DM / 2}; pg8::StaticOrder S; S.init(MS, 2 * DFF, F.G, (int)blockIdx.x);
                rstd_prepass(F, S, SSQ, 0, (const float*)(ws + WS_OC + XQ_SCALE)); pg8::EpiSwiGLUQ E{ACT, DFF, (const float*)(wq + WGUQ_SCALE), (const LAS float*)(F.lds + RS_OFF)};
                pg8::gemm_phase<pg8::EpiSwiGLUQ, pg8::StaticOrder, true, true, false, true>(ring, g, S, E, F.wave); GRID_BAR(); }
            if (IN(2)) { PH_BEGIN pg8::Gemm g{ACT, Wl + EO_WD1, MS, DM, DFF, DFF, DFF}; pg8::StaticOrder S; S.init(MS, DM, F.G, (int)blockIdx.x);
                if (F.wave == 0 && lane_id() == 0) MISC[11] += 1u; __syncthreads(); const unsigned ptgt = 8u * (unsigned)__builtin_amdgcn_readfirstlane((int)MISC[11]);
                pg8::EpiResid E{XN, DM, 0.5f, SSQ, (unsigned*)(ws + WS_CTL), ptgt, ws + WS_OC, (float*)(ws + WS_OC + XQ_SCALE), (LAS unsigned*)(F.lds + RS_OFF)}; pg8::gemm_phase<pg8::EpiResid, pg8::StaticOrder, true, true>(ring, g, S, E, F.wave); GRID_BAR(); }
            if (IN(3)) {
                { PH_BEGIN
                  pg8::Gemm g{XN, Wl + EO_WIN, MS, O_GA, DM, DM, DM}; pg8::StaticOrder S; S.init(MS, O_GA, F.G, (int)blockIdx.x);
                  rstd_prepass(F, S, SSQ); pg8::EpiProj E{PROJ, PW, tab + TAB_LB + (0 * NLAYER + lq) * 512, tab + TAB_LB + (1 * NLAYER + lq) * 512, (const LAS float*)(F.lds + RS_OFF)};
                  pg8::gemm_phase<pg8::EpiProj, pg8::StaticOrder, true, true>(ring, g, S, E, F.wave); }
                { PH_BEGIN
                  const unsigned char* wq = ws + WS_WQ + (size_t)lq * WQ_LAYER;
                  pg8::Gemm g{(const pg8::bf16_t*)(ws + WS_OC), (const pg8::bf16_t*)wq, MS, 3 * DM, DM / 2, DM / 2, DM / 2}; pg8::GateOrder S; S.init(MS, 3 * DM, F.G, (int)blockIdx.x);
                  rstd_prepass(F, S, SSQ, 6, (const float*)(ws + WS_OC + XQ_SCALE));
                  pg8::EpiGateQ E{(unsigned char*)(PROJ + O_GA), PW * 2, (const float*)(wq + WQ_SCALE), (const LAS float*)(F.lds + RS_OFF) + 6 * 256};
                  pg8::gemm_phase<pg8::EpiGateQ, pg8::GateOrder, true, true, false, true>(ring, g, S, E, F.wave); }
                GRID_BAR(); }
            if (IN(4)) { PH_BEGIN
                hg_h1(F, PROJ, (bf16*)OC, (float*)(ws + WS_MG));
                mixA_mfma(F, PROJ, Y, tab, A->in[I_SINK] + lq * 8, Ts);
                mixB_mfma(F, PROJ, Y, A->in[I_NAB] + (size_t)lq * 4 * 15 * 31, Ts);
                GRID_BAR(); }
            if (IN(5)) { PH_BEGIN hg_scan(F, (bf16*)OC, (const float*)(ws + WS_MG), MS / Ts, Ts / 64); GRID_BAR(); }
            if (IN(6)) { PH_BEGIN hg_h3(F, PROJ, (const bf16*)OC, Y, A->in[I_HN] + lq * 512); GRID_BAR(); }
            if (IN(7)) { PH_BEGIN pg8::SubOrder S; S.init(MS, DM, F.G, (int)blockIdx.x);
                pg8::Gemm g{Y, Wl + EO_WBR, MS, DM, DM, DM, DM}; pg8::EpiMerged E{PROJ, PW, MG, DM};
                pg8::gemm_phase<pg8::EpiMerged, pg8::SubOrder, true, true, true>(ring, g, S, E, F.wave); GRID_BAR(); }
            if (IN(8)) { PH_BEGIN pg8::Gemm g{MG, Wl + EO_WOUT, MS, DM, DM, DM, DM}; pg8::StaticOrder S; S.init(MS, DM, F.G, (int)blockIdx.x);
                if (F.wave == 0 && lane_id() == 0) MISC[11] += 1u; __syncthreads(); const unsigned ptgt = 8u * (unsigned)__builtin_amdgcn_readfirstlane((int)MISC[11]);
                pg8::EpiResid E{XN, DM, 1.0f, SSQ, (unsigned*)(ws + WS_CTL), ptgt, ws + WS_OC, (float*)(ws + WS_OC + XQ_SCALE), (LAS unsigned*)(F.lds + RS_OFF)}; pg8::gemm_phase<pg8::EpiResid, pg8::StaticOrder, true, true>(ring, g, S, E, F.wave); GRID_BAR(); }
            if (IN(9)) { PH_BEGIN
                const unsigned char* wq = (const unsigned char*)(Wl + EO_WGU2);
                pg8::Gemm g{(const pg8::bf16_t*)(ws + WS_OC), (const pg8::bf16_t*)wq, MS, 2 * DFF, DM / 2, DM / 2, DM / 2}; pg8::StaticOrder S; S.init(MS, 2 * DFF, F.G, (int)blockIdx.x);
                rstd_prepass(F, S, SSQ, 0, (const float*)(ws + WS_OC + XQ_SCALE)); pg8::EpiSwiGLUQ E{ACT, DFF, (const float*)(wq + WGUQ_SCALE), (const LAS float*)(F.lds + RS_OFF)};
                pg8::gemm_phase<pg8::EpiSwiGLUQ, pg8::StaticOrder, true, true, false, true>(ring, g, S, E, F.wave); GRID_BAR(); }
            if (IN(10)) { PH_BEGIN pg8::Gemm g{ACT, Wl + EO_WD2, MS, DM, DFF, DFF, DFF}; pg8::StaticOrder S; S.init(MS, DM, F.G, (int)blockIdx.x);
                if (F.wave == 0 && lane_id() == 0) MISC[11] += 1u; __syncthreads(); const unsigned ptgt = 8u * (unsigned)__builtin_amdgcn_readfirstlane((int)MISC[11]);
                pg8::EpiResid E{XN, DM, 0.5f, SSQ, (unsigned*)(ws + WS_CTL), ptgt, ws + WS_OC, (float*)(ws + WS_OC + XQ_SCALE), (LAS unsigned*)(F.lds + RS_OFF)}; pg8::gemm_phase<pg8::EpiResid, pg8::StaticOrder, true, true>(ring, g, S, E, F.wave); GRID_BAR(); }
            if (IN(11)) { PH_BEGIN if (lq == NLAYER - 1) { final_rows(F, XN, A->in[I_FN], xs, MS); GRID_BAR(); } }
        }
    }
#undef IN
}

extern "C" void kernel_launch(void* const* d_in, const int* in_sizes, int n_in, void* d_out, int out_size, void* d_ws, size_t ws_size, hipStream_t stream) {
    static int grid = 0;
    if (grid == 0) {
        if (n_in != 22 || out_size != MTOT * DM || ws_size < WS_END) { fprintf(stderr, "kernel_launch: unexpected shapes (n_in %d out %d ws %zu, need ws >= %zu)\n", n_in, out_size, ws_size, (size_t)WS_END); grid = -1; return; }
        int dev = 0, cus = 0, per_cu = 0;
        if (hipGetDevice(&dev) != hipSuccess || hipDeviceGetAttribute(&cus, hipDeviceAttributeMultiprocessorCount, dev) != hipSuccess) { grid = -1; return; }
        if (hipFuncSetAttribute((const void*)fwd, hipFuncAttributeMaxDynamicSharedMemorySize, LDS_BYTES) != hipSuccess) { fprintf(stderr, "kernel_launch: hipFuncSetAttribute failed\n"); grid = -1; return; }
        if (hipOccupancyMaxActiveBlocksPerMultiprocessor(&per_cu, (const void*)fwd, 512, LDS_BYTES) != hipSuccess || per_cu < 1) fprintf(stderr, "kernel_launch: occupancy query reports %d\n", per_cu);
        (void)hipGetLastError();
        grid = cus;
    }
    if (grid < 0) return;
    (void)hipMemsetAsync((char*)d_ws + WS_CTL, 0, CTL_ZERO_BYTES, stream);
    Args a{};
    for (int i = 0; i < 22; ++i) a.in[i] = (const float*)d_in[i];
    a.out = (float*)d_out; a.ws = (unsigned char*)d_ws;
#if MK_ONE_LAUNCH
    a.l_lo = 0; a.l_hi = NLAYER; a.s_lo = 0; a.s_hi = NSLICE; a.ph_lo = 0; a.ph_hi = NPH; a.do_pro = 1; a.do_fin = 1; a.use_bar = 1;
    hipLaunchKernelGGL(fwd, dim3(grid), dim3(512), LDS_BYTES, stream, a);
#else
    a.use_bar = 0;
    a.do_pro = 1; a.do_fin = 0; a.l_lo = a.l_hi = 0; a.s_lo = a.s_hi = 0; a.ph_lo = a.ph_hi = 0;
    hipLaunchKernelGGL(fwd, dim3(grid), dim3(512), LDS_BYTES, stream, a);
    a.do_pro = 0;
    for (int s = 0; s < NSLICE; ++s) for (int l = 0; l < NLAYER; ++l) for (int p = 0; p < NPH; ++p) {
        a.l_lo = l; a.l_hi = l + 1; a.s_lo = s; a.s_hi = s + 1; a.ph_lo = p; a.ph_hi = p + 1;
        hipLaunchKernelGGL(fwd, dim3(grid), dim3(512), LDS_BYTES, stream, a);
    }
    a.do_fin = 1; a.l_lo = a.l_hi = 0; a.s_lo = a.s_hi = 0; a.ph_lo = a.ph_hi = 0;
    hipLaunchKernelGGL(fwd, dim3(grid), dim3(512), LDS_BYTES, stream, a);
#endif
    const hipError_t le = hipPeekAtLastError();
    if (le != hipSuccess) fprintf(stderr, "kernel_launch: launch failed: %s\n", hipGetErrorName(le));
}
```

```cpp
#include <hip/hip_runtime.h>
#include <cstdio>
#include <cstdint>

#ifndef MK_ONE_LAUNCH
#define MK_ONE_LAUNCH 1
#endif

#define GAS __attribute__((address_space(1)))
#define LAS __attribute__((address_space(3)))
typedef unsigned short bf16;
typedef unsigned v4u __attribute__((ext_vector_type(4)));
typedef unsigned v2u __attribute__((ext_vector_type(2)));
typedef float f32x4 __attribute__((ext_vector_type(4)));
typedef float f32x2 __attribute__((ext_vector_type(2)));
typedef short bf16x8 __attribute__((ext_vector_type(8)));
typedef GAS unsigned gu32;

constexpr int DM = 2048, DFF = 5632, PW = 11776, NLAYER = 4;
constexpr int MS = 16384, NSLICE = 3, MTOT = 49152;
constexpr float EPS = 1e-6f;
constexpr float LOG2E = 1.4426950408889634f, LN2 = 0.6931471805599453f;
constexpr float QSCALE = 0.08838834764831845f * LOG2E;
constexpr float CQSCALE = 0.08838834764831845f;
constexpr int O_AQ = 0, O_AK = 1024, O_AV = 1280, O_BQ = 1536, O_BK = 2048, O_BV = 2560, O_CFF = 3072, O_CFB = 3584, O_CI = 4096, O_CQ = 4608, O_CG = 5120, O_GA = 5632, O_GB = 7680, O_GC = 9728;

constexpr size_t MiB = 1u << 20;
constexpr size_t WS_CTL = 0, CTL_ZERO_BYTES = 1 * MiB;
constexpr size_t WS_TAB = 1 * MiB;
constexpr size_t WS_W = 2 * MiB;
constexpr size_t E_WGU = (size_t)2 * DFF * DM, E_WD = (size_t)DM * DFF, E_WIN = (size_t)PW * DM, E_WBR = (size_t)DM * DM, E_WOUT = (size_t)DM * DM;
constexpr size_t EO_WGU1 = 0, EO_WD1 = EO_WGU1 + E_WGU, EO_WIN = EO_WD1 + E_WD, EO_WBR = EO_WIN + E_WIN, EO_WOUT = EO_WBR + E_WBR, EO_WGU2 = EO_WOUT + E_WOUT, EO_WD2 = EO_WGU2 + E_WGU, E_LAYER = EO_WD2 + E_WD;
static_assert(E_LAYER * 2 == 194 * MiB, "weights per layer");
constexpr size_t WS_XN = WS_W + 4 * 194 * MiB;
constexpr size_t WS_PROJ = WS_XN + 64 * MiB;
constexpr size_t WS_Y = WS_PROJ + 368 * MiB;
constexpr size_t WS_OC = WS_Y + 64 * MiB;
constexpr size_t WS_MG = WS_OC + 128 * MiB;
constexpr size_t WS_SSQ = WS_MG + 64 * MiB;
constexpr size_t WS_WQ = WS_SSQ + 2 * MiB;
constexpr size_t WQ_LAYER = 13 * MiB, WQ_SCALE = 12 * MiB;
constexpr size_t WS_END = WS_WQ + 4 * WQ_LAYER;
constexpr size_t XQ_SCALE = 32 * MiB;
constexpr size_t WGUQ_SCALE = 22 * MiB;
static_assert(8 * E_WGU * 2 <= 368 * MiB && (size_t)2 * DFF * DM <= WGUQ_SCALE, "gate|up temporaries / int8 slot");
constexpr int CW_RMAX = 65536;
constexpr int CW_PCNT = 2048;
constexpr int CW_QCNT = 1024;
constexpr int TAB_T5 = 0, TAB_LB = 8 * 260;
constexpr int CW_TMO = 0, CW_CODE = 1, CW_BAR = 4096;

constexpr int RING_OFF = 0, RING_BYTES = 131072;
constexpr int LDSCTL_OFF = RING_BYTES, MISC_OFF = LDSCTL_OFF + 320;
constexpr int LDS_BYTES = 147456;

#define LDS_WAIT() asm volatile("s_waitcnt lgkmcnt(0)" ::: "memory")
#define VM_WAIT() asm volatile("s_waitcnt vmcnt(0)" ::: "memory")
__device__ __forceinline__ unsigned f2bf(float f) { unsigned u = __builtin_bit_cast(unsigned, f); return (u + 0x7fffu + ((u >> 16) & 1u)) >> 16; }
__device__ __forceinline__ unsigned pk2(float lo, float hi) { return f2bf(lo) | (f2bf(hi) << 16); }
__device__ __forceinline__ float bflo(unsigned w) { return __builtin_bit_cast(float, w << 16); }
__device__ __forceinline__ float bfhi(unsigned w) { return __builtin_bit_cast(float, w & 0xffff0000u); }
__device__ __forceinline__ float bf2f(bf16 b) { return __builtin_bit_cast(float, ((unsigned)b) << 16); }
__device__ __forceinline__ void v8(const v4u w, float (&o)[8]) { o[0] = bflo(w.x); o[1] = bfhi(w.x); o[2] = bflo(w.y); o[3] = bfhi(w.y); o[4] = bflo(w.z); o[5] = bfhi(w.z); o[6] = bflo(w.w); o[7] = bfhi(w.w); }
__device__ __forceinline__ float fexp2(float x) { return __builtin_amdgcn_exp2f(x); }
__device__ __forceinline__ float frcp(float x) { return __builtin_amdgcn_rcpf(x); }
__device__ __forceinline__ float sigmoidf_(float x) { return frcp(1.0f + fexp2(-x * LOG2E)); }
__device__ __forceinline__ float wave_sum(float v) {
#pragma unroll
    for (int o = 1; o < 64; o <<= 1) v += __shfl_xor(v, o);
    return v;
}
__device__ __forceinline__ float wave_max(float v) {
#pragma unroll
    for (int o = 1; o < 64; o <<= 1) v = fmaxf(v, __shfl_xor(v, o));
    return v;
}

__device__ __forceinline__ int opq_v(int x) { asm volatile("" : "+v"(x)); return x; }
__device__ __forceinline__ int opq_s(int x) { asm volatile("" : "+s"(x)); return x; }
__device__ __forceinline__ int lane_id() { const unsigned m = (unsigned)opq_s(-1); return (int)__builtin_amdgcn_mbcnt_hi(m, __builtin_amdgcn_mbcnt_lo(m, 0u)); }

namespace pg8 {
#define PG8_LAS __attribute__((address_space(3)))
typedef unsigned short bf16_t;
typedef unsigned u32x4 __attribute__((ext_vector_type(4)));
typedef unsigned u32x2 __attribute__((ext_vector_type(2)));
typedef int i32x4 __attribute__((ext_vector_type(4)));
typedef unsigned short u16x2 __attribute__((ext_vector_type(2)));
constexpr int BM = 256, BK = 64, HALF = 128, HTB = HALF * BK * 2, STAGE_BYTES = 8 * HTB, NXCD = 8, WGM = 4;
__host__ __device__ __forceinline__ int lds_byte(int r, int c) { const int st = (r >> 4) * 2 + (c >> 5), rr = r & 15, cc = c & 31, ob = rr * 64 + cc * 2; return st * 1024 + (ob ^ (((ob >> 9) & 1) << 5)); }
__host__ __device__ __forceinline__ void stage_rc(int b, int& R, int& C) { const int st = b / 1024, sb = b % 1024, swz = sb ^ (((sb >> 9) & 1) << 5); R = (st >> 1) * 16 + swz / 64; C = (st & 1) * 32 + (swz % 64) / 2; }
__host__ __device__ __forceinline__ int perm32(int rho) { const int n = rho >> 4, i = rho & 15; return 8 * (i >> 2) + 4 * n + (i & 3); }
struct Unit { int pm, pn, sub; };
struct Gemm { const bf16_t* A; const bf16_t* Bt; int M, N, K, lda, ldb; };
struct StaticOrder {
    int nM, nN, nwg, G, c;
    __host__ __device__ void init(int M, int N, int G_, int c_) { nM = M / BM; nN = N / BM; nwg = nM * nN; G = G_; c = c_; }
    __host__ __device__ bool next(int i, Unit& u) const { const long L = (long)i * G + c; if (L >= nwg) return false; at(L, u); return true; }
    __host__ __device__ void at(long L, Unit& u) const {
        int wgid = (int)L; { const int q = nwg / NXCD, r = nwg % NXCD, xcd = wgid % NXCD, off = wgid / NXCD; wgid = (xcd < r ? xcd * (q + 1) : r * (q + 1) + (xcd - r) * q) + off; }
        const int nig = WGM * nN, gid = wgid / nig, fm = gid * WGM, gsz = (nM - fm) < WGM ? (nM - fm) : WGM;
        u.pm = fm + ((wgid % nig) % gsz); u.pn = (wgid % nig) / gsz; u.sub = 0;
    }
    __device__ __forceinline__ void a_ready(const Unit&) const {}
    __device__ __forceinline__ void done(const Unit&) const {}
};
struct GateOrder : StaticOrder {
    __host__ __device__ bool next(int i, Unit& u) const {
        if (G != 256 || nwg != 1536) return StaticOrder::next(i, u);
        if (i < 5) { at((long)i * 256 + c, u); return true; }
        if (c < 128 || i > 6) return false;
        at((long)(1280 + 2 * (c - 128) + (i - 5)), u); return true;
    }
};
struct SubOrder : StaticOrder {
    __device__ __forceinline__ bool next(int i, Unit& u) const { const int t3 = i / 3; if (!StaticOrder::next(t3, u)) return false; u.sub = i - 3 * t3; return true; }
};
typedef __bf16 bf16x2_t __attribute__((ext_vector_type(2)));
__device__ __forceinline__ unsigned cvt_pk_bf16(float lo, float hi) { const f32x2 v = {lo, hi}; const bf16x2_t b = __builtin_convertvector(v, bf16x2_t); return __builtin_bit_cast(unsigned, b); }
typedef f32x4 Acc[2][2][4][2];

__device__ __forceinline__ float silu_(float x) { return x * frcp(1.0f + fexp2(-x * LOG2E)); }

__device__ __forceinline__ void row_rstd(const PG8_LAS float* rsl, int ui, int wr, int fr, float (&rs)[2][4]) {
#pragma unroll
    for (int ai = 0; ai < 2; ++ai)
#pragma unroll
        for (int m = 0; m < 4; ++m) rs[ai][m] = rsl[ui * 256 + ai * HALF + wr * 64 + m * 16 + fr];
}
struct EpiSwiGLU {
    static constexpr bool PERM = true, AFTER_DRAIN = false;
    bf16_t* O; int ldc; const PG8_LAS float* rsl;
    __device__ __forceinline__ void operator()(const Acc& acc, const Unit& u, int ui, int wr, int wc, int fr, int fq) const {
        const int row0 = u.pm * BM + wr * 64 + fr, col0 = u.pn * HALF + wc * 32 + 8 * fq;
        float rs[2][4]; row_rstd(rsl, ui, wr, fr, rs);
#pragma unroll
        for (int ai = 0; ai < 2; ++ai)
#pragma unroll
            for (int m = 0; m < 4; ++m) {
                bf16_t* rowp = O + (size_t)(row0 + ai * HALF + m * 16) * ldc + col0; const float r = rs[ai][m];
                const f32x4 g0 = acc[ai][0][m][0] * r, g1 = acc[ai][0][m][1] * r, u0 = acc[ai][1][m][0] * r, u1 = acc[ai][1][m][1] * r;
                u32x4 w;
                w.x = cvt_pk_bf16(silu_(g0[0]) * u0[0], silu_(g0[1]) * u0[1]); w.y = cvt_pk_bf16(silu_(g0[2]) * u0[2], silu_(g0[3]) * u0[3]);
                w.z = cvt_pk_bf16(silu_(g1[0]) * u1[0], silu_(g1[1]) * u1[1]); w.w = cvt_pk_bf16(silu_(g1[2]) * u1[2], silu_(g1[3]) * u1[3]);
                *(GAS u32x4*)rowp = w;
            }
    }
};
struct EpiSwiGLUQ {
    static constexpr bool PERM = true, AFTER_DRAIN = false;
    bf16_t* O; int ldc; const float* wsc; const PG8_LAS float* rsl;
    __device__ __forceinline__ void operator()(const Acc& acc, const Unit& u, int ui, int wr, int wc, int fr, int fq) const {
        const int row0 = u.pm * BM + wr * 64 + fr, col0 = u.pn * HALF + wc * 32 + 8 * fq;
        float rs[2][4]; row_rstd(rsl, ui, wr, fr, rs);
        const float* sp = wsc + u.pn * BM + wc * 32 + 8 * fq;
        const f32x4 cg0 = *(const GAS f32x4*)sp * -LOG2E, cg1 = *(const GAS f32x4*)(sp + 4) * -LOG2E, cu0 = *(const GAS f32x4*)(sp + HALF) * -LN2, cu1 = *(const GAS f32x4*)(sp + HALF + 4) * -LN2;
#pragma unroll
        for (int ai = 0; ai < 2; ++ai)
#pragma unroll
            for (int m = 0; m < 4; ++m) {
                bf16_t* rowp = O + (size_t)(row0 + ai * HALF + m * 16) * ldc + col0; const float r = rs[ai][m];
                const f32x4 g0 = __builtin_convertvector(__builtin_bit_cast(i32x4, acc[ai][0][m][0]), f32x4) * cg0 * r, g1 = __builtin_convertvector(__builtin_bit_cast(i32x4, acc[ai][0][m][1]), f32x4) * cg1 * r;
                const f32x4 u0 = __builtin_convertvector(__builtin_bit_cast(i32x4, acc[ai][1][m][0]), f32x4) * cu0 * r, u1 = __builtin_convertvector(__builtin_bit_cast(i32x4, acc[ai][1][m][1]), f32x4) * cu1 * r;
                float y0[4], y1[4];
#pragma unroll
                for (int i = 0; i < 4; ++i) { y0[i] = g0[i] * frcp(1.0f + fexp2(g0[i])) * u0[i]; y1[i] = g1[i] * frcp(1.0f + fexp2(g1[i])) * u1[i]; }
                u32x4 w;
                w.x = cvt_pk_bf16(y0[0], y0[1]); w.y = cvt_pk_bf16(y0[2], y0[3]); w.z = cvt_pk_bf16(y1[0], y1[1]); w.w = cvt_pk_bf16(y1[2], y1[3]);
                *(GAS u32x4*)rowp = w;
            }
    }
};
struct EpiResid {
    static constexpr bool PERM = true, AFTER_DRAIN = false;
    bf16_t* x; int ldc; float scale; float* ssq;
    unsigned* ctl; unsigned target; unsigned char* xq; float* xsc; PG8_LAS unsigned* scr;
    __device__ __forceinline__ void operator()(const Acc& acc, const Unit& u, int ui, int wr, int wc, int fr, int fq) const {
        const int row0 = u.pm * BM + wr * 64 + fr, col0 = u.pn * BM + wc * 32 + 8 * fq;
        bf16_t* const x = this->x; float* const ssq = this->ssq; const float scale = this->scale; const int ldc = this->ldc;
        u32x4 wk[2][4][2];
        unsigned mxr[2][4];
#pragma unroll
        for (int ai = 0; ai < 2; ++ai) {
            u32x4 xv[4][2];
#pragma unroll
            for (int m = 0; m < 4; ++m)
#pragma unroll
                for (int bj = 0; bj < 2; ++bj) xv[m][bj] = *(const GAS u32x4*)(x + (size_t)(row0 + ai * HALF + m * 16) * ldc + col0 + bj * HALF);
            asm volatile("" ::: "memory");
#pragma unroll
            for (int m = 0; m < 4; ++m) {
                const size_t off = (size_t)(row0 + ai * HALF + m * 16) * ldc + col0; float s = 0.f; u16x2 mx2 = {0, 0};
#pragma unroll
                for (int bj = 0; bj < 2; ++bj) {
                    const u32x4 w0 = xv[m][bj]; const f32x4 a0 = acc[ai][bj][m][0] * scale, a1 = acc[ai][bj][m][1] * scale;
                    const float v0 = bflo(w0.x) + a0[0], v1 = bfhi(w0.x) + a0[1], v2 = bflo(w0.y) + a0[2], v3 = bfhi(w0.y) + a0[3];
                    const float v4 = bflo(w0.z) + a1[0], v5 = bfhi(w0.z) + a1[1], v6 = bflo(w0.w) + a1[2], v7 = bfhi(w0.w) + a1[3];
                    u32x4 w; w.x = cvt_pk_bf16(v0, v1); w.y = cvt_pk_bf16(v2, v3); w.z = cvt_pk_bf16(v4, v5); w.w = cvt_pk_bf16(v6, v7);
                    *(GAS u32x4*)(x + off + bj * HALF) = w; wk[ai][m][bj] = w;
#pragma unroll
                    for (int e2 = 0; e2 < 4; ++e2) mx2 = __builtin_elementwise_max(mx2, __builtin_bit_cast(u16x2, w[e2] & 0x7fff7fffu));
                    s += ((v0 * v0 + v1 * v1) + (v2 * v2 + v3 * v3)) + ((v4 * v4 + v5 * v5) + (v6 * v6 + v7 * v7));
                }
                s += __shfl_xor(s, 16); s += __shfl_xor(s, 32);
                if (fq == 0) ssq[(size_t)(row0 + ai * HALF + m * 16) * 32 + u.pn * 4 + wc] = s;
                unsigned mh = mx2.x > mx2.y ? (unsigned)mx2.x : (unsigned)mx2.y;
                { const unsigned o = (unsigned)__shfl_xor((int)mh, 16); mh = o > mh ? o : mh; } { const unsigned o = (unsigned)__shfl_xor((int)mh, 32); mh = o > mh ? o : mh; }
                mxr[ai][m] = mh;
            }
            asm volatile("" ::: "memory");
        }
        {
            const int wave = wr * 4 + wc, lane = fq * 16 + fr, tid = wave * 64 + lane;
            PG8_LAS unsigned* const PM = this->scr; PG8_LAS float* const SC = (PG8_LAS float*)(this->scr + 1024);
            const unsigned tg = this->target; unsigned* const cur = this->ctl + CW_RMAX + ((tg >> 3) & 1u) * 16384 + u.pm * BM; unsigned* const nxt = this->ctl + CW_RMAX + (((tg >> 3) & 1u) ^ 1u) * 16384 + u.pm * BM;
            if (fq == 0) {
#pragma unroll
                for (int ai = 0; ai < 2; ++ai)
#pragma unroll
                    for (int m = 0; m < 4; ++m) PM[wc * 256 + ai * HALF + wr * 64 + m * 16 + fr] = mxr[ai][m];
            }
            __syncthreads();
            if (tid < 256) { const unsigned a = PM[tid], b = PM[256 + tid], c = PM[512 + tid], d = PM[768 + tid]; const unsigned ab = a > b ? a : b, cd = c > d ? c : d;
                (void)__hip_atomic_fetch_max(cur + tid, (ab > cd ? ab : cd) << 16, __ATOMIC_RELAXED, __HIP_MEMORY_SCOPE_AGENT); }
            asm volatile("s_waitcnt vmcnt(0)" ::: "memory"); __builtin_amdgcn_s_barrier();
            if (tid == 0) { unsigned* const pc = this->ctl + CW_PCNT + u.pm;
                (void)__hip_atomic_fetch_add(pc, 1u, __ATOMIC_RELAXED, __HIP_MEMORY_SCOPE_AGENT);
                unsigned sp = 0u; while (__hip_atomic_load(pc, __ATOMIC_RELAXED, __HIP_MEMORY_SCOPE_AGENT) < tg && ++sp < (1u << 22)) __builtin_amdgcn_s_sleep(1); }
            __builtin_amdgcn_s_barrier();
            if (tid < 256) { const unsigned mb = __hip_atomic_load(cur + tid, __ATOMIC_RELAXED, __HIP_MEMORY_SCOPE_AGENT);
                const float sc = mb ? __builtin_bit_cast(float, mb) * (1.0f / 127.0f) : 1.0f; SC[tid] = sc;
                if (u.pn == 0) this->xsc[u.pm * BM + tid] = sc;
                __hip_atomic_store(nxt + tid, 0u, __ATOMIC_RELAXED, __HIP_MEMORY_SCOPE_AGENT); }
            __syncthreads();
            unsigned char* const xq = this->xq;
#pragma unroll
            for (int ai = 0; ai < 2; ++ai)
#pragma unroll
                for (int m = 0; m < 4; ++m) {
                    const int rl = ai * HALF + wr * 64 + m * 16 + fr; const float inv = 1.0f / SC[rl];
                    unsigned char* const rp = xq + (size_t)(u.pm * BM + rl) * 2048 + col0;
#pragma unroll
                    for (int bj = 0; bj < 2; ++bj) {
                        const u32x4 w = wk[ai][m][bj]; u32x2 q;
#pragma unroll
                        for (int h = 0; h < 2; ++h) {
                            const unsigned a = w[2 * h], b = w[2 * h + 1];
                            const int q0 = (int)rintf(bflo(a) * inv), q1 = (int)rintf(bfhi(a) * inv), q2 = (int)rintf(bflo(b) * inv), q3 = (int)rintf(bfhi(b) * inv);
                            q[h] = (unsigned)(q0 & 255) | ((unsigned)(q1 & 255) << 8) | ((unsigned)(q2 & 255) << 16) | ((unsigned)(q3 & 255) << 24);
                        }
                        *(GAS u32x2*)(rp + bj * HALF) = q;
                    }
                }
        }
    }
};
struct EpiProj {
    static constexpr bool PERM = true, AFTER_DRAIN = false;
    bf16_t* O; int ldc; const float* lb0; const float* lb1; const PG8_LAS float* rsl;
    template <int MODE> __device__ __forceinline__ void tile(const Acc& acc, const Unit& u, int ui, int wr, int wc, int fr, int fq, float scale, const float* lb) const {
        const int row0 = u.pm * BM + wr * 64 + fr, col0 = u.pn * BM + wc * 32 + 8 * fq;
        float rs[2][4]; row_rstd(rsl, ui, wr, fr, rs);
        f32x4 l[2][2];
        if (MODE == 1) {
#pragma unroll
            for (int bj = 0; bj < 2; ++bj)
#pragma unroll
                for (int n = 0; n < 2; ++n) l[bj][n] = *(const GAS f32x4*)(lb + bj * HALF + wc * 32 + 8 * fq + 4 * n);
        }
#pragma unroll
        for (int ai = 0; ai < 2; ++ai)
#pragma unroll
            for (int m = 0; m < 4; ++m) {
                bf16_t* rowp = O + (size_t)(row0 + ai * HALF + m * 16) * ldc + col0;
#pragma unroll
                for (int bj = 0; bj < 2; ++bj) {
                    f32x4 v[2] = {acc[ai][bj][m][0] * rs[ai][m], acc[ai][bj][m][1] * rs[ai][m]};
#pragma unroll
                    for (int n = 0; n < 2; ++n)
#pragma unroll
                        for (int i = 0; i < 4; ++i) {
                            float x = v[n][i];
                            if (MODE == 0) x *= scale;
                            if (MODE == 1) { const float lbv = l[bj][n][i]; x = __builtin_amdgcn_logf(lbv + (1.0f - lbv) * sigmoidf_(x)); }
                            if (MODE == 2) x = silu_(x);
                            if (MODE == 3) x = sigmoidf_(x);
                            v[n][i] = x;
                        }
                    if (MODE == 3) {
                        unsigned q[2][4];
#pragma unroll
                        for (int n = 0; n < 2; ++n)
#pragma unroll
                            for (int i = 0; i < 4; ++i) { const unsigned t = (unsigned)(v[n][i] * 256.0f); q[n][i] = t < 255u ? t : 255u; }
                        u32x2 w; w.x = q[0][0] | (q[0][1] << 8) | (q[0][2] << 16) | (q[0][3] << 24); w.y = q[1][0] | (q[1][1] << 8) | (q[1][2] << 16) | (q[1][3] << 24);
                        *(GAS u32x2*)((unsigned char*)(rowp - col0 + O_GA) + (col0 - O_GA) + bj * HALF) = w;
                    } else {
                        u32x4 w; w.x = cvt_pk_bf16(v[0][0], v[0][1]); w.y = cvt_pk_bf16(v[0][2], v[0][3]); w.z = cvt_pk_bf16(v[1][0], v[1][1]); w.w = cvt_pk_bf16(v[1][2], v[1][3]);
                        *(GAS u32x4*)(rowp + bj * HALF) = w;
                    }
                }
            }
    }
    __device__ __forceinline__ void operator()(const Acc& acc, const Unit& u, int ui, int wr, int wc, int fr, int fq) const {
        const int pn = u.pn;
        if (pn >= 22) tile<3>(acc, u, ui, wr, wc, fr, fq, 1.f, nullptr);
        else if (pn >= 20) tile<2>(acc, u, ui, wr, wc, fr, fq, 1.f, nullptr);
        else if (pn >= 12 && pn < 16) tile<1>(acc, u, ui, wr, wc, fr, fq, 1.f, (pn < 14 ? lb0 : lb1) + (pn & 1) * BM);
        else { const float s = (pn < 4 || pn == 6 || pn == 7) ? QSCALE : ((pn == 18 || pn == 19) ? CQSCALE : 1.0f); tile<0>(acc, u, ui, wr, wc, fr, fq, s, nullptr); }
    }
};
struct EpiGateQ {
    static constexpr bool PERM = true, AFTER_DRAIN = false;
    unsigned char* G8; int ldg; const float* wsc; const PG8_LAS float* rsl;
    __device__ __forceinline__ void operator()(const Acc& acc, const Unit& u, int ui, int wr, int wc, int fr, int fq) const {
        const int row0 = u.pm * BM + wr * 64 + fr, col0 = u.pn * BM + wc * 32 + 8 * fq;
        float rs[2][4]; row_rstd(rsl, ui, wr, fr, rs);
        f32x4 cs[2][2];
#pragma unroll
        for (int bj = 0; bj < 2; ++bj)
#pragma unroll
            for (int n = 0; n < 2; ++n) cs[bj][n] = *(const GAS f32x4*)(wsc + col0 + bj * HALF + 4 * n) * -LOG2E;
#pragma unroll
        for (int ai = 0; ai < 2; ++ai)
#pragma unroll
            for (int m = 0; m < 4; ++m) {
                unsigned char* rowp = G8 + (size_t)(row0 + ai * HALF + m * 16) * ldg + col0;
#pragma unroll
                for (int bj = 0; bj < 2; ++bj) {
                    unsigned q[2][4];
#pragma unroll
                    for (int n = 0; n < 2; ++n) {
                        const i32x4 iv = __builtin_bit_cast(i32x4, acc[ai][bj][m][n]);
#pragma unroll
                        for (int i = 0; i < 4; ++i) {
                            const float z = (float)iv[i] * rs[ai][m] * cs[bj][n][i];
                            const unsigned t = (unsigned)frcp(__builtin_fmaf(fexp2(z), 1.0f / 256.0f, 1.0f / 256.0f)); q[n][i] = t < 255u ? t : 255u;
                        }
                    }
                    u32x2 w; w.x = q[0][0] | (q[0][1] << 8) | (q[0][2] << 16) | (q[0][3] << 24); w.y = q[1][0] | (q[1][1] << 8) | (q[1][2] << 16) | (q[1][3] << 24);
                    *(GAS u32x2*)(rowp + bj * HALF) = w;
                }
            }
    }
};
template <int MODE> struct EpiGate {
    static constexpr bool PERM = true, AFTER_DRAIN = false;
    const bf16_t* Gt; int ldg; bf16_t* O; int ldc;
    __device__ __forceinline__ void operator()(const Acc& acc, const Unit& u, int ui, int wr, int wc, int fr, int fq) const {
        const int row0 = u.pm * BM + wr * 64 + fr, col0 = u.pn * BM + wc * 32 + 8 * fq;
#pragma unroll
        for (int ai = 0; ai < 2; ++ai)
#pragma unroll
            for (int m = 0; m < 4; ++m) {
                const size_t r = (size_t)(row0 + ai * HALF + m * 16);
#pragma unroll
                for (int bj = 0; bj < 2; ++bj) {
                    const u32x4 c = *(const GAS u32x4*)(Gt + r * ldg + col0 + bj * HALF);
                    f32x4 v0 = acc[ai][bj][m][0], v1 = acc[ai][bj][m][1];
                    v0[0] *= bflo(c.x); v0[1] *= bfhi(c.x); v0[2] *= bflo(c.y); v0[3] *= bfhi(c.y); v1[0] *= bflo(c.z); v1[1] *= bfhi(c.z); v1[2] *= bflo(c.w); v1[3] *= bfhi(c.w);
                    if (MODE) { const u32x4 o = *(const GAS u32x4*)(O + r * ldc + col0 + bj * HALF);
                        v0[0] += bflo(o.x); v0[1] += bfhi(o.x); v0[2] += bflo(o.y); v0[3] += bfhi(o.y); v1[0] += bflo(o.z); v1[1] += bfhi(o.z); v1[2] += bflo(o.w); v1[3] += bfhi(o.w); }
                    u32x4 w; w.x = cvt_pk_bf16(v0[0], v0[1]); w.y = cvt_pk_bf16(v0[2], v0[3]); w.z = cvt_pk_bf16(v1[0], v1[1]); w.w = cvt_pk_bf16(v1[2], v1[3]);
                    *(GAS u32x4*)(O + r * ldc + col0 + bj * HALF) = w;
                }
                if (m & 1) asm volatile("" ::: "memory");
            }
    }
};

struct EpiMerged {
    static constexpr bool PERM = true, AFTER_DRAIN = false;
    const bf16_t* P; int ldp; bf16_t* O; int ldc;
    __device__ __forceinline__ void operator()(Acc& acc, const Unit& u, int ui, int wr, int wc, int fr, int fq) const {
        const int row0 = u.pm * BM + wr * 64 + fr, col0 = u.pn * BM + wc * 32 + 8 * fq;
        const GAS unsigned char* g8 = (const GAS unsigned char*)((const GAS bf16_t*)P + (size_t)row0 * ldp + O_GA) + (col0 - 0);
        const size_t rstep = (size_t)ldp * 2;
        if (u.sub < 2) {
            const GAS unsigned char* rp = g8 + u.sub * 2048;
#pragma unroll
            for (int ai = 0; ai < 2; ++ai) {
                u32x2 ga[4][2], gb[4][2];
#pragma unroll
                for (int m = 0; m < 4; ++m) {
                    const GAS unsigned char* rowp = rp + (size_t)(ai * HALF + m * 16) * rstep;
#pragma unroll
                    for (int bj = 0; bj < 2; ++bj) { ga[m][bj] = *(const GAS u32x2*)(rowp + bj * HALF); gb[m][bj] = *(const GAS u32x2*)(rowp + 2048 + bj * HALF); }
                }
                asm volatile("" ::: "memory");
#pragma unroll
                for (int m = 0; m < 4; ++m)
#pragma unroll
                    for (int bj = 0; bj < 2; ++bj) {
                        const u32x2 a = ga[m][bj], b = gb[m][bj];
                        f32x4 r0, r1;
#pragma unroll
                        for (int i = 0; i < 4; ++i) {
                            r0[i] = ((float)((a.x >> (8 * i)) & 255u) + 0.5f) * frcp((float)((b.x >> (8 * i)) & 255u) + 0.5f);
                            r1[i] = ((float)((a.y >> (8 * i)) & 255u) + 0.5f) * frcp((float)((b.y >> (8 * i)) & 255u) + 0.5f);
                        }
                        acc[ai][bj][m][0] *= r0; acc[ai][bj][m][1] *= r1;
                    }
                asm volatile("" ::: "memory");
            }
        } else {
#pragma unroll
            for (int ai = 0; ai < 2; ++ai)
#pragma unroll
                for (int m = 0; m < 4; ++m) {
                    const size_t r = (size_t)(row0 + ai * HALF + m * 16);
#pragma unroll
                    for (int bj = 0; bj < 2; ++bj) {
                        const u32x2 c = *(const GAS u32x2*)(g8 + (size_t)(ai * HALF + m * 16) * rstep + 4096 + bj * HALF);
                        const f32x4 v0 = acc[ai][bj][m][0], v1 = acc[ai][bj][m][1];
                        float s0[4], s1[4];
#pragma unroll
                        for (int i = 0; i < 4; ++i) { s0[i] = ((float)((c.x >> (8 * i)) & 255u) + 0.5f) * (1.0f / 256.0f); s1[i] = ((float)((c.y >> (8 * i)) & 255u) + 0.5f) * (1.0f / 256.0f); }
                        u32x4 w; w.x = cvt_pk_bf16(v0[0] * s0[0], v0[1] * s0[1]); w.y = cvt_pk_bf16(v0[2] * s0[2], v0[3] * s0[3]);
                        w.z = cvt_pk_bf16(v1[0] * s1[0], v1[1] * s1[1]); w.w = cvt_pk_bf16(v1[2] * s1[2], v1[3] * s1[3]);
                        *(GAS u32x4*)(O + r * ldc + col0 + bj * HALF) = w;
                    }
                    if (m & 1) asm volatile("" ::: "memory");
                }
        }
    }
};

template <class Epi, class Sched, bool ALIGN_EPI = false, bool SP2 = false, bool SUBK = false, bool I8 = false>
__device__ __forceinline__ void gemm_phase(PG8_LAS unsigned char* lds, const Gemm g, const Sched S, const Epi E, int wave) {
    const int wid = wave, lane = lane_id(), tid = wid * 64 + lane, wr = wid >> 2, wc = wid & 3, fr = lane & 15, fq = lane >> 4;
    const int K = g.K, nt = K / BK;
#define PG8_KOFF(u) (SUBK ? ((u).sub == 0 ? 0 : ((u).sub == 1 ? 2048 : 3072)) : 0)
#define PG8_NT(u) (SUBK ? ((u).sub == 0 ? 16 : 8) : nt)
    unsigned voffA[2], voffB[2];
#pragma unroll
    for (int i = 0; i < 2; ++i) { int R, C; stage_rc(tid * 16 + i * 8192, R, C); const int Rb = Epi::PERM ? ((R & ~31) + perm32(R & 31)) : R;
        voffA[i] = (unsigned)(R * g.lda + C) * 2u; voffB[i] = (unsigned)(Rb * g.ldb + C) * 2u; }
    const size_t kstep = (size_t)(BK * 2);
    const size_t hstepA = (size_t)HALF * g.lda * 2, hstepB = (size_t)HALF * g.ldb * 2;
    const size_t tstepA = 2 * hstepA, tstepB = 2 * hstepB;
    const unsigned ldsw = (unsigned)wid * 1024u;
    const int aoff = lds_byte(wr * 64 + fr, fq * 8), boff = lds_byte(wc * 32 + fr, fq * 8);
#define PG8_SA(b, h) (((b) * 2 + (h)) * HTB)
#define PG8_SB(b, h) ((4 + (b) * 2 + (h)) * HTB)
#define PG8_STAGE(bufoff, gbase, voff) do { _Pragma("unroll") for (int _i = 0; _i < 2; ++_i) \
        __builtin_amdgcn_global_load_lds((const unsigned*)((const char*)(gbase) + (voff)[_i]), (PG8_LAS unsigned*)(lds + (bufoff) + ldsw + _i * 8192), 16, 0, 0); } while (0)
#define PG8_LDA(dst, b, h) do { _Pragma("unroll") for (int m = 0; m < 4; ++m) _Pragma("unroll") for (int k = 0; k < 2; ++k) dst[m][k] = *(const PG8_LAS bf16x8*)(lds + PG8_SA(b, h) + aoff + m * 2048 + k * 1024); } while (0)
#define PG8_LDB(dst, b, h) do { _Pragma("unroll") for (int n = 0; n < 2; ++n) _Pragma("unroll") for (int k = 0; k < 2; ++k) dst[n][k] = *(const PG8_LAS bf16x8*)(lds + PG8_SB(b, h) + boff + n * 2048 + k * 1024); } while (0)
#define PG8_MMA(ai, bj, At, Bt) do { __builtin_amdgcn_s_setprio(1); _Pragma("unroll") for (int m = 0; m < 4; ++m) _Pragma("unroll") for (int n = 0; n < 2; ++n) _Pragma("unroll") for (int k = 0; k < 2; ++k) \
        { if constexpr (I8) acc[ai][bj][m][n] = __builtin_bit_cast(f32x4, __builtin_amdgcn_mfma_i32_16x16x64_i8(__builtin_bit_cast(i32x4, Bt[n][k]), __builtin_bit_cast(i32x4, At[m][k]), __builtin_bit_cast(i32x4, acc[ai][bj][m][n]), 0, 0, 0)); \
          else acc[ai][bj][m][n] = __builtin_amdgcn_mfma_f32_16x16x32_bf16(Bt[n][k], At[m][k], acc[ai][bj][m][n], 0, 0, 0); } __builtin_amdgcn_s_setprio(0); } while (0)
#define PG8_WAIT_V(n) asm volatile("s_waitcnt vmcnt(" #n ")" ::: "memory")
#define PG8_WAIT_L(n) asm volatile("s_waitcnt lgkmcnt(" #n ")" ::: "memory")
#define PG8_BAR __builtin_amdgcn_s_barrier()
#define PG8_SCHED __builtin_amdgcn_sched_barrier(0)
    Unit cur, nxt; int ui = 0;
    if (!S.next(0, cur)) return;
    f32x4 acc[2][2][4][2];
#pragma unroll
    for (int a = 0; a < 2; ++a)
#pragma unroll
        for (int b = 0; b < 2; ++b)
#pragma unroll
            for (int m = 0; m < 4; ++m)
#pragma unroll
                for (int n = 0; n < 2; ++n) acc[a][b][m][n] = (f32x4){0.f, 0.f, 0.f, 0.f};
    bf16x8 At[4][2], B0[2][2], B1[2][2];
    const char* cA = (const char*)g.A + (size_t)cur.pm * tstepA + PG8_KOFF(cur); const char* cB = (const char*)g.Bt + (size_t)cur.pn * tstepB + PG8_KOFF(cur);
    S.a_ready(cur);
    if constexpr (SP2) {
        PG8_STAGE(PG8_SB(0, 0), cB, voffB); PG8_STAGE(PG8_SB(0, 1), cB + hstepB, voffB); PG8_STAGE(PG8_SA(0, 0), cA, voffA); PG8_STAGE(PG8_SA(0, 1), cA + hstepA, voffA);
        if (wr == 1) PG8_BAR;
        PG8_WAIT_V(2); PG8_BAR;
        PG8_STAGE(PG8_SB(1, 0), cB + kstep, voffB); PG8_STAGE(PG8_SA(1, 0), cA + kstep, voffA); PG8_STAGE(PG8_SB(1, 1), cB + hstepB + kstep, voffB);
        PG8_WAIT_V(6); PG8_BAR;
    } else {
        PG8_STAGE(PG8_SB(0, 0), cB, voffB); PG8_STAGE(PG8_SA(0, 0), cA, voffA); PG8_STAGE(PG8_SB(0, 1), cB + hstepB, voffB); PG8_STAGE(PG8_SA(0, 1), cA + hstepA, voffA);
        if (wr == 1) PG8_BAR;
        PG8_WAIT_V(4); PG8_BAR;
        PG8_STAGE(PG8_SB(1, 0), cB + kstep, voffB); PG8_STAGE(PG8_SA(1, 0), cA + kstep, voffA); PG8_STAGE(PG8_SB(1, 1), cB + hstepB + kstep, voffB);
        PG8_WAIT_V(6); PG8_BAR;
    }
    for (;;) {
        const bool has_next = S.next(ui + 1, nxt);
        const char* nA = has_next ? (const char*)g.A + (size_t)nxt.pm * tstepA + PG8_KOFF(nxt) : cA; const char* nB = has_next ? (const char*)g.Bt + (size_t)nxt.pn * tstepB + PG8_KOFF(nxt) : cB;
        const int ntc = PG8_NT(cur);
        for (int t = 0; t < ntc; t += 2) {
            const bool last = (t == ntc - 2);
            const char* a1 = cA + (size_t)(t + 1) * kstep;
            const char* a2 = last ? nA : cA + (size_t)(t + 2) * kstep; const char* b2 = last ? nB : cB + (size_t)(t + 2) * kstep;
            const char* a3 = a2 + kstep; const char* b3 = b2 + kstep;
            if (last && has_next) S.a_ready(nxt);
            if constexpr (SP2) {
            PG8_LDB(B0, 0, 0); PG8_LDB(B1, 0, 1); PG8_SCHED; PG8_LDA(At, 0, 0); PG8_STAGE(PG8_SA(1, 1), a1 + hstepA, voffA);
            PG8_WAIT_V(8); PG8_WAIT_L(0); PG8_BAR; PG8_MMA(0, 0, At, B0); PG8_MMA(0, 1, At, B1); PG8_BAR; PG8_SCHED;
            PG8_LDA(At, 0, 1); PG8_STAGE(PG8_SB(0, 0), b2, voffB); PG8_STAGE(PG8_SB(0, 1), b2 + hstepB, voffB); PG8_STAGE(PG8_SA(0, 0), a2, voffA);
            PG8_WAIT_V(8); PG8_WAIT_L(0); PG8_BAR; PG8_MMA(1, 0, At, B0); PG8_MMA(1, 1, At, B1); PG8_BAR; PG8_SCHED;
            PG8_LDB(B0, 1, 0); PG8_LDB(B1, 1, 1); PG8_SCHED; PG8_LDA(At, 1, 0); PG8_STAGE(PG8_SA(0, 1), a2 + hstepA, voffA);
            PG8_WAIT_V(8); PG8_WAIT_L(0); PG8_BAR; PG8_MMA(0, 0, At, B0); PG8_MMA(0, 1, At, B1); PG8_BAR; PG8_SCHED;
            PG8_LDA(At, 1, 1); PG8_STAGE(PG8_SB(1, 0), b3, voffB); PG8_STAGE(PG8_SB(1, 1), b3 + hstepB, voffB); PG8_STAGE(PG8_SA(1, 0), a3, voffA);
            PG8_WAIT_V(8); PG8_WAIT_L(0); PG8_BAR; PG8_MMA(1, 0, At, B0); PG8_MMA(1, 1, At, B1); PG8_BAR; PG8_SCHED;
            } else {
            PG8_LDB(B0, 0, 0); PG8_SCHED; PG8_LDA(At, 0, 0); PG8_STAGE(PG8_SA(1, 1), a1 + hstepA, voffA);
            PG8_WAIT_L(8); PG8_BAR; PG8_WAIT_L(0); PG8_MMA(0, 0, At, B0); PG8_BAR; PG8_SCHED;
            PG8_LDB(B1, 0, 1); PG8_STAGE(PG8_SB(0, 0), b2, voffB);
            PG8_BAR; PG8_WAIT_L(0); PG8_MMA(0, 1, At, B1); PG8_BAR;
            PG8_LDA(At, 0, 1); PG8_STAGE(PG8_SA(0, 0), a2, voffA);
            PG8_BAR; PG8_WAIT_L(0); PG8_MMA(1, 0, At, B0); PG8_BAR; PG8_SCHED;
            PG8_STAGE(PG8_SB(0, 1), b2 + hstepB, voffB);
            PG8_WAIT_V(6); PG8_BAR; PG8_MMA(1, 1, At, B1); PG8_BAR;
            PG8_LDB(B0, 1, 0); PG8_SCHED; PG8_LDA(At, 1, 0); PG8_STAGE(PG8_SA(0, 1), a2 + hstepA, voffA);
            PG8_WAIT_L(8); PG8_BAR; PG8_WAIT_L(0); PG8_MMA(0, 0, At, B0); PG8_BAR; PG8_SCHED;
            PG8_LDB(B1, 1, 1); PG8_STAGE(PG8_SB(1, 0), b3, voffB);
            PG8_BAR; PG8_WAIT_L(0); PG8_MMA(0, 1, At, B1); PG8_BAR;
            PG8_LDA(At, 1, 1); PG8_STAGE(PG8_SA(1, 0), a3, voffA);
            PG8_BAR; PG8_WAIT_L(0); PG8_MMA(1, 0, At, B0); PG8_BAR; PG8_SCHED;
            PG8_STAGE(PG8_SB(1, 1), b3 + hstepB, voffB);
            PG8_WAIT_V(6); PG8_BAR; PG8_MMA(1, 1, At, B1); PG8_BAR;
            }
        }
        if constexpr (ALIGN_EPI) { if (wr == 0) PG8_BAR; }
        E(acc, cur, ui, wr, wc, fr, fq); S.done(cur);
        if (!has_next) break;
        if (!SUBK || nxt.sub == 0) {
#pragma unroll
        for (int a = 0; a < 2; ++a)
#pragma unroll
            for (int b = 0; b < 2; ++b)
#pragma unroll
                for (int m = 0; m < 4; ++m)
#pragma unroll
                    for (int n = 0; n < 2; ++n) acc[a][b][m][n] = (f32x4){0.f, 0.f, 0.f, 0.f};
        }
        cur = nxt; cA = nA; cB = nB; ++ui;
        if constexpr (ALIGN_EPI) { if (wr == 1) PG8_BAR; }
    }
    PG8_WAIT_V(0);
    if constexpr (!ALIGN_EPI) { if (wr == 0) PG8_BAR; }
    PG8_BAR;
#undef PG8_KOFF
#undef PG8_NT
#undef PG8_SA
#undef PG8_SB
#undef PG8_STAGE
#undef PG8_LDA
#undef PG8_LDB
#undef PG8_MMA
#undef PG8_WAIT_V
#undef PG8_WAIT_L
#undef PG8_BAR
#undef PG8_SCHED
}
}

#define XB_TMO      128
#define XB_XCNT(j)  (256  + 64 * (j))
#define XB_XSUB(j)  (1280 + 64 * (j))
#define XB_XGEN(j)  (2304 + 64 * (j))
#define XB_TOP      3328
#define XB_TOPGEN   3392
#define XCD_BAR_WORDS 3456
#define XB_SPIN_CAP (1u << 24)
__device__ __forceinline__ unsigned xb_ld(unsigned* p)              { return __hip_atomic_load(p, __ATOMIC_RELAXED, __HIP_MEMORY_SCOPE_AGENT); }
__device__ __forceinline__ unsigned xb_add(unsigned* p, unsigned v) { return __hip_atomic_fetch_add(p, v, __ATOMIC_RELAXED, __HIP_MEMORY_SCOPE_AGENT); }
__device__ __forceinline__ unsigned xb_xcc_id() { return (unsigned)__builtin_amdgcn_s_getreg((3 << 11) | 20) & 0xFu; }
#define XB_SPIN(cond, bar) do { unsigned _sp = 0; while (cond) { __builtin_amdgcn_s_sleep(1); \
    if ((++_sp & 255u) == 0u) { if (xb_ld(&(bar)[XB_TMO])) break; if (_sp > XB_SPIN_CAP) { atomicAdd(&(bar)[XB_TMO], 1u); break; } } } } while (0)
struct XcdBarrier { unsigned* bar; unsigned x; volatile LAS unsigned* st; };
__device__ __forceinline__ XcdBarrier xcd_barrier_post(unsigned* bar, volatile LAS unsigned* st, bool t0) {
    XcdBarrier b; b.bar = bar; b.x = xb_xcc_id(); b.st = st;
    if (t0) (void)xb_add(&bar[XB_XCNT(b.x)], 1u);
    return b;
}
__device__ __forceinline__ void xcd_barrier_complete(unsigned* bar, unsigned x, unsigned& nloc, unsigned& nx) {
    const unsigned G = gridDim.x * gridDim.y * gridDim.z;
    unsigned sum, cnt, mine, sp = 0u;
    for (;;) {
        sum = 0u; cnt = 0u; mine = 0u;
#pragma unroll
        for (unsigned j = 0; j < 16; ++j) { const unsigned c = xb_ld(&bar[XB_XCNT(j)]); sum += c; cnt += (c > 0u) ? 1u : 0u; mine = (j == x) ? c : mine; }
        if (sum == G) break;
        __builtin_amdgcn_s_sleep(1);
        if ((++sp & 255u) == 0u) { if (xb_ld(&bar[XB_TMO])) break; if (sp > XB_SPIN_CAP) { atomicAdd(&bar[XB_TMO], 1u); break; } }
    }
    nloc = mine > 0u ? mine : 1u; nx = cnt > 0u ? cnt : 1u;
}
__device__ __forceinline__ void xcd_barrier(const XcdBarrier& b, bool t0) {
    asm volatile("s_waitcnt vmcnt(0)" ::: "memory");
    __syncthreads();
    if (t0) {
        unsigned* bar = b.bar;
        __builtin_amdgcn_s_waitcnt(0);
        unsigned nloc = b.st[0], nx = b.st[1];
        if (nloc == 0u) { xcd_barrier_complete(bar, b.x, nloc, nx); b.st[0] = nloc; b.st[1] = nx; }
        const unsigned old = xb_add(&bar[XB_XSUB(b.x)], 1u);
        const unsigned gen = old / nloc;
        if (old + 1u == (gen + 1u) * nloc) {
            __builtin_amdgcn_fence(__ATOMIC_RELEASE, "agent");
            asm volatile("s_waitcnt vmcnt(0)" ::: "memory");
            const unsigned og = xb_add(&bar[XB_TOP], 1u);
            const unsigned tg = og / nx;
            if (og + 1u == (tg + 1u) * nx) xb_add(&bar[XB_TOPGEN], 1u);
            else XB_SPIN(xb_ld(&bar[XB_TOPGEN]) == tg, bar);
            __builtin_amdgcn_fence(__ATOMIC_ACQUIRE, "agent");
            xb_add(&bar[XB_XGEN(b.x)], 1u);
            asm volatile("s_waitcnt vmcnt(0)" ::: "memory");
        } else {
            XB_SPIN(xb_ld(&bar[XB_XGEN(b.x)]) == gen, bar);
            __builtin_amdgcn_fence(__ATOMIC_ACQUIRE, "agent");
            asm volatile("s_waitcnt vmcnt(0)" ::: "memory");
        }
    }
    __syncthreads();
}

struct Args {
    const float* in[22]; float* out; unsigned char* ws;
    int l_lo, l_hi, s_lo, s_hi, ph_lo, ph_hi, do_pro, do_fin, use_bar, pad;
};
struct Frame {
    LAS unsigned char* lds;
    int wave, G, gw, NGW;
};
enum { I_XP = 0, I_XS, I_F1N, I_F1G, I_F1U, I_F1D, I_MN, I_WIN, I_SINK, I_T5, I_NAB, I_LBL, I_HN, I_WA, I_WB, I_WC, I_WO, I_F2N, I_F2G, I_F2U, I_F2D, I_FN };

__device__ __forceinline__ void tr_item(const float* W, int K, int N, bf16* WT, int ld, int koff, int rowmode, LAS float* scr, int item, int lane, const float* gain) {
    const int nblk = N / 32, kb = item / nblk, nb = item % nblk, k0 = 64 * kb, n0 = 32 * nb;
#pragma unroll 8
    for (int i = 0; i < 32; ++i) { const int kk = 2 * i + (lane >> 5); scr[kk * 33 + (lane & 31)] = W[(size_t)(k0 + kk) * N + n0 + (lane & 31)]; }
    LDS_WAIT(); asm volatile("" ::: "memory");
    const int c = lane & 7;
    f32x4 g0 = (f32x4){1.f, 1.f, 1.f, 1.f}, g1 = g0;
    if (gain) { g0 = *(const GAS f32x4*)(gain + k0 + 8 * c); g1 = *(const GAS f32x4*)(gain + k0 + 8 * c + 4); }
#pragma unroll
    for (int j = 0; j < 4; ++j) { const int n = (lane >> 3) + 8 * j; const LAS float* s = scr + (8 * c) * 33 + n;
        v4u o; o.x = pk2(s[0 * 33] * g0[0], s[1 * 33] * g0[1]); o.y = pk2(s[2 * 33] * g0[2], s[3 * 33] * g0[3]); o.z = pk2(s[4 * 33] * g1[0], s[5 * 33] * g1[1]); o.w = pk2(s[6 * 33] * g1[2], s[7 * 33] * g1[3]);
        const int nn = n0 + n; const int drow = rowmode == 0 ? nn : ((nn >> 7) * 256 + (nn & 127) + (rowmode == 2 ? 128 : 0));
        *(GAS v4u*)(WT + (size_t)drow * ld + koff + k0 + 8 * c) = o; }
    LDS_WAIT(); asm volatile("" ::: "memory");
}
__device__ __forceinline__ void tr_matrix(Frame& F, const float* W, int K, int N, bf16* WT, int ld, int koff, int rowmode, const float* gain = nullptr) {
    LAS float* scr = (LAS float*)(F.lds + RING_OFF + F.wave * 16384);
    const int nitems = (K / 64) * (N / 32);
    const int lane = lane_id();
    for (int it = F.gw; it < nitems; it += F.NGW) tr_item(W, K, N, WT, ld, koff, rowmode, scr, it, lane, gain);
}
__device__ __forceinline__ int t5_bucket(int rel) {
    const int n = rel < 0 ? -rel : rel; int b = rel > 0 ? 16 : 0;
    if (n < 8) return b + n;
    int lg = 2 + (31 - __builtin_clz((unsigned)(n * n)));
    if (lg > 15) lg = 15;
    return b + lg;
}
__device__ __forceinline__ void prologue(Frame& F, const __attribute__((address_space(4))) Args* ap) {
    bf16* W = (bf16*)(ap->ws + WS_W);
    for (int l = 0; l < NLAYER; ++l) {
        bf16* Wl = W + (size_t)l * E_LAYER;
        bf16* const T1 = (bf16*)(ap->ws + WS_PROJ) + (size_t)(2 * l) * E_WGU; bf16* const T2 = T1 + E_WGU;
        tr_matrix(F, ap->in[I_F1G] + (size_t)l * DM * DFF, DM, DFF, T1, DM, 0, 1, ap->in[I_F1N] + l * DM);
        tr_matrix(F, ap->in[I_F1U] + (size_t)l * DM * DFF, DM, DFF, T1, DM, 0, 2, ap->in[I_F1N] + l * DM);
        tr_matrix(F, ap->in[I_F1D] + (size_t)l * DFF * DM, DFF, DM, Wl + EO_WD1, DFF, 0, 0);
        tr_matrix(F, ap->in[I_WIN] + (size_t)l * DM * PW, DM, PW, Wl + EO_WIN, DM, 0, 0, ap->in[I_MN] + l * DM);
        tr_matrix(F, ap->in[I_WA] + (size_t)l * 1024 * DM, 1024, DM, Wl + EO_WBR, DM, 0, 0);
        tr_matrix(F, ap->in[I_WB] + (size_t)l * 512 * DM, 512, DM, Wl + EO_WBR, DM, 1024, 0);
        tr_matrix(F, ap->in[I_WC] + (size_t)l * 512 * DM, 512, DM, Wl + EO_WBR, DM, 1536, 0);
        tr_matrix(F, ap->in[I_WO] + (size_t)l * DM * DM, DM, DM, Wl + EO_WOUT, DM, 0, 0);
        tr_matrix(F, ap->in[I_F2G] + (size_t)l * DM * DFF, DM, DFF, T2, DM, 0, 1, ap->in[I_F2N] + l * DM);
        tr_matrix(F, ap->in[I_F2U] + (size_t)l * DM * DFF, DM, DFF, T2, DM, 0, 2, ap->in[I_F2N] + l * DM);
        tr_matrix(F, ap->in[I_F2D] + (size_t)l * DFF * DM, DFF, DM, Wl + EO_WD2, DFF, 0, 0);
    }
    float* tab = (float*)(ap->ws + WS_TAB);
    const int gt = blockIdx.x * 512 + F.wave * 64 + lane_id(), NT = F.G * 512;
    for (int i = gt; i < 8 * 260; i += NT) { const int h = i / 260, j = i % 260; tab[TAB_T5 + i] = j <= 256 ? ap->in[I_T5][t5_bucket(j - 128) * 8 + h] * LOG2E : -1e30f; }
    for (int i = gt; i < 2 * 512; i += NT) {
        const int dir = i / 512, c = i % 512; const float* lg = ap->in[I_LBL] + (size_t)dir * NLAYER * 512 + c;
        float mx = lg[0]; for (int l = 1; l < NLAYER; ++l) mx = fmaxf(mx, lg[l * 512]);
        float e[NLAYER], s = 0.f; for (int l = 0; l < NLAYER; ++l) { e[l] = expf(lg[l * 512] - mx); s += e[l]; }
        float cum = 0.f; for (int l = 0; l < NLAYER; ++l) { cum += e[l] / s; tab[TAB_LB + (dir * NLAYER + l) * 512 + c] = cum - e[0] / s; }
    }
}
__device__ __forceinline__ void quant_rows(Frame& F, const bf16* src, unsigned char* dst, float* scl, int nrows) {
    const int lane = lane_id();
    for (int r0 = F.gw; r0 < nrows; r0 += 4 * F.NGW) {
        pg8::u32x4 v[4][4];
#pragma unroll
        for (int u = 0; u < 4; ++u) { const int r = r0 + u * F.NGW;
            if (r < nrows) { const GAS pg8::u32x4* p = (const GAS pg8::u32x4*)(src + (size_t)r * 2048) + lane * 4;
#pragma unroll
                for (int j = 0; j < 4; ++j) v[u][j] = p[j]; } }
        asm volatile("" ::: "memory");
#pragma unroll
        for (int u = 0; u < 4; ++u) { const int r = r0 + u * F.NGW;
            if (r < nrows) {
                float mx = 0.f;
#pragma unroll
                for (int j = 0; j < 4; ++j)
#pragma unroll
                    for (int e = 0; e < 4; ++e) mx = fmaxf(mx, fmaxf(fabsf(bflo(v[u][j][e])), fabsf(bfhi(v[u][j][e]))));
#pragma unroll
                for (int o = 32; o > 0; o >>= 1) mx = fmaxf(mx, __shfl_xor(mx, o));
                const float sc = mx > 0.f ? mx * (1.0f / 127.0f) : 1.0f, inv = 1.0f / sc;
                pg8::u32x4 w[2];
#pragma unroll
                for (int j = 0; j < 4; ++j)
#pragma unroll
                    for (int h = 0; h < 2; ++h) {
                        const unsigned a = v[u][j][2 * h], b = v[u][j][2 * h + 1];
                        const int q0 = (int)rintf(bflo(a) * inv), q1 = (int)rintf(bfhi(a) * inv), q2 = (int)rintf(bflo(b) * inv), q3 = (int)rintf(bfhi(b) * inv);
                        w[j >> 1][(j & 1) * 2 + h] = (unsigned)(q0 & 255) | ((unsigned)(q1 & 255) << 8) | ((unsigned)(q2 & 255) << 16) | ((unsigned)(q3 & 255) << 24);
                    }
                GAS pg8::u32x4* d = (GAS pg8::u32x4*)(dst + (size_t)r * 2048) + lane * 2;
                d[0] = w[0]; d[1] = w[1];
                if (lane == 0) scl[r] = sc;
            } }
    }
}
__device__ __forceinline__ void quant_gate_weights(Frame& F, const __attribute__((address_space(4))) Args* ap) {
    for (int l = 0; l < NLAYER; ++l) {
        unsigned char* wq = ap->ws + WS_WQ + (size_t)l * WQ_LAYER;
        quant_rows(F, (const bf16*)(ap->ws + WS_W) + (size_t)l * E_LAYER + EO_WIN + (size_t)O_GA * DM, wq, (float*)(wq + WQ_SCALE), 3 * DM);
        for (int j = 0; j < 2; ++j) { unsigned char* d = (unsigned char*)((bf16*)(ap->ws + WS_W) + (size_t)l * E_LAYER + (j ? EO_WGU2 : EO_WGU1));
            quant_rows(F, (const bf16*)(ap->ws + WS_PROJ) + (size_t)(2 * l + j) * E_WGU, d, (float*)(d + WGUQ_SCALE), 2 * DFF); }
    }
}
template <bool OUT_F32> __device__ __forceinline__ void norm_rows(Frame& F, const float* x, const float* gain, void* out, int M) {
    const int lane = lane_id();
    const GAS f32x4* gr = (const GAS f32x4*)gain + lane;
    for (int m = F.gw; m < M; m += F.NGW) {
        const GAS f32x4* xr = (const GAS f32x4*)(x + (size_t)m * DM) + lane;
        f32x4 v[8]; float s = 0.f;
#pragma unroll
        for (int j = 0; j < 8; ++j) { v[j] = xr[64 * j]; s += (v[j].x * v[j].x + v[j].y * v[j].y) + (v[j].z * v[j].z + v[j].w * v[j].w); }
        const float rstd = 1.0f / sqrtf(wave_sum(s) * (1.0f / DM) + EPS);
#pragma unroll
        for (int j = 0; j < 8; ++j) { const f32x4 g = gr[64 * j]; const f32x4 o = v[j] * rstd * g;
            if (OUT_F32) ((GAS f32x4*)((float*)out + (size_t)m * DM) + lane)[64 * j] = o;
            else { v2u w; w.x = pk2(o.x, o.y); w.y = pk2(o.z, o.w); ((GAS v2u*)((bf16*)out + (size_t)m * DM) + lane)[64 * j] = w; } }
    }
}

__device__ __forceinline__ void cast_rows(Frame& F, const float* x, bf16* xb, float* ssq, int M) {
    const int lane = lane_id();
    for (int m = F.gw; m < M; m += F.NGW) {
        const GAS f32x4* xr = (const GAS f32x4*)(x + (size_t)m * DM) + lane; float s = 0.f;
#pragma unroll
        for (int j = 0; j < 8; ++j) { const f32x4 v = xr[64 * j]; s += (v.x * v.x + v.y * v.y) + (v.z * v.z + v.w * v.w);
            v2u w; w.x = pk2(v.x, v.y); w.y = pk2(v.z, v.w); ((GAS v2u*)(xb + (size_t)m * DM) + lane)[64 * j] = w; }
        s = wave_sum(s);
        if (lane < 32) ssq[(size_t)m * 32 + lane] = lane == 0 ? s : 0.f;
    }
}
__device__ __forceinline__ void final_rows(Frame& F, const bf16* xb, const float* gain, float* out, int M) {
    const int lane = lane_id();
    const GAS f32x4* gr = (const GAS f32x4*)gain;
    for (int m = F.gw; m < M; m += F.NGW) {
        const GAS v4u* xr = (const GAS v4u*)(xb + (size_t)m * DM) + lane;
        float v[4][8]; float s = 0.f;
#pragma unroll
        for (int j = 0; j < 4; ++j) { v8(xr[64 * j], v[j]);
#pragma unroll
            for (int k = 0; k < 8; ++k) s += v[j][k] * v[j][k]; }
        const float rstd = 1.0f / sqrtf(wave_sum(s) * (1.0f / DM) + EPS);
#pragma unroll
        for (int j = 0; j < 4; ++j) { const f32x4 g0 = gr[2 * (64 * j + lane)], g1 = gr[2 * (64 * j + lane) + 1];
            GAS f32x4* o = (GAS f32x4*)(out + (size_t)m * DM) + 2 * (64 * j + lane);
            o[0] = (f32x4){v[j][0] * rstd * g0[0], v[j][1] * rstd * g0[1], v[j][2] * rstd * g0[2], v[j][3] * rstd * g0[3]};
            o[1] = (f32x4){v[j][4] * rstd * g1[0], v[j][5] * rstd * g1[1], v[j][6] * rstd * g1[2], v[j][7] * rstd * g1[3]}; }
    }
}
__device__ __forceinline__ void mixA_naive(Frame& F, const bf16* P, bf16* Y, const float* tab, const float* sink, int Ts) {
    LAS float* ql = (LAS float*)(F.lds + RING_OFF + 65536 + F.wave * 2048);
    LAS float* pl = ql + 128;
    const int lane = lane_id();
    for (int it = F.gw; it < MS * 8; it += F.NGW) {
        const int row = it >> 3, h = it & 7, kvh = h >> 2, t = row & (Ts - 1), rb = row - t;
        { const unsigned w = *(const GAS unsigned*)(P + (size_t)row * PW + O_AQ + h * 128 + 2 * lane); ql[2 * lane] = bflo(w); ql[2 * lane + 1] = bfhi(w); }
        LDS_WAIT(); asm volatile("" ::: "memory");
        float sc[5]; float mx = sink[h] * LOG2E;
#pragma unroll
        for (int p = 0; p < 5; ++p) {
            const int j = lane + 64 * p, kpos = t + j - 128; float s = -1e30f;
            if (j <= 256 && kpos >= 0 && kpos < Ts) {
                const GAS v4u* kr = (const GAS v4u*)(P + (size_t)(rb + kpos) * PW + O_AK + kvh * 128); float a = 0.f;
#pragma unroll 4
                for (int d8 = 0; d8 < 16; ++d8) { const v4u w = kr[d8]; const LAS float* q = ql + d8 * 8;
                    a += q[0] * bflo(w.x) + q[1] * bfhi(w.x) + q[2] * bflo(w.y) + q[3] * bfhi(w.y) + q[4] * bflo(w.z) + q[5] * bfhi(w.z) + q[6] * bflo(w.w) + q[7] * bfhi(w.w); }
                s = a + tab[TAB_T5 + h * 260 + j];
            }
            sc[p] = s; mx = fmaxf(mx, s);
        }
        mx = wave_max(mx);
        float sum = 0.f;
#pragma unroll
        for (int p = 0; p < 5; ++p) { const float e = fexp2(sc[p] - mx); pl[lane + 64 * p] = e; sum += e; }
        sum = wave_sum(sum) + fexp2(sink[h] * LOG2E - mx);
        LDS_WAIT(); asm volatile("" ::: "memory");
        float o0 = 0.f, o1 = 0.f;
        const int jlo = t >= 128 ? 0 : 128 - t, jhi = (t + 128 < Ts) ? 256 : (Ts - 1 - t + 128);
        for (int j = jlo; j <= jhi; ++j) { const float pj = pl[j]; const unsigned w = *(const GAS unsigned*)(P + (size_t)(rb + t + j - 128) * PW + O_AV + kvh * 128 + 2 * lane); o0 += pj * bflo(w); o1 += pj * bfhi(w); }
        const float inv = 1.0f / sum;
        *(GAS unsigned*)(Y + (size_t)row * DM + h * 128 + 2 * lane) = pk2(o0 * inv, o1 * inv);
        LDS_WAIT(); asm volatile("" ::: "memory");
    }
}
__device__ __forceinline__ void mixB_naive(Frame& F, const bf16* P, bf16* Y, const float* nab, int Ts) {
    LAS float* ql = (LAS float*)(F.lds + RING_OFF + 65536 + F.wave * 2048);
    LAS float* pl = ql + 128;
    const int lane = lane_id(), rows = Ts >> 6;
    for (int it = F.gw; it < MS * 4; it += F.NGW) {
        const int row = it >> 2, h = it & 3, t = row & (Ts - 1), rb = row - t, r = t >> 6, c = t & 63;
        int rs = r - 4; rs = rs < 0 ? 0 : (rs > rows - 8 ? rows - 8 : rs);
        int cs = c - 8; cs = cs < 0 ? 0 : (cs > 48 ? 48 : cs);
        { const unsigned w = *(const GAS unsigned*)(P + (size_t)row * PW + O_BQ + h * 128 + 2 * lane); ql[2 * lane] = bflo(w); ql[2 * lane + 1] = bfhi(w); }
        LDS_WAIT(); asm volatile("" ::: "memory");
        float sc[2]; float mx = -1e30f;
#pragma unroll
        for (int p = 0; p < 2; ++p) {
            const int i = lane + 64 * p, kr_ = rs + (i >> 4), kc = cs + (i & 15);
            const GAS v4u* kr = (const GAS v4u*)(P + (size_t)(rb + kr_ * 64 + kc) * PW + O_BK + h * 128); float a = 0.f;
#pragma unroll 4
            for (int d8 = 0; d8 < 16; ++d8) { const v4u w = kr[d8]; const LAS float* q = ql + d8 * 8;
                a += q[0] * bflo(w.x) + q[1] * bfhi(w.x) + q[2] * bflo(w.y) + q[3] * bfhi(w.y) + q[4] * bflo(w.z) + q[5] * bfhi(w.z) + q[6] * bflo(w.w) + q[7] * bfhi(w.w); }
            int dc = kc - c; dc = dc < -15 ? -15 : (dc > 15 ? 15 : dc);
            sc[p] = a + nab[(h * 15 + (kr_ - r + 7)) * 31 + dc + 15] * LOG2E; mx = fmaxf(mx, sc[p]);
        }
        mx = wave_max(mx);
        float sum = 0.f;
#pragma unroll
        for (int p = 0; p < 2; ++p) { const float e = fexp2(sc[p] - mx); pl[lane + 64 * p] = e; sum += e; }
        sum = wave_sum(sum);
        LDS_WAIT(); asm volatile("" ::: "memory");
        float o0 = 0.f, o1 = 0.f;
        for (int i = 0; i < 128; ++i) { const float pj = pl[i]; const unsigned w = *(const GAS unsigned*)(P + (size_t)(rb + (rs + (i >> 4)) * 64 + cs + (i & 15)) * PW + O_BV + h * 128 + 2 * lane); o0 += pj * bflo(w); o1 += pj * bfhi(w); }
        const float inv = 1.0f / sum;
        *(GAS unsigned*)(Y + (size_t)row * DM + 1024 + h * 128 + 2 * lane) = pk2(o0 * inv, o1 * inv);
        LDS_WAIT(); asm volatile("" ::: "memory");
    }
}
typedef float f32x16 __attribute__((ext_vector_type(16)));
typedef short s16x4 __attribute__((ext_vector_type(4)));
#define KSWZ(row, colB) ((row) * 256 + ((colB) ^ (((row) & 7) << 4)))
__device__ __forceinline__ int crow(int r, int hi) { return (r & 3) + 8 * (r >> 2) + 4 * hi; }
__device__ __forceinline__ int v_st(int k, int c) { const int kk = (k & ~0xC) | ((k & 4) << 1) | ((k & 8) >> 1); return ((kk >> 3) * 4 + (c >> 5)) * 512 + ((kk & 7) * 32 + (c & 31)) * 2; }
__device__ __forceinline__ int v_rd_base(int lane) { return ((lane & 3) << 3) | (((lane >> 2) & 3) << 6) | (((lane >> 4) & 1) << 5) | (((lane >> 5) & 1) << 8); }
constexpr int v_rd_off(int d0, int ks, int half) { return d0 * 512 + ks * 4096 + half * 2048; }
template <int OFF> __device__ __forceinline__ s16x4 tr_read(int vb) { s16x4 r; asm volatile("ds_read_b64_tr_b16 %0, %1 offset:%2" : "=&v"(r) : "v"(vb), "i"(OFF) : "memory"); return r; }
template <int D0> __device__ __forceinline__ void pv_one(f32x16& od, int vb, bf16x8 pa0, bf16x8 pa1, bf16x8 pa2, bf16x8 pa3) {
    const s16x4 l0 = tr_read<v_rd_off(D0, 0, 0)>(vb), h0 = tr_read<v_rd_off(D0, 0, 1)>(vb), l1 = tr_read<v_rd_off(D0, 1, 0)>(vb), h1 = tr_read<v_rd_off(D0, 1, 1)>(vb);
    const s16x4 l2 = tr_read<v_rd_off(D0, 2, 0)>(vb), h2 = tr_read<v_rd_off(D0, 2, 1)>(vb), l3 = tr_read<v_rd_off(D0, 3, 0)>(vb), h3 = tr_read<v_rd_off(D0, 3, 1)>(vb);
    asm volatile("s_waitcnt lgkmcnt(0)" ::: "memory"); __builtin_amdgcn_sched_barrier(0);
#define PKV(L, H) (bf16x8){L[0], L[1], L[2], L[3], H[0], H[1], H[2], H[3]}
    od = __builtin_amdgcn_mfma_f32_32x32x16_bf16(pa0, PKV(l0, h0), od, 0, 0, 0);
    od = __builtin_amdgcn_mfma_f32_32x32x16_bf16(pa1, PKV(l1, h1), od, 0, 0, 0);
    od = __builtin_amdgcn_mfma_f32_32x32x16_bf16(pa2, PKV(l2, h2), od, 0, 0, 0);
    od = __builtin_amdgcn_mfma_f32_32x32x16_bf16(pa3, PKV(l3, h3), od, 0, 0, 0);
#undef PKV
}
constexpr int AT_K = 0, AT_V = 32768, AT_TAB = 65536, AT_WS = 65536 + 8192, AT_KV = 16384;
__device__ __forceinline__ void attn_tile_update(f32x16& p0, f32x16& p1, f32x16 (&o)[4], float& m_reg, float& l_reg, int vb, LAS float* al_l, int r32, int hi) {
    float pmax = p0[0];
#pragma unroll
    for (int r = 1; r < 16; ++r) pmax = fmaxf(pmax, p0[r]);
#pragma unroll
    for (int r = 0; r < 16; ++r) pmax = fmaxf(pmax, p1[r]);
    pmax = fmaxf(pmax, __shfl_xor(pmax, 32));
    const float mn = fmaxf(m_reg, pmax), alpha = fexp2(m_reg - mn);
    m_reg = mn;
    if (__any(alpha < 1.f)) {
        if (hi == 0) al_l[r32] = alpha;
        asm volatile("s_waitcnt lgkmcnt(0)" ::: "memory");
#pragma unroll
        for (int r = 0; r < 16; ++r) { const float a = al_l[crow(r, hi)];
#pragma unroll
            for (int d = 0; d < 4; ++d) o[d][r] *= a; }
        asm volatile("s_waitcnt lgkmcnt(0)" ::: "memory");
    }
    float ps = 0.f;
#pragma unroll
    for (int r = 0; r < 16; ++r) { p0[r] = fexp2(p0[r] - mn); p1[r] = fexp2(p1[r] - mn); ps += p0[r] + p1[r]; }
    ps += __shfl_xor(ps, 32);
    l_reg = l_reg * alpha + ps;
    bf16x8 pa0, pa1, pa2, pa3;
#define PK4(P, BASE, OUT) do { const unsigned a0 = pg8::cvt_pk_bf16(P[BASE + 0], P[BASE + 1]), a1 = pg8::cvt_pk_bf16(P[BASE + 2], P[BASE + 3]);   \
    const unsigned b0 = pg8::cvt_pk_bf16(P[BASE + 4], P[BASE + 5]), b1 = pg8::cvt_pk_bf16(P[BASE + 6], P[BASE + 7]);                              \
    auto r0 = __builtin_amdgcn_permlane32_swap(a0, b0, false, false); auto r1 = __builtin_amdgcn_permlane32_swap(a1, b1, false, false); \
    v4u wv = {r0[0], r1[0], r0[1], r1[1]}; OUT = __builtin_bit_cast(bf16x8, wv); } while (0)
    PK4(p0, 0, pa0); PK4(p0, 8, pa1); PK4(p1, 0, pa2); PK4(p1, 8, pa3);
#undef PK4
    pv_one<0>(o[0], vb, pa0, pa1, pa2, pa3); pv_one<1>(o[1], vb, pa0, pa1, pa2, pa3); pv_one<2>(o[2], vb, pa0, pa1, pa2, pa3); pv_one<3>(o[3], vb, pa0, pa1, pa2, pa3);
}
__device__ __forceinline__ void attn_qkt(f32x16& p0, f32x16& p1, const LAS unsigned char* Ks, const bf16x8 (&qr)[8], int r32, int hi) {
    p0 = (f32x16){}; p1 = (f32x16){};
#pragma unroll
    for (int d0 = 0; d0 < 8; ++d0) { const int cb = (d0 * 16 + hi * 8) * 2;
        const bf16x8 b0 = *(const LAS bf16x8*)(Ks + KSWZ(r32, cb)), b1 = *(const LAS bf16x8*)(Ks + KSWZ(32 + r32, cb));
        p0 = __builtin_amdgcn_mfma_f32_32x32x16_bf16(b0, qr[d0], p0, 0, 0, 0);
        p1 = __builtin_amdgcn_mfma_f32_32x32x16_bf16(b1, qr[d0], p1, 0, 0, 0); }
}
struct KVStage { v4u k0, k1, v0, v1; };
__device__ __forceinline__ void kv_load(KVStage& st, const bf16* Kp, const bf16* Vp, int row0, int sr, int sc) {
    st.k0 = *(const GAS v4u*)(Kp + (size_t)(row0 + sr) * PW + sc); st.k1 = *(const GAS v4u*)(Kp + (size_t)(row0 + 32 + sr) * PW + sc);
    st.v0 = *(const GAS v4u*)(Vp + (size_t)(row0 + sr) * PW + sc); st.v1 = *(const GAS v4u*)(Vp + (size_t)(row0 + 32 + sr) * PW + sc);
}
__device__ __forceinline__ void kv_write(const KVStage& st, LAS unsigned char* Kb, LAS unsigned char* Vb, int sr, int sc) {
    *(LAS v4u*)(Kb + KSWZ(sr, sc * 2)) = st.k0; *(LAS v4u*)(Kb + KSWZ(32 + sr, sc * 2)) = st.k1;
    *(LAS v4u*)(Vb + v_st(sr, sc)) = st.v0; *(LAS v4u*)(Vb + v_st(32 + sr, sc)) = st.v1;
}
__device__ __forceinline__ void attn_store(const f32x16 (&o)[4], float l_reg, LAS float* li_l, bf16* Yrow0  , int r32, int hi) {
    if (hi == 0) li_l[r32] = l_reg;
    asm volatile("s_waitcnt lgkmcnt(0)" ::: "memory");
#pragma unroll
    for (int r = 0; r < 16; ++r) { const int orow = crow(r, hi); const float rl = frcp(li_l[orow]);
#pragma unroll
        for (int d0 = 0; d0 < 4; ++d0) ((GAS bf16*)Yrow0)[(unsigned)(orow * DM + d0 * 32 + r32)] = (bf16)f2bf(o[d0][r] * rl); }
    asm volatile("s_waitcnt lgkmcnt(0)" ::: "memory");
}
__device__ __forceinline__ void mixA_mfma(Frame& F, const bf16* P, bf16* Y, const float* tab, const float* sink, int Ts) {
    const int lane = lane_id(), w = F.wave, tid = w * 64 + lane, r32 = lane & 31, hi = lane >> 5, sr = tid >> 4, sc = (tid & 15) * 8;
    LAS unsigned char* const L = F.lds + RING_OFF;
    LAS float* const TB = (LAS float*)(L + AT_TAB);
    LAS float* const wsf = (LAS float*)(L + AT_WS) + w * 64;
    const int nqb = Ts >> 7, nitems = (MS >> 7) * 4;
    for (int item = blockIdx.x; item < nitems; item += F.G) {
        const int hp = item & 1, kvh = (item >> 1) & 1, qblk = item >> 2, n = qblk & (nqb - 1), rb = (qblk - n) << 7;
        const int h = kvh * 4 + hp * 2 + (w >> 2), q0 = 128 * n + 32 * (w & 3);
        __syncthreads();
        for (int e = tid; e < 2 * 448; e += 512) { const int hl = e / 448, idx = e % 448 - 96; TB[e] = (idx >= 0 && idx <= 256) ? tab[TAB_T5 + (kvh * 4 + hp * 2 + hl) * 260 + idx] : -1e30f; }
        bf16x8 qr[8];
        { const bf16* qp = P + (size_t)(rb + q0 + r32) * PW + O_AQ + h * 128 + hi * 8;
#pragma unroll
          for (int d0 = 0; d0 < 8; ++d0) qr[d0] = *(const GAS bf16x8*)(qp + d0 * 16); }
        f32x16 o[4] = {}; float m_reg = sink[h] * LOG2E, l_reg = 1.0f;
        const int kt0 = n == 0 ? 0 : 2 * n - 2, kt1 = (n == nqb - 1) ? 2 * n + 2 : 2 * n + 4;
        const bf16* Kp = P + (size_t)rb * PW + O_AK + kvh * 128; const bf16* Vp = P + (size_t)rb * PW + O_AV + kvh * 128;
        KVStage st0, st1; kv_load(st0, Kp, Vp, 64 * kt0, sr, sc);
        if (kt0 + 1 < kt1) kv_load(st1, Kp, Vp, 64 * (kt0 + 1), sr, sc);
        kv_write(st0, L + AT_K, L + AT_V, sr, sc);
        __syncthreads();
        const LAS float* tbh = TB + (w >> 2) * 448;
#define MIXA_STEP(kt, STN, STW) do { const int b = ((kt) - kt0) & 1; \
            if ((kt) + 2 < kt1) kv_load(STN, Kp, Vp, 64 * ((kt) + 2), sr, sc); \
            const int k0 = 64 * (kt); \
            if (k0 + 63 >= q0 - 128 && k0 <= q0 + 31 + 128) { \
                f32x16 p0, p1; attn_qkt(p0, p1, L + AT_K + b * AT_KV, qr, r32, hi); \
                const LAS float* tl = tbh + (k0 - q0 - r32 + 4 * hi + 224); \
                _Pragma("unroll") for (int r = 0; r < 16; ++r) { p0[r] += tl[(r & 3) + 8 * (r >> 2)]; p1[r] += tl[32 + (r & 3) + 8 * (r >> 2)]; } \
                attn_tile_update(p0, p1, o, m_reg, l_reg, (int)(uintptr_t)(L + AT_V + b * AT_KV) + v_rd_base(lane), wsf, r32, hi); } \
            if ((kt) + 1 < kt1) kv_write(STW, L + AT_K + (b ^ 1) * AT_KV, L + AT_V + (b ^ 1) * AT_KV, sr, sc); \
            __syncthreads(); } while (0)
        for (int kt = kt0; kt < kt1; kt += 2) {
            MIXA_STEP(kt, st0, st1);
            MIXA_STEP(kt + 1, st1, st0);
        }
#undef MIXA_STEP
        { bf16* Yq = Y; asm volatile("" : "+s"(Yq)); attn_store(o, l_reg, wsf, Yq + (size_t)(rb + q0) * DM + h * 128, r32, hi); }
    }
    __syncthreads();
}
__device__ __forceinline__ void mixB_mfma(Frame& F, const bf16* P, bf16* Y, const float* nab, int Ts) {
    const int lane = lane_id(), w = F.wave, tid = w * 64 + lane, r32 = lane & 31, hi = lane >> 5, sr = tid >> 4, sc = (tid & 15) * 8;
    LAS unsigned char* const L = F.lds + RING_OFF;
    LAS float* const TB = (LAS float*)(L + AT_TAB);
    LAS float* const wsf = (LAS float*)(L + AT_WS) + w * 64;
    const int rows = Ts >> 6, ngrp = rows >> 2, nitems = (MS >> 8) * 4;
    for (int item = blockIdx.x; item < nitems; item += F.G) {
        const int h = item & 3, g = item >> 2, gi = g & (ngrp - 1), rb = (g - gi) << 8, r0 = 4 * gi, r = r0 + (w >> 1), c = 32 * (w & 1) + r32;
        __syncthreads();
        for (int e = tid; e < 15 * 128; e += 512) { const int dr = e >> 7, dci = (e & 127) - 48; TB[e] = (dci >= 0 && dci <= 30) ? nab[(h * 15 + dr) * 31 + dci] * LOG2E : -1e30f; }
        bf16x8 qr[8];
        { const bf16* qp = P + (size_t)(rb + r * 64 + c) * PW + O_BQ + h * 128 + hi * 8;
#pragma unroll
          for (int d0 = 0; d0 < 8; ++d0) qr[d0] = *(const GAS bf16x8*)(qp + d0 * 16); }
        f32x16 o[4] = {}; float m_reg = -1e30f, l_reg = 0.0f;
        int rs = r - 4; rs = rs < 0 ? 0 : (rs > rows - 8 ? rows - 8 : rs);
        int t0 = r0 - 4; t0 = t0 < 0 ? 0 : (t0 > rows - 8 ? rows - 8 : t0);
        int t1 = r0 + 3 - 4; t1 = (t1 < 0 ? 0 : (t1 > rows - 8 ? rows - 8 : t1)) + 8;
        int cs = c - 8; cs = cs < 0 ? 0 : (cs > 48 ? 48 : cs);
        const unsigned long long vm = (0xFFFFull << cs) >> (4 * hi);
        const unsigned mlo = (unsigned)vm, mhi = (unsigned)(vm >> 32);
        const bf16* Kp = P + (size_t)rb * PW + O_BK + h * 128; const bf16* Vp = P + (size_t)rb * PW + O_BV + h * 128;
        KVStage st0, st1; kv_load(st0, Kp, Vp, 64 * t0, sr, sc);
        if (t0 + 1 < t1) kv_load(st1, Kp, Vp, 64 * (t0 + 1), sr, sc);
        kv_write(st0, L + AT_K, L + AT_V, sr, sc);
        __syncthreads();
#define MIXB_STEP(kr, STN, STW) do { const int b = ((kr) - t0) & 1; \
            if ((kr) + 2 < t1) kv_load(STN, Kp, Vp, 64 * ((kr) + 2), sr, sc); \
            if ((kr) >= rs && (kr) < rs + 8) { \
                f32x16 p0, p1; attn_qkt(p0, p1, L + AT_K + b * AT_KV, qr, r32, hi); \
                const LAS float* tl = TB + ((kr) - r + 7) * 128 + (4 * hi - c + 63); \
                _Pragma("unroll") for (int q = 0; q < 16; ++q) { const int kc = (q & 3) + 8 * (q >> 2); \
                    p0[q] = ((mlo >> kc) & 1u) ? p0[q] + tl[kc] : -1e30f; p1[q] = ((mhi >> kc) & 1u) ? p1[q] + tl[32 + kc] : -1e30f; } \
                attn_tile_update(p0, p1, o, m_reg, l_reg, (int)(uintptr_t)(L + AT_V + b * AT_KV) + v_rd_base(lane), wsf, r32, hi); } \
            if ((kr) + 1 < t1) kv_write(STW, L + AT_K + (b ^ 1) * AT_KV, L + AT_V + (b ^ 1) * AT_KV, sr, sc); \
            __syncthreads(); } while (0)
        for (int kr = t0; kr < t1; kr += 2) {
            MIXB_STEP(kr, st0, st1);
            if (kr + 1 < t1) MIXB_STEP(kr + 1, st1, st0);
        }
#undef MIXB_STEP
        { bf16* Yq = Y; asm volatile("" : "+s"(Yq)); attn_store(o, l_reg, wsf, Yq + (size_t)(rb + r * 64 + 32 * (w & 1)) * DM + 1024 + h * 128, r32, hi); }
    }
    __syncthreads();
}

typedef float f32x4v __attribute__((ext_vector_type(4)));
constexpr int HG_VS = 288;
constexpr int HG_KL = 272;
constexpr int ST_ITEM = 2 * 128 * 128;
template <int SH> __device__ __forceinline__ float dpp_shr(float v) { return __builtin_bit_cast(float, __builtin_amdgcn_update_dpp(0, __builtin_bit_cast(int, v), 0x110 + SH, 0xf, 0xf, true)); }
template <int SH> __device__ __forceinline__ float dpp_shl(float v) { return __builtin_bit_cast(float, __builtin_amdgcn_update_dpp(0, __builtin_bit_cast(int, v), 0x100 + SH, 0xf, 0xf, true)); }
__device__ __forceinline__ float row_scan(float v, int dir) {
    if (dir == 0) { v += dpp_shr<1>(v); v += dpp_shr<2>(v); v += dpp_shr<4>(v); v += dpp_shr<8>(v); }
    else          { v += dpp_shl<1>(v); v += dpp_shl<2>(v); v += dpp_shl<4>(v); v += dpp_shl<8>(v); }
    return v;
}
__device__ __forceinline__ void ld32bf(const bf16* p, float (&o)[32]) {
#pragma unroll
    for (int m = 0; m < 4; ++m) { const v4u w = *(const GAS v4u*)(p + 8 * m);
        o[8 * m + 0] = bflo(w.x); o[8 * m + 1] = bfhi(w.x); o[8 * m + 2] = bflo(w.y); o[8 * m + 3] = bfhi(w.y); o[8 * m + 4] = bflo(w.z); o[8 * m + 5] = bfhi(w.z); o[8 * m + 6] = bflo(w.w); o[8 * m + 7] = bfhi(w.w); }
}
#define HG_PREP(VS_OFF, TOT_OFF) \
    const int lane = lane_id(), tl = lane & 15, kq = lane >> 4, w = F.wave, dir = w >> 2, i = w & 3, tid = w * 64 + lane; \
    LAS unsigned char* const vs = F.lds + RING_OFF + (VS_OFF); LAS float* const TOT = (LAS float*)(F.lds + RING_OFF + (TOT_OFF));
constexpr int HG_TS = 144;
__device__ __forceinline__ void hg_h1(Frame& F, const bf16* P, bf16* ST, float* DEC) {
    const int lane = lane_id(), tl = lane & 15, kq = lane >> 4, w = F.wave, dir = w >> 2, i = w & 3, tid = w * 64 + lane;
    LAS unsigned char* const KT = F.lds + RING_OFF;
    LAS unsigned char* const VT = F.lds + RING_OFF + 36864;
    LAS float* const TOT = (LAS float*)(F.lds + RING_OFF + 55296);
    for (int item = blockIdx.x; item < MS / 64 * 4; item += F.G) {
        const int chunk = item >> 2, h = item & 3, r0 = chunk * 64;
        __syncthreads();
#pragma unroll
        for (int k2 = 0; k2 < 2; ++k2) { const int idx = tid + 512 * k2, row = idx >> 4, c16 = idx & 15;
            const v4u vv = *(const GAS v4u*)(P + (size_t)(r0 + row) * PW + O_CI + h * 128 + 8 * c16);
            LAS unsigned char* vp = VT + (8 * c16) * HG_TS + 2 * row;
            *(LAS unsigned short*)(vp) = (unsigned short)vv.x; *(LAS unsigned short*)(vp + HG_TS) = (unsigned short)(vv.x >> 16);
            *(LAS unsigned short*)(vp + 2 * HG_TS) = (unsigned short)vv.y; *(LAS unsigned short*)(vp + 3 * HG_TS) = (unsigned short)(vv.y >> 16);
            *(LAS unsigned short*)(vp + 4 * HG_TS) = (unsigned short)vv.z; *(LAS unsigned short*)(vp + 5 * HG_TS) = (unsigned short)(vv.z >> 16);
            *(LAS unsigned short*)(vp + 6 * HG_TS) = (unsigned short)vv.w; *(LAS unsigned short*)(vp + 7 * HG_TS) = (unsigned short)(vv.w >> 16); }
        float g[32];
        ld32bf(P + (size_t)(r0 + 16 * i + tl) * PW + O_CFF + dir * 512 + h * 128 + 32 * kq, g);
        float kl[32];
#pragma unroll
        for (int s = 0; s < 32; ++s) { const float c = row_scan(g[s], dir), rc = row_scan(g[s], 1 - dir) - g[s];
            if (tl == (dir == 0 ? 15 : 0)) TOT[(dir * 4 + i) * 128 + 32 * kq + s] = c;
            kl[s] = (1.0f - fexp2(g[s])) * fexp2(rc); if ((s & 3) == 3) asm volatile("" ::: "memory"); }
        __syncthreads();
#pragma unroll
        for (int s4 = 0; s4 < 8; ++s4) {
            f32x4v tv[4];
#pragma unroll
            for (int m = 0; m < 4; ++m) tv[m] = *(const LAS f32x4v*)(TOT + (dir * 4 + m) * 128 + 32 * kq + 4 * s4);
            f32x4v a = (f32x4v){0.f, 0.f, 0.f, 0.f};
#pragma unroll
            for (int m = 0; m < 4; ++m) if (dir == 0 ? m > i : m < i) a += tv[m];
            LAS unsigned char* kp = KT + (dir * 128 + 32 * kq + 4 * s4) * HG_TS + 2 * (16 * i + tl);
#pragma unroll
            for (int k = 0; k < 4; ++k) *(LAS unsigned short*)(kp + k * HG_TS) = (unsigned short)f2bf(kl[4 * s4 + k] * fexp2(a[k]));
            if (i == 0 && tl == 0) { const f32x4v all = (tv[0] + tv[1]) + (tv[2] + tv[3]);
                *(GAS f32x4v*)(DEC + ((size_t)item * 2 + dir) * 128 + 32 * kq + 4 * s4) = (f32x4v){fexp2(all[0]), fexp2(all[1]), fexp2(all[2]), fexp2(all[3])}; }
            asm volatile("" ::: "memory");
        }
        __syncthreads();
        f32x4v acc[2][8];
#pragma unroll
        for (int a = 0; a < 2; ++a)
#pragma unroll
            for (int T = 0; T < 8; ++T) acc[a][T] = (f32x4v){0.f, 0.f, 0.f, 0.f};
#pragma unroll
        for (int m = 0; m < 2; ++m) {
            const bf16x8 a0 = *(const LAS bf16x8*)(KT + (dir * 128 + 32 * i + tl) * HG_TS + 64 * m + 16 * kq), a1 = *(const LAS bf16x8*)(KT + (dir * 128 + 32 * i + 16 + tl) * HG_TS + 64 * m + 16 * kq);
#pragma unroll
            for (int T = 0; T < 8; ++T) { const bf16x8 bv = *(const LAS bf16x8*)(VT + (16 * T + tl) * HG_TS + 64 * m + 16 * kq);
                acc[0][T] = __builtin_amdgcn_mfma_f32_16x16x32_bf16(a0, bv, acc[0][T], 0, 0, 0); acc[1][T] = __builtin_amdgcn_mfma_f32_16x16x32_bf16(a1, bv, acc[1][T], 0, 0, 0); }
        }
        bf16* sp = ST + (size_t)item * ST_ITEM + (size_t)dir * 16384;
#pragma unroll
        for (int a = 0; a < 2; ++a)
#pragma unroll
            for (int T = 0; T < 8; ++T) { v2u wv; wv.x = pk2(acc[a][T][0], acc[a][T][1]); wv.y = pk2(acc[a][T][2], acc[a][T][3]);
                *(GAS v2u*)(sp + (size_t)(16 * T + tl) * 128 + 32 * i + 16 * a + 4 * kq) = wv; }
    }
    __syncthreads();
}
__device__ __forceinline__ void hg_scan(Frame& F, bf16* ST, const float* DEC, int nseq, int nchunk) {
    const int gt = blockIdx.x * 512 + F.wave * 64 + lane_id(), NT = F.G * 512, total = nseq * 16384;
    for (int idx = gt; idx < total; idx += NT) {
        const int d8 = idx & 15, e = (idx >> 4) & 127, dir = (idx >> 11) & 1, h = (idx >> 12) & 3, sq = idx >> 14;
        float S[8];
#pragma unroll
        for (int k = 0; k < 8; ++k) S[k] = 0.f;
#pragma unroll 8
        for (int st = 0; st < nchunk; ++st) {
            const int c = dir == 0 ? st : nchunk - 1 - st; const size_t it2 = ((size_t)(sq * nchunk + c) * 4 + h) * 2 + dir;
            GAS v4u* p = (GAS v4u*)(ST + it2 * 16384 + (size_t)e * 128 + 8 * d8);
            const v4u dl = *p; const f32x4 dc0 = *(const GAS f32x4*)(DEC + it2 * 128 + 8 * d8), dc1 = *(const GAS f32x4*)(DEC + it2 * 128 + 8 * d8 + 4);
            v4u wv; wv.x = pk2(S[0], S[1]); wv.y = pk2(S[2], S[3]); wv.z = pk2(S[4], S[5]); wv.w = pk2(S[6], S[7]);
            *p = wv;
            float df[8]; v8(dl, df);
            S[0] = S[0] * dc0[0] + df[0]; S[1] = S[1] * dc0[1] + df[1]; S[2] = S[2] * dc0[2] + df[2]; S[3] = S[3] * dc0[3] + df[3];
            S[4] = S[4] * dc1[0] + df[4]; S[5] = S[5] * dc1[1] + df[5]; S[6] = S[6] * dc1[2] + df[6]; S[7] = S[7] * dc1[3] + df[7];
        }
    }
}
__device__ __forceinline__ void hg_h3(Frame& F, const bf16* P, const bf16* ST, bf16* Y, const float* gain) {
    HG_PREP(34816, 53248)
    LAS unsigned char* const KL = F.lds + RING_OFF;
    LAS float* const TR = (LAS float*)(F.lds + RING_OFF + 57344) + w * 320;
    LAS float* const OX = (LAS float*)(F.lds + RING_OFF);
    for (int item = blockIdx.x; item < MS / 64 * 4; item += F.G) {
        const int chunk = item >> 2, h = item & 3, r0 = chunk * 64, row = r0 + 16 * i + tl;
        const bf16* sp = ST + (size_t)item * ST_ITEM + (size_t)dir * 16384 + (size_t)(8 * tl) * 128 + 32 * kq;
        v4u sa[8], sb[8];
#define HG_LDS(buf, m_) do { _Pragma("unroll") for (int T_ = 0; T_ < 8; ++T_) buf[T_] = *(const GAS v4u*)(sp + T_ * 128 + 8 * (m_)); } while (0)
#define HG_MMS(buf, m_) do { v4u aw_; aw_.x = pg8::cvt_pk_bf16(qd[8 * (m_)], qd[8 * (m_) + 1]); aw_.y = pg8::cvt_pk_bf16(qd[8 * (m_) + 2], qd[8 * (m_) + 3]); \
        aw_.z = pg8::cvt_pk_bf16(qd[8 * (m_) + 4], qd[8 * (m_) + 5]); aw_.w = pg8::cvt_pk_bf16(qd[8 * (m_) + 6], qd[8 * (m_) + 7]); const bf16x8 af_ = __builtin_bit_cast(bf16x8, aw_); \
        _Pragma("unroll") for (int T_ = 0; T_ < 8; ++T_) o[T_] = __builtin_amdgcn_mfma_f32_16x16x32_bf16(af_, __builtin_bit_cast(bf16x8, buf[T_]), o[T_], 0, 0, 0); } while (0)
        HG_LDS(sa, 0); HG_LDS(sb, 1);
        __syncthreads();
#pragma unroll
        for (int k2 = 0; k2 < 2; ++k2) { const int idx = tid + 512 * k2, rw = idx >> 4, c16 = idx & 15;
            *(LAS v4u*)(vs + rw * HG_VS + c16 * 16) = *(const GAS v4u*)(P + (size_t)(r0 + rw) * PW + O_CI + h * 128 + 8 * c16); }
        float qd[32]; bf16x8 kdp[4];
        { float g[32];
          ld32bf(P + (size_t)row * PW + O_CFF + dir * 512 + h * 128 + 32 * kq, g);
          ld32bf(P + (size_t)row * PW + O_CQ + h * 128 + 32 * kq, qd);
#pragma unroll
          for (int m = 0; m < 4; ++m) { float kd8[8];
#pragma unroll
              for (int j = 0; j < 8; ++j) { const int s = 8 * m + j;
                  const float c = row_scan(g[s], dir), rc = row_scan(g[s], 1 - dir) - g[s];
                  if (tl == (dir == 0 ? 15 : 0)) TOT[(dir * 4 + i) * 128 + 32 * kq + s] = c;
                  const float k = 1.0f - fexp2(g[s]);
                  g[s] = k * fexp2(rc);
                  qd[s] *= fexp2(c); kd8[j] = k * fexp2(fminf(-c, 120.0f)); }
              v4u wv; wv.x = pg8::cvt_pk_bf16(g[8 * m], g[8 * m + 1]); wv.y = pg8::cvt_pk_bf16(g[8 * m + 2], g[8 * m + 3]); wv.z = pg8::cvt_pk_bf16(g[8 * m + 4], g[8 * m + 5]); wv.w = pg8::cvt_pk_bf16(g[8 * m + 6], g[8 * m + 7]);
              *(LAS v4u*)(KL + (dir * 64 + 16 * i + tl) * HG_KL + (32 * kq + 8 * m) * 2) = wv;
              v4u kv; kv.x = pg8::cvt_pk_bf16(kd8[0], kd8[1]); kv.y = pg8::cvt_pk_bf16(kd8[2], kd8[3]); kv.z = pg8::cvt_pk_bf16(kd8[4], kd8[5]); kv.w = pg8::cvt_pk_bf16(kd8[6], kd8[7]);
              kdp[m] = __builtin_bit_cast(bf16x8, kv);
              asm volatile("" ::: "memory"); } }
        __syncthreads();
        f32x4v o[8];
#pragma unroll
        for (int T = 0; T < 8; ++T) o[T] = (f32x4v){0.f, 0.f, 0.f, 0.f};
#define HG_PACK8(x, m_) __builtin_bit_cast(bf16x8, (v4u){pg8::cvt_pk_bf16(x[8 * (m_)], x[8 * (m_) + 1]), pg8::cvt_pk_bf16(x[8 * (m_) + 2], x[8 * (m_) + 3]), pg8::cvt_pk_bf16(x[8 * (m_) + 4], x[8 * (m_) + 5]), pg8::cvt_pk_bf16(x[8 * (m_) + 6], x[8 * (m_) + 7])})
        { f32x4v a4 = (f32x4v){0.f, 0.f, 0.f, 0.f};
#pragma unroll
          for (int m = 0; m < 4; ++m) a4 = __builtin_amdgcn_mfma_f32_16x16x32_bf16(HG_PACK8(qd, m), kdp[m], a4, 0, 0, 0);
#pragma unroll
          for (int r = 0; r < 4; ++r) { const int t = 4 * kq + r; const bool keep = dir == 0 ? (tl <= t) : (tl >= t); TR[t * 20 + tl] = keep ? a4[r] : 0.f; }
          LDS_WAIT(); asm volatile("" ::: "memory");
#pragma unroll
          for (int m = 0; m < 4; ++m) { const float a = TR[tl * 20 + 4 * m + kq]; float vf[8]; v8(*(const LAS v4u*)(vs + (16 * i + 4 * m + kq) * HG_VS + tl * 16), vf);
#pragma unroll
              for (int T = 0; T < 8; ++T) o[T] = __builtin_amdgcn_mfma_f32_16x16x4f32(a, vf[T], o[T], 0, 0, 0); }
          LDS_WAIT(); asm volatile("" ::: "memory"); }
        const int nblk = dir == 0 ? i : 3 - i;
        for (int jj = 1; jj <= nblk; ++jj) {
            const int j = dir == 0 ? i - jj : i + jj;
            if (jj >= 2) { const LAS float* tp = TOT + (dir * 4 + (dir == 0 ? j + 1 : j - 1)) * 128 + 32 * kq;
#pragma unroll
                for (int s4 = 0; s4 < 8; ++s4) { const f32x4v t4 = *(const LAS f32x4v*)(tp + 4 * s4); qd[4 * s4] *= fexp2(t4[0]); qd[4 * s4 + 1] *= fexp2(t4[1]); qd[4 * s4 + 2] *= fexp2(t4[2]); qd[4 * s4 + 3] *= fexp2(t4[3]); } }
            f32x4v a4 = (f32x4v){0.f, 0.f, 0.f, 0.f};
            { const LAS unsigned char* kp = KL + (dir * 64 + 16 * j + tl) * HG_KL + 64 * kq;
#pragma unroll
              for (int m = 0; m < 4; ++m) a4 = __builtin_amdgcn_mfma_f32_16x16x32_bf16(HG_PACK8(qd, m), *(const LAS bf16x8*)(kp + 16 * m), a4, 0, 0, 0); }
#pragma unroll
            for (int r = 0; r < 4; ++r) TR[(4 * kq + r) * 20 + tl] = a4[r];
            LDS_WAIT(); asm volatile("" ::: "memory");
#pragma unroll
            for (int m = 0; m < 4; ++m) { const float a = TR[tl * 20 + 4 * m + kq]; float vf[8]; v8(*(const LAS v4u*)(vs + (16 * j + 4 * m + kq) * HG_VS + tl * 16), vf);
#pragma unroll
                for (int T = 0; T < 8; ++T) o[T] = __builtin_amdgcn_mfma_f32_16x16x4f32(a, vf[T], o[T], 0, 0, 0); }
            LDS_WAIT(); asm volatile("" ::: "memory");
        }
        if (nblk >= 1) { const LAS float* tp = TOT + (dir * 4 + (dir == 0 ? 0 : 3)) * 128 + 32 * kq;
#pragma unroll
            for (int s4 = 0; s4 < 8; ++s4) { const f32x4v t4 = *(const LAS f32x4v*)(tp + 4 * s4); qd[4 * s4] *= fexp2(t4[0]); qd[4 * s4 + 1] *= fexp2(t4[1]); qd[4 * s4 + 2] *= fexp2(t4[2]); qd[4 * s4 + 3] *= fexp2(t4[3]); } }
        HG_MMS(sa, 0); HG_LDS(sa, 2); HG_MMS(sb, 1); HG_LDS(sb, 3); HG_MMS(sa, 2); HG_MMS(sb, 3);
#undef HG_LDS
#undef HG_MMS
#undef HG_PACK8
        __syncthreads();
        if (dir == 1) {
#pragma unroll
            for (int r = 0; r < 4; ++r) { LAS float* q = OX + (i * 16 + 4 * kq + r) * 128 + 8 * tl;
                *(LAS f32x4v*)q = (f32x4v){o[0][r], o[1][r], o[2][r], o[3][r]}; *(LAS f32x4v*)(q + 4) = (f32x4v){o[4][r], o[5][r], o[6][r], o[7][r]}; } }
        __syncthreads();
        if (dir == 0) {
            const f32x4v g0 = *(const GAS f32x4v*)(gain + h * 128 + 8 * tl), g1 = *(const GAS f32x4v*)(gain + h * 128 + 8 * tl + 4);
#pragma unroll
            for (int r = 0; r < 4; ++r) { const LAS float* q = OX + (i * 16 + 4 * kq + r) * 128 + 8 * tl;
                const f32x4v x0 = *(const LAS f32x4v*)q, x1 = *(const LAS f32x4v*)(q + 4);
                float v[8] = {o[0][r] + x0[0], o[1][r] + x0[1], o[2][r] + x0[2], o[3][r] + x0[3], o[4][r] + x1[0], o[5][r] + x1[1], o[6][r] + x1[2], o[7][r] + x1[3]};
                float ss = 0.f;
#pragma unroll
                for (int T = 0; T < 8; ++T) ss += v[T] * v[T];
                ss += __shfl_xor(ss, 1); ss += __shfl_xor(ss, 2); ss += __shfl_xor(ss, 4); ss += __shfl_xor(ss, 8);
                const float rstd = 1.0f / sqrtf(ss * (1.0f / 128.0f) + EPS);
                const size_t orow = (size_t)(r0 + 16 * i + 4 * kq + r);
                float sg[8]; v8(*(const GAS v4u*)(P + orow * PW + O_CG + h * 128 + 8 * tl), sg);
                v4u wv; wv.x = pk2(v[0] * rstd * g0[0] * sg[0], v[1] * rstd * g0[1] * sg[1]); wv.y = pk2(v[2] * rstd * g0[2] * sg[2], v[3] * rstd * g0[3] * sg[3]);
                wv.z = pk2(v[4] * rstd * g1[0] * sg[4], v[5] * rstd * g1[1] * sg[5]); wv.w = pk2(v[6] * rstd * g1[2] * sg[6], v[7] * rstd * g1[3] * sg[7]);
                *(GAS v4u*)(Y + orow * DM + 1536 + h * 128 + 8 * tl) = wv; }
        }
    }
    __syncthreads();
}

constexpr int RS_OFF = MISC_OFF + 128;
static_assert(RS_OFF + 13 * 256 * 4 <= LDS_BYTES, "rstd table");
template <class Sched> __device__ __forceinline__ void rstd_prepass(Frame& F, const Sched& S, const float* ssq, int ubase = 0, const float* rowscale = nullptr) {
    const int lane = lane_id(), tid = F.wave * 64 + lane, row = tid >> 1, half = tid & 1;
    LAS float* RS = (LAS float*)(F.lds + RS_OFF) + ubase * 256;
    pg8::Unit u;
    for (int i = 0; S.next(i, u); ++i) {
        const float* p = ssq + (size_t)(u.pm * 256 + row) * 32 + 16 * half;
        const f32x4 a = *(const GAS f32x4*)p, b = *(const GAS f32x4*)(p + 4), c = *(const GAS f32x4*)(p + 8), d = *(const GAS f32x4*)(p + 12);
        float s = (((a[0] + a[1]) + (a[2] + a[3])) + ((b[0] + b[1]) + (b[2] + b[3]))) + (((c[0] + c[1]) + (c[2] + c[3])) + ((d[0] + d[1]) + (d[2] + d[3])));
        s += __shfl_xor(s, 1);
        if (half == 0) RS[i * 256 + row] = (1.0f / sqrtf(s * (1.0f / 2048.0f) + EPS)) * (rowscale ? rowscale[u.pm * 256 + row] : 1.0f);
    }
    __syncthreads();
}
constexpr int NPH = 12;
typedef const __attribute__((address_space(4))) Args* ArgP;
__device__ __forceinline__ ArgP argp() { ArgP p = (ArgP)__builtin_amdgcn_kernarg_segment_ptr(); asm volatile("" : "+s"(p)); return p; }
#define PH_BEGIN const ArgP A = argp(); const int lq = opq_s(l), sq = opq_s(s); unsigned char* const ws = A->ws; \
    const bf16* const Wl = (const bf16*)(ws + WS_W) + (size_t)lq * E_LAYER; float* const xs = A->out + (size_t)sq * MS * DM; \
    bf16* const XN = (bf16*)(ws + WS_XN); bf16* const PROJ = (bf16*)(ws + WS_PROJ); bf16* const ACT = (bf16*)(ws + WS_PROJ); bf16* const Y = (bf16*)(ws + WS_Y); \
    float* const OC = (float*)(ws + WS_OC); const float* const tab = (const float*)(ws + WS_TAB); const int Ts = sq == 0 ? 8192 : 2048; \
    bf16* const MG = (bf16*)(ws + WS_MG); float* const SSQ = (float*)(ws + WS_SSQ); \
    (void)Wl; (void)xs; (void)XN; (void)PROJ; (void)ACT; (void)Y; (void)OC; (void)tab; (void)Ts; (void)MG; (void)SSQ;
__global__ void __launch_bounds__(512, 2) fwd(Args args_unused) {
    extern __shared__ __attribute__((aligned(16))) unsigned char lds[];
    Frame F;
    F.lds = (LAS unsigned char*)lds;
    F.wave = __builtin_amdgcn_readfirstlane(threadIdx.x >> 6);
    F.G = gridDim.x; F.gw = blockIdx.x * 8 + F.wave; F.NGW = F.G * 8;
    volatile LAS unsigned* MISC = (volatile LAS unsigned*)(F.lds + MISC_OFF);
    for (int u = F.wave * 64 + lane_id(); u < (LDS_BYTES - LDSCTL_OFF) / 4; u += 512) ((LAS unsigned*)(F.lds + LDSCTL_OFF))[u] = 0u;
    __syncthreads();
    const ArgP A0 = argp();
    const int use_bar = A0->use_bar;
    XcdBarrier bar; bar.bar = (unsigned*)(A0->ws + WS_CTL) + CW_BAR; bar.x = 0; bar.st = nullptr;
    if (use_bar) bar = xcd_barrier_post((unsigned*)(A0->ws + WS_CTL) + CW_BAR, MISC + 8, F.wave == 0 && lane_id() == 0);
#define GRID_BAR() do { if (opq_s(use_bar)) xcd_barrier(bar, F.wave == 0 && lane_id() == 0); } while (0)
    LAS unsigned char* ring = F.lds + RING_OFF;

    if (A0->do_pro) { prologue(F, A0); GRID_BAR(); quant_gate_weights(F, A0); GRID_BAR(); }

    const int plo = A0->ph_lo, phi = A0->ph_hi, l_lo = A0->l_lo, l_hi = A0->l_hi, s_hi = A0->s_hi;
#define IN(k) (opq_s(plo) <= (k) && (k) < opq_s(phi))
    for (int s = A0->s_lo; s < s_hi; ++s) {
        for (int l = l_lo; l < l_hi; ++l) {
            if (IN(0)) { PH_BEGIN if (lq == 0) { const float* xin = sq == 0 ? A->in[I_XP] : A->in[I_XS] + (size_t)(sq - 1) * MS * DM; cast_rows(F, xin, XN, SSQ, MS); GRID_BAR(); } }
            if (IN(1)) { PH_BEGIN
                if (lq == 0) { quant_rows(F, XN, ws + WS_OC, (float*)(ws + WS_OC + XQ_SCALE), MS); GRID_BAR(); }
                const unsigned char* wq = (const unsigned char*)(Wl + EO_WGU1);
                pg8::Gemm g{(const pg8::bf16_t*)(ws + WS_OC), (const pg8::bf16_t*)wq, MS, 2 * DFF, DM / 2, DM / 2, DM / 2}; pg8::StaticOrder S; S.init(MS, 2 * DFF, F.G, (int)blockIdx.x);
                rstd_prepass(F, S, SSQ, 0, (const float*)(ws + WS_OC + XQ_SCALE)); pg8::EpiSwiGLUQ E{ACT, DFF, (const float*)(wq + WGUQ_SCALE), (const LAS float*)(F.lds + RS_OFF)};
                pg8::gemm_phase<pg8::EpiSwiGLUQ, pg8::StaticOrder, true, true, false, true>(ring, g, S, E, F.wave); GRID_BAR(); }
            if (IN(2)) { PH_BEGIN pg8::Gemm g{ACT, Wl + EO_WD1, MS, DM, DFF, DFF, DFF}; pg8::StaticOrder S; S.init(MS, DM, F.G, (int)blockIdx.x);
                if (F.wave == 0 && lane_id() == 0) MISC[11] += 1u; __syncthreads(); const unsigned ptgt = 8u * (unsigned)__builtin_amdgcn_readfirstlane((int)MISC[11]);
                pg8::EpiResid E{XN, DM, 0.5f, SSQ, (unsigned*)(ws + WS_CTL), ptgt, ws + WS_OC, (float*)(ws + WS_OC + XQ_SCALE), (LAS unsigned*)(F.lds + RS_OFF)}; pg8::gemm_phase<pg8::EpiResid, pg8::StaticOrder, true, true>(ring, g, S, E, F.wave); GRID_BAR(); }
            if (IN(3)) {
                { PH_BEGIN
                  pg8::Gemm g{XN, Wl + EO_WIN, MS, O_GA, DM, DM, DM}; pg8::StaticOrder S; S.init(MS, O_GA, F.G, (int)blockIdx.x);
                  rstd_prepass(F, S, SSQ); pg8::EpiProj E{PROJ, PW, tab + TAB_LB + (0 * NLAYER + lq) * 512, tab + TAB_LB + (1 * NLAYER + lq) * 512, (const LAS float*)(F.lds + RS_OFF)};
                  pg8::gemm_phase<pg8::EpiProj, pg8::StaticOrder, true, true>(ring, g, S, E, F.wave); }
                { PH_BEGIN
                  const unsigned char* wq = ws + WS_WQ + (size_t)lq * WQ_LAYER;
                  pg8::Gemm g{(const pg8::bf16_t*)(ws + WS_OC), (const pg8::bf16_t*)wq, MS, 3 * DM, DM / 2, DM / 2, DM / 2}; pg8::GateOrder S; S.init(MS, 3 * DM, F.G, (int)blockIdx.x);
                  rstd_prepass(F, S, SSQ, 6, (const float*)(ws + WS_OC + XQ_SCALE));
                  pg8::EpiGateQ E{(unsigned char*)(PROJ + O_GA), PW * 2, (const float*)(wq + WQ_SCALE), (const LAS float*)(F.lds + RS_OFF) + 6 * 256};
                  pg8::gemm_phase<pg8::EpiGateQ, pg8::GateOrder, true, true, false, true>(ring, g, S, E, F.wave); }
                GRID_BAR(); }
            if (IN(4)) { PH_BEGIN
                for (int st = 0; st < 3; ++st) {
                    const int which = __builtin_amdgcn_readfirstlane((st + (int)(blockIdx.x & 1u)) % 3);
                    if (which == 0) hg_h1(F, PROJ, (bf16*)OC, (float*)(ws + WS_MG));
                    else if (which == 1) mixA_mfma(F, PROJ, Y, tab, A->in[I_SINK] + lq * 8, Ts);
                    else mixB_mfma(F, PROJ, Y, A->in[I_NAB] + (size_t)lq * 4 * 15 * 31, Ts);
                }
                GRID_BAR(); }
            if (IN(5)) { PH_BEGIN hg_scan(F, (bf16*)OC, (const float*)(ws + WS_MG), MS / Ts, Ts / 64); GRID_BAR(); }
            if (IN(6)) { PH_BEGIN hg_h3(F, PROJ, (const bf16*)OC, Y, A->in[I_HN] + lq * 512); GRID_BAR(); }
            if (IN(7)) { PH_BEGIN pg8::SubOrder S; S.init(MS, DM, F.G, (int)blockIdx.x);
                pg8::Gemm g{Y, Wl + EO_WBR, MS, DM, DM, DM, DM}; pg8::EpiMerged E{PROJ, PW, MG, DM};
                pg8::gemm_phase<pg8::EpiMerged, pg8::SubOrder, true, true, true>(ring, g, S, E, F.wave); GRID_BAR(); }
            if (IN(8)) { PH_BEGIN pg8::Gemm g{MG, Wl + EO_WOUT, MS, DM, DM, DM, DM}; pg8::StaticOrder S; S.init(MS, DM, F.G, (int)blockIdx.x);
                if (F.wave == 0 && lane_id() == 0) MISC[11] += 1u; __syncthreads(); const unsigned ptgt = 8u * (unsigned)__builtin_amdgcn_readfirstlane((int)MISC[11]);
                pg8::EpiResid E{XN, DM, 1.0f, SSQ, (unsigned*)(ws + WS_CTL), ptgt, ws + WS_OC, (float*)(ws + WS_OC + XQ_SCALE), (LAS unsigned*)(F.lds + RS_OFF)}; pg8::gemm_phase<pg8::EpiResid, pg8::StaticOrder, true, true>(ring, g, S, E, F.wave); GRID_BAR(); }
            if (IN(9)) { PH_BEGIN
                const unsigned char* wq = (const unsigned char*)(Wl + EO_WGU2);
                pg8::Gemm g{(const pg8::bf16_t*)(ws + WS_OC), (const pg8::bf16_t*)wq, MS, 2 * DFF, DM / 2, DM / 2, DM / 2}; pg8::StaticOrder S; S.init(MS, 2 * DFF, F.G, (int)blockIdx.x);
                rstd_prepass(F, S, SSQ, 0, (const float*)(ws + WS_OC + XQ_SCALE)); pg8::EpiSwiGLUQ E{ACT, DFF, (const float*)(wq + WGUQ_SCALE), (const LAS float*)(F.lds + RS_OFF)};
                pg8::gemm_phase<pg8::EpiSwiGLUQ, pg8::StaticOrder, true, true, false, true>(ring, g, S, E, F.wave); GRID_BAR(); }
            if (IN(10)) { PH_BEGIN pg8::Gemm g{ACT, Wl + EO_WD2, MS, DM, DFF, DFF, DFF}; pg8::StaticOrder S; S.init(MS, DM, F.G, (int)blockIdx.x);
                if (F.wave == 0 && lane_id() == 0) MISC[11] += 1u; __syncthreads(); const unsigned ptgt = 8u * (unsigned)__builtin_amdgcn_readfirstlane((int)MISC[11]);
                pg8::EpiResid E{XN, DM, 0.5f, SSQ, (unsigned*)(ws + WS_CTL), ptgt, ws + WS_OC, (float*)(ws + WS_OC + XQ_SCALE), (LAS unsigned*)(F.lds + RS_OFF)}; pg8::gemm_phase<pg8::EpiResid, pg8::StaticOrder, true, true>(ring, g, S, E, F.wave); GRID_BAR(); }
            if (IN(11)) { PH_BEGIN if (lq == NLAYER - 1) { final_rows(F, XN, A->in[I_FN], xs, MS); GRID_BAR(); } }
        }
    }
#undef IN
}

extern "C" void kernel_launch(void* const* d_in, const int* in_sizes, int n_in, void* d_out, int out_size, void* d_ws, size_t ws_size, hipStream_t stream) {
    static int grid = 0;
    if (grid == 0) {
        if (n_in != 22 || out_size != MTOT * DM || ws_size < WS_END) { fprintf(stderr, "kernel_launch: unexpected shapes (n_in %d out %d ws %zu, need ws >= %zu)\n", n_in, out_size, ws_size, (size_t)WS_END); grid = -1; return; }
        int dev = 0, cus = 0, per_cu = 0;
        if (hipGetDevice(&dev) != hipSuccess || hipDeviceGetAttribute(&cus, hipDeviceAttributeMultiprocessorCount, dev) != hipSuccess) { grid = -1; return; }
        if (hipFuncSetAttribute((const void*)fwd, hipFuncAttributeMaxDynamicSharedMemorySize, LDS_BYTES) != hipSuccess) { fprintf(stderr, "kernel_launch: hipFuncSetAttribute failed\n"); grid = -1; return; }
        if (hipOccupancyMaxActiveBlocksPerMultiprocessor(&per_cu, (const void*)fwd, 512, LDS_BYTES) != hipSuccess || per_cu < 1) fprintf(stderr, "kernel_launch: occupancy query reports %d\n", per_cu);
        (void)hipGetLastError();
        grid = cus;
    }
    if (grid < 0) return;
    (void)hipMemsetAsync((char*)d_ws + WS_CTL, 0, CTL_ZERO_BYTES, stream);
    Args a{};
    for (int i = 0; i < 22; ++i) a.in[i] = (const float*)d_in[i];
    a.out = (float*)d_out; a.ws = (unsigned char*)d_ws;
#if MK_ONE_LAUNCH
    a.l_lo = 0; a.l_hi = NLAYER; a.s_lo = 0; a.s_hi = NSLICE; a.ph_lo = 0; a.ph_hi = NPH; a.do_pro = 1; a.do_fin = 1; a.use_bar = 1;
    hipLaunchKernelGGL(fwd, dim3(grid), dim3(512), LDS_BYTES, stream, a);
#else
    a.use_bar = 0;
    a.do_pro = 1; a.do_fin = 0; a.l_lo = a.l_hi = 0; a.s_lo = a.s_hi = 0; a.ph_lo = a.ph_hi = 0;
    hipLaunchKernelGGL(fwd, dim3(grid), dim3(512), LDS_BYTES, stream, a);
    a.do_pro = 0;
    for (int s = 0; s < NSLICE; ++s) for (int l = 0; l < NLAYER; ++l) for (int p = 0; p < NPH; ++p) {
        a.l_lo = l; a.l_hi = l + 1; a.s_lo = s; a.s_hi = s + 1; a.ph_lo = p; a.ph_hi = p + 1;
        hipLaunchKernelGGL(fwd, dim3(grid), dim3(512), LDS_BYTES, stream, a);
    }
    a.do_fin = 1; a.l_lo = a.l_hi = 0; a.s_lo = a.s_hi = 0; a.ph_lo = a.ph_hi = 0;
    hipLaunchKernelGGL(fwd, dim3(grid), dim3(512), LDS_BYTES, stream, a);
#endif
    const hipError_t le = hipPeekAtLastError();
    if (le != hipSuccess) fprintf(stderr, "kernel_launch: launch failed: %s\n", hipGetErrorName(le));
}
```

```cpp
#include <hip/hip_runtime.h>
#include <cstdio>
#include <cstdint>

#ifndef MK_ONE_LAUNCH
#define MK_ONE_LAUNCH 1
#endif

#define GAS __attribute__((address_space(1)))
#define LAS __attribute__((address_space(3)))
typedef unsigned short bf16;
typedef unsigned v4u __attribute__((ext_vector_type(4)));
typedef unsigned v2u __attribute__((ext_vector_type(2)));
typedef float f32x4 __attribute__((ext_vector_type(4)));
typedef float f32x2 __attribute__((ext_vector_type(2)));
typedef short bf16x8 __attribute__((ext_vector_type(8)));
typedef GAS unsigned gu32;

constexpr int DM = 2048, DFF = 5632, PW = 11776, NLAYER = 4;
constexpr int MS = 16384, NSLICE = 3, MTOT = 49152;
constexpr float EPS = 1e-6f;
constexpr float LOG2E = 1.4426950408889634f, LN2 = 0.6931471805599453f;
constexpr float QSCALE = 0.08838834764831845f * LOG2E;
constexpr float CQSCALE = 0.08838834764831845f;
constexpr int O_AQ = 0, O_AK = 1024, O_AV = 1280, O_BQ = 1536, O_BK = 2048, O_BV = 2560, O_CFF = 3072, O_CFB = 3584, O_CI = 4096, O_CQ = 4608, O_CG = 5120, O_GA = 5632, O_GB = 7680, O_GC = 9728;

constexpr size_t MiB = 1u << 20;
constexpr size_t WS_CTL = 0, CTL_ZERO_BYTES = 1 * MiB;
constexpr size_t WS_TAB = 1 * MiB;
constexpr size_t WS_W = 2 * MiB;
constexpr size_t E_WGU = (size_t)2 * DFF * DM, E_WD = (size_t)DM * DFF, E_WIN = (size_t)PW * DM, E_WBR = (size_t)DM * DM, E_WOUT = (size_t)DM * DM;
constexpr size_t EO_WGU1 = 0, EO_WD1 = EO_WGU1 + E_WGU, EO_WIN = EO_WD1 + E_WD, EO_WBR = EO_WIN + E_WIN, EO_WOUT = EO_WBR + E_WBR, EO_WGU2 = EO_WOUT + E_WOUT, EO_WD2 = EO_WGU2 + E_WGU, E_LAYER = EO_WD2 + E_WD;
static_assert(E_LAYER * 2 == 194 * MiB, "weights per layer");
constexpr size_t WS_XN = WS_W + 4 * 194 * MiB;
constexpr size_t WS_PROJ = WS_XN + 64 * MiB;
constexpr size_t WS_Y = WS_PROJ + 368 * MiB;
constexpr size_t WS_OC = WS_Y + 64 * MiB;
constexpr size_t WS_MG = WS_OC + 128 * MiB;
constexpr size_t WS_SSQ = WS_MG + 64 * MiB;
constexpr size_t WS_WQ = WS_SSQ + 2 * MiB;
constexpr size_t WQ_LAYER = 13 * MiB, WQ_SCALE = 12 * MiB;
constexpr size_t WS_END = WS_WQ + 4 * WQ_LAYER;
constexpr size_t XQ_SCALE = 32 * MiB;
constexpr size_t WGUQ_SCALE = 22 * MiB;
static_assert(8 * E_WGU * 2 <= 368 * MiB && (size_t)2 * DFF * DM <= WGUQ_SCALE, "gate|up temporaries / int8 slot");
constexpr int CW_RMAX = 65536;
constexpr int CW_PCNT = 2048;
constexpr int CW_QCNT = 1024;
constexpr int TAB_T5 = 0, TAB_LB = 8 * 260;
constexpr int CW_TMO = 0, CW_CODE = 1, CW_BAR = 4096;

constexpr int RING_OFF = 0, RING_BYTES = 131072;
constexpr int LDSCTL_OFF = RING_BYTES, MISC_OFF = LDSCTL_OFF + 320;
constexpr int LDS_BYTES = 147456;

#define LDS_WAIT() asm volatile("s_waitcnt lgkmcnt(0)" ::: "memory")
#define VM_WAIT() asm volatile("s_waitcnt vmcnt(0)" ::: "memory")
__device__ __forceinline__ unsigned f2bf(float f) { unsigned u = __builtin_bit_cast(unsigned, f); return (u + 0x7fffu + ((u >> 16) & 1u)) >> 16; }
__device__ __forceinline__ unsigned pk2(float lo, float hi) { return f2bf(lo) | (f2bf(hi) << 16); }
__device__ __forceinline__ float bflo(unsigned w) { return __builtin_bit_cast(float, w << 16); }
__device__ __forceinline__ float bfhi(unsigned w) { return __builtin_bit_cast(float, w & 0xffff0000u); }
__device__ __forceinline__ float bf2f(bf16 b) { return __builtin_bit_cast(float, ((unsigned)b) << 16); }
__device__ __forceinline__ void v8(const v4u w, float (&o)[8]) { o[0] = bflo(w.x); o[1] = bfhi(w.x); o[2] = bflo(w.y); o[3] = bfhi(w.y); o[4] = bflo(w.z); o[5] = bfhi(w.z); o[6] = bflo(w.w); o[7] = bfhi(w.w); }
__device__ __forceinline__ float fexp2(float x) { return __builtin_amdgcn_exp2f(x); }
__device__ __forceinline__ float frcp(float x) { return __builtin_amdgcn_rcpf(x); }
__device__ __forceinline__ float sigmoidf_(float x) { return frcp(1.0f + fexp2(-x * LOG2E)); }
__device__ __forceinline__ float wave_sum(float v) {
#pragma unroll
    for (int o = 1; o < 64; o <<= 1) v += __shfl_xor(v, o);
    return v;
}
__device__ __forceinline__ float wave_max(float v) {
#pragma unroll
    for (int o = 1; o < 64; o <<= 1) v = fmaxf(v, __shfl_xor(v, o));
    return v;
}

__device__ __forceinline__ int opq_v(int x) { asm volatile("" : "+v"(x)); return x; }
__device__ __forceinline__ int opq_s(int x) { asm volatile("" : "+s"(x)); return x; }
__device__ __forceinline__ int lane_id() { const unsigned m = (unsigned)opq_s(-1); return (int)__builtin_amdgcn_mbcnt_hi(m, __builtin_amdgcn_mbcnt_lo(m, 0u)); }

namespace pg8 {
#define PG8_LAS __attribute__((address_space(3)))
typedef unsigned short bf16_t;
typedef unsigned u32x4 __attribute__((ext_vector_type(4)));
typedef unsigned u32x2 __attribute__((ext_vector_type(2)));
typedef int i32x4 __attribute__((ext_vector_type(4)));
typedef unsigned short u16x2 __attribute__((ext_vector_type(2)));
constexpr int BM = 256, BK = 64, HALF = 128, HTB = HALF * BK * 2, STAGE_BYTES = 8 * HTB, NXCD = 8, WGM = 4;
__host__ __device__ __forceinline__ int lds_byte(int r, int c) { const int st = (r >> 4) * 2 + (c >> 5), rr = r & 15, cc = c & 31, ob = rr * 64 + cc * 2; return st * 1024 + (ob ^ (((ob >> 9) & 1) << 5)); }
__host__ __device__ __forceinline__ void stage_rc(int b, int& R, int& C) { const int st = b / 1024, sb = b % 1024, swz = sb ^ (((sb >> 9) & 1) << 5); R = (st >> 1) * 16 + swz / 64; C = (st & 1) * 32 + (swz % 64) / 2; }
__host__ __device__ __forceinline__ int perm32(int rho) { const int n = rho >> 4, i = rho & 15; return 8 * (i >> 2) + 4 * n + (i & 3); }
struct Unit { int pm, pn, sub; };
struct Gemm { const bf16_t* A; const bf16_t* Bt; int M, N, K, lda, ldb; };
struct StaticOrder {
    int nM, nN, nwg, G, c;
    __host__ __device__ void init(int M, int N, int G_, int c_) { nM = M / BM; nN = N / BM; nwg = nM * nN; G = G_; c = c_; }
    __host__ __device__ bool next(int i, Unit& u) const { const long L = (long)i * G + c; if (L >= nwg) return false; at(L, u); return true; }
    __host__ __device__ void at(long L, Unit& u) const {
        int wgid = (int)L; { const int q = nwg / NXCD, r = nwg % NXCD, xcd = wgid % NXCD, off = wgid / NXCD; wgid = (xcd < r ? xcd * (q + 1) : r * (q + 1) + (xcd - r) * q) + off; }
        const int nig = WGM * nN, gid = wgid / nig, fm = gid * WGM, gsz = (nM - fm) < WGM ? (nM - fm) : WGM;
        u.pm = fm + ((wgid % nig) % gsz); u.pn = (wgid % nig) / gsz; u.sub = 0;
    }
    __device__ __forceinline__ void a_ready(const Unit&) const {}
    __device__ __forceinline__ void done(const Unit&) const {}
};
struct GateOrder : StaticOrder {
    __host__ __device__ bool next(int i, Unit& u) const {
        if (G != 256 || nwg != 1536) return StaticOrder::next(i, u);
        if (i < 5) { at((long)i * 256 + c, u); return true; }
        if (c < 128 || i > 6) return false;
        at((long)(1280 + 2 * (c - 128) + (i - 5)), u); return true;
    }
};
struct SubOrder : StaticOrder {
    __device__ __forceinline__ bool next(int i, Unit& u) const { const int t3 = i / 3; if (!StaticOrder::next(t3, u)) return false; u.sub = i - 3 * t3; return true; }
};
typedef __bf16 bf16x2_t __attribute__((ext_vector_type(2)));
__device__ __forceinline__ unsigned cvt_pk_bf16(float lo, float hi) { const f32x2 v = {lo, hi}; const bf16x2_t b = __builtin_convertvector(v, bf16x2_t); return __builtin_bit_cast(unsigned, b); }
typedef f32x4 Acc[2][2][4][2];

__device__ __forceinline__ float silu_(float x) { return x * frcp(1.0f + fexp2(-x * LOG2E)); }

__device__ __forceinline__ void row_rstd(const PG8_LAS float* rsl, int ui, int wr, int fr, float (&rs)[2][4]) {
#pragma unroll
    for (int ai = 0; ai < 2; ++ai)
#pragma unroll
        for (int m = 0; m < 4; ++m) rs[ai][m] = rsl[ui * 256 + ai * HALF + wr * 64 + m * 16 + fr];
}
struct EpiSwiGLU {
    static constexpr bool PERM = true, AFTER_DRAIN = false;
    bf16_t* O; int ldc; const PG8_LAS float* rsl;
    __device__ __forceinline__ void operator()(const Acc& acc, const Unit& u, int ui, int wr, int wc, int fr, int fq) const {
        const int row0 = u.pm * BM + wr * 64 + fr, col0 = u.pn * HALF + wc * 32 + 8 * fq;
        float rs[2][4]; row_rstd(rsl, ui, wr, fr, rs);
#pragma unroll
        for (int ai = 0; ai < 2; ++ai)
#pragma unroll
            for (int m = 0; m < 4; ++m) {
                bf16_t* rowp = O + (size_t)(row0 + ai * HALF + m * 16) * ldc + col0; const float r = rs[ai][m];
                const f32x4 g0 = acc[ai][0][m][0] * r, g1 = acc[ai][0][m][1] * r, u0 = acc[ai][1][m][0] * r, u1 = acc[ai][1][m][1] * r;
                u32x4 w;
                w.x = cvt_pk_bf16(silu_(g0[0]) * u0[0], silu_(g0[1]) * u0[1]); w.y = cvt_pk_bf16(silu_(g0[2]) * u0[2], silu_(g0[3]) * u0[3]);
                w.z = cvt_pk_bf16(silu_(g1[0]) * u1[0], silu_(g1[1]) * u1[1]); w.w = cvt_pk_bf16(silu_(g1[2]) * u1[2], silu_(g1[3]) * u1[3]);
                *(GAS u32x4*)rowp = w;
            }
    }
};
struct EpiSwiGLUQ {
    static constexpr bool PERM = true, AFTER_DRAIN = false;
    bf16_t* O; int ldc; const float* wsc; const PG8_LAS float* rsl;
    __device__ __forceinline__ void operator()(const Acc& acc, const Unit& u, int ui, int wr, int wc, int fr, int fq) const {
        const int row0 = u.pm * BM + wr * 64 + fr, col0 = u.pn * HALF + wc * 32 + 8 * fq;
        float rs[2][4]; row_rstd(rsl, ui, wr, fr, rs);
        const float* sp = wsc + u.pn * BM + wc * 32 + 8 * fq;
        const f32x4 cg0 = *(const GAS f32x4*)sp * -LOG2E, cg1 = *(const GAS f32x4*)(sp + 4) * -LOG2E, cu0 = *(const GAS f32x4*)(sp + HALF) * -LN2, cu1 = *(const GAS f32x4*)(sp + HALF + 4) * -LN2;
#pragma unroll
        for (int ai = 0; ai < 2; ++ai)
#pragma unroll
            for (int m = 0; m < 4; ++m) {
                bf16_t* rowp = O + (size_t)(row0 + ai * HALF + m * 16) * ldc + col0; const float r = rs[ai][m];
                const f32x4 g0 = __builtin_convertvector(__builtin_bit_cast(i32x4, acc[ai][0][m][0]), f32x4) * cg0 * r, g1 = __builtin_convertvector(__builtin_bit_cast(i32x4, acc[ai][0][m][1]), f32x4) * cg1 * r;
                const f32x4 u0 = __builtin_convertvector(__builtin_bit_cast(i32x4, acc[ai][1][m][0]), f32x4) * cu0 * r, u1 = __builtin_convertvector(__builtin_bit_cast(i32x4, acc[ai][1][m][1]), f32x4) * cu1 * r;
                float y0[4], y1[4];
#pragma unroll
                for (int i = 0; i < 4; ++i) { y0[i] = g0[i] * frcp(1.0f + fexp2(g0[i])) * u0[i]; y1[i] = g1[i] * frcp(1.0f + fexp2(g1[i])) * u1[i]; }
                u32x4 w;
                w.x = cvt_pk_bf16(y0[0], y0[1]); w.y = cvt_pk_bf16(y0[2], y0[3]); w.z = cvt_pk_bf16(y1[0], y1[1]); w.w = cvt_pk_bf16(y1[2], y1[3]);
                *(GAS u32x4*)rowp = w;
            }
    }
};
struct EpiResid {
    static constexpr bool PERM = true, AFTER_DRAIN = false;
    bf16_t* x; int ldc; float scale; float* ssq;
    unsigned* ctl; unsigned target; unsigned char* xq; float* xsc; PG8_LAS unsigned* scr;
    __device__ __forceinline__ void operator()(const Acc& acc, const Unit& u, int ui, int wr, int wc, int fr, int fq) const {
        const int row0 = u.pm * BM + wr * 64 + fr, col0 = u.pn * BM + wc * 32 + 8 * fq;
        bf16_t* const x = this->x; float* const ssq = this->ssq; const float scale = this->scale; const int ldc = this->ldc;
        u32x4 wk[2][4][2];
        unsigned mxr[2][4];
#pragma unroll
        for (int ai = 0; ai < 2; ++ai) {
            u32x4 xv[4][2];
#pragma unroll
            for (int m = 0; m < 4; ++m)
#pragma unroll
                for (int bj = 0; bj < 2; ++bj) xv[m][bj] = *(const GAS u32x4*)(x + (size_t)(row0 + ai * HALF + m * 16) * ldc + col0 + bj * HALF);
            asm volatile("" ::: "memory");
#pragma unroll
            for (int m = 0; m < 4; ++m) {
                const size_t off = (size_t)(row0 + ai * HALF + m * 16) * ldc + col0; float s = 0.f; u16x2 mx2 = {0, 0};
#pragma unroll
                for (int bj = 0; bj < 2; ++bj) {
                    const u32x4 w0 = xv[m][bj]; const f32x4 a0 = acc[ai][bj][m][0] * scale, a1 = acc[ai][bj][m][1] * scale;
                    const float v0 = bflo(w0.x) + a0[0], v1 = bfhi(w0.x) + a0[1], v2 = bflo(w0.y) + a0[2], v3 = bfhi(w0.y) + a0[3];
                    const float v4 = bflo(w0.z) + a1[0], v5 = bfhi(w0.z) + a1[1], v6 = bflo(w0.w) + a1[2], v7 = bfhi(w0.w) + a1[3];
                    u32x4 w; w.x = cvt_pk_bf16(v0, v1); w.y = cvt_pk_bf16(v2, v3); w.z = cvt_pk_bf16(v4, v5); w.w = cvt_pk_bf16(v6, v7);
                    *(GAS u32x4*)(x + off + bj * HALF) = w; wk[ai][m][bj] = w;
#pragma unroll
                    for (int e2 = 0; e2 < 4; ++e2) mx2 = __builtin_elementwise_max(mx2, __builtin_bit_cast(u16x2, w[e2] & 0x7fff7fffu));
                    s += ((v0 * v0 + v1 * v1) + (v2 * v2 + v3 * v3)) + ((v4 * v4 + v5 * v5) + (v6 * v6 + v7 * v7));
                }
                s += __shfl_xor(s, 16); s += __shfl_xor(s, 32);
                if (fq == 0) ssq[(size_t)(row0 + ai * HALF + m * 16) * 32 + u.pn * 4 + wc] = s;
                unsigned mh = mx2.x > mx2.y ? (unsigned)mx2.x : (unsigned)mx2.y;
                { const unsigned o = (unsigned)__shfl_xor((int)mh, 16); mh = o > mh ? o : mh; } { const unsigned o = (unsigned)__shfl_xor((int)mh, 32); mh = o > mh ? o : mh; }
                mxr[ai][m] = mh;
            }
            asm volatile("" ::: "memory");
        }
        {
            const int wave = wr * 4 + wc, lane = fq * 16 + fr, tid = wave * 64 + lane;
            PG8_LAS unsigned* const PM = this->scr; PG8_LAS float* const SC = (PG8_LAS float*)(this->scr + 1024);
            const unsigned tg = this->target; unsigned* const cur = this->ctl + CW_RMAX + ((tg >> 3) & 1u) * 16384 + u.pm * BM; unsigned* const nxt = this->ctl + CW_RMAX + (((tg >> 3) & 1u) ^ 1u) * 16384 + u.pm * BM;
            if (fq == 0) {
#pragma unroll
                for (int ai = 0; ai < 2; ++ai)
#pragma unroll
                    for (int m = 0; m < 4; ++m) PM[wc * 256 + ai * HALF + wr * 64 + m * 16 + fr] = mxr[ai][m];
            }
            __syncthreads();
            if (tid < 256) { const unsigned a = PM[tid], b = PM[256 + tid], c = PM[512 + tid], d = PM[768 + tid]; const unsigned ab = a > b ? a : b, cd = c > d ? c : d;
                (void)__hip_atomic_fetch_max(cur + tid, (ab > cd ? ab : cd) << 16, __ATOMIC_RELAXED, __HIP_MEMORY_SCOPE_AGENT); }
            asm volatile("s_waitcnt vmcnt(0)" ::: "memory"); __builtin_amdgcn_s_barrier();
            if (tid == 0) { unsigned* const pc = this->ctl + CW_PCNT + u.pm;
                (void)__hip_atomic_fetch_add(pc, 1u, __ATOMIC_RELAXED, __HIP_MEMORY_SCOPE_AGENT);
                unsigned sp = 0u; while (__hip_atomic_load(pc, __ATOMIC_RELAXED, __HIP_MEMORY_SCOPE_AGENT) < tg && ++sp < (1u << 22)) __builtin_amdgcn_s_sleep(1); }
            __builtin_amdgcn_s_barrier();
            if (tid < 256) { const unsigned mb = __hip_atomic_load(cur + tid, __ATOMIC_RELAXED, __HIP_MEMORY_SCOPE_AGENT);
                const float sc = mb ? __builtin_bit_cast(float, mb) * (1.0f / 127.0f) : 1.0f; SC[tid] = sc;
                if (u.pn == 0) this->xsc[u.pm * BM + tid] = sc;
                __hip_atomic_store(nxt + tid, 0u, __ATOMIC_RELAXED, __HIP_MEMORY_SCOPE_AGENT); }
            __syncthreads();
            unsigned char* const xq = this->xq;
#pragma unroll
            for (int ai = 0; ai < 2; ++ai)
#pragma unroll
                for (int m = 0; m < 4; ++m) {
                    const int rl = ai * HALF + wr * 64 + m * 16 + fr; const float inv = 1.0f / SC[rl];
                    unsigned char* const rp = xq + (size_t)(u.pm * BM + rl) * 2048 + col0;
#pragma unroll
                    for (int bj = 0; bj < 2; ++bj) {
                        const u32x4 w = wk[ai][m][bj]; u32x2 q;
#pragma unroll
                        for (int h = 0; h < 2; ++h) {
                            const unsigned a = w[2 * h], b = w[2 * h + 1];
                            const int q0 = (int)rintf(bflo(a) * inv), q1 = (int)rintf(bfhi(a) * inv), q2 = (int)rintf(bflo(b) * inv), q3 = (int)rintf(bfhi(b) * inv);
                            q[h] = (unsigned)(q0 & 255) | ((unsigned)(q1 & 255) << 8) | ((unsigned)(q2 & 255) << 16) | ((unsigned)(q3 & 255) << 24);
                        }
                        *(GAS u32x2*)(rp + bj * HALF) = q;
                    }
                }
        }
    }
};
struct EpiProj {
    static constexpr bool PERM = true, AFTER_DRAIN = false;
    bf16_t* O; int ldc; const float* lb0; const float* lb1; const PG8_LAS float* rsl;
    template <int MODE> __device__ __forceinline__ void tile(const Acc& acc, const Unit& u, int ui, int wr, int wc, int fr, int fq, float scale, const float* lb) const {
        const int row0 = u.pm * BM + wr * 64 + fr, col0 = u.pn * BM + wc * 32 + 8 * fq;
        float rs[2][4]; row_rstd(rsl, ui, wr, fr, rs);
        f32x4 l[2][2];
        if (MODE == 1) {
#pragma unroll
            for (int bj = 0; bj < 2; ++bj)
#pragma unroll
                for (int n = 0; n < 2; ++n) l[bj][n] = *(const GAS f32x4*)(lb + bj * HALF + wc * 32 + 8 * fq + 4 * n);
        }
#pragma unroll
        for (int ai = 0; ai < 2; ++ai)
#pragma unroll
            for (int m = 0; m < 4; ++m) {
                bf16_t* rowp = O + (size_t)(row0 + ai * HALF + m * 16) * ldc + col0;
#pragma unroll
                for (int bj = 0; bj < 2; ++bj) {
                    f32x4 v[2] = {acc[ai][bj][m][0] * rs[ai][m], acc[ai][bj][m][1] * rs[ai][m]};
#pragma unroll
                    for (int n = 0; n < 2; ++n)
#pragma unroll
                        for (int i = 0; i < 4; ++i) {
                            float x = v[n][i];
                            if (MODE == 0) x *= scale;
                            if (MODE == 1) { const float lbv = l[bj][n][i]; x = __builtin_amdgcn_logf(lbv + (1.0f - lbv) * sigmoidf_(x)); }
                            if (MODE == 2) x = silu_(x);
                            if (MODE == 3) x = sigmoidf_(x);
                            v[n][i] = x;
                        }
                    if (MODE == 3) {
                        unsigned q[2][4];
#pragma unroll
                        for (int n = 0; n < 2; ++n)
#pragma unroll
                            for (int i = 0; i < 4; ++i) { const unsigned t = (unsigned)(v[n][i] * 256.0f); q[n][i] = t < 255u ? t : 255u; }
                        u32x2 w; w.x = q[0][0] | (q[0][1] << 8) | (q[0][2] << 16) | (q[0][3] << 24); w.y = q[1][0] | (q[1][1] << 8) | (q[1][2] << 16) | (q[1][3] << 24);
                        *(GAS u32x2*)((unsigned char*)(rowp - col0 + O_GA) + (col0 - O_GA) + bj * HALF) = w;
                    } else {
                        u32x4 w; w.x = cvt_pk_bf16(v[0][0], v[0][1]); w.y = cvt_pk_bf16(v[0][2], v[0][3]); w.z = cvt_pk_bf16(v[1][0], v[1][1]); w.w = cvt_pk_bf16(v[1][2], v[1][3]);
                        *(GAS u32x4*)(rowp + bj * HALF) = w;
                    }
                }
            }
    }
    __device__ __forceinline__ void operator()(const Acc& acc, const Unit& u, int ui, int wr, int wc, int fr, int fq) const {
        const int pn = u.pn;
        if (pn >= 22) tile<3>(acc, u, ui, wr, wc, fr, fq, 1.f, nullptr);
        else if (pn >= 20) tile<2>(acc, u, ui, wr, wc, fr, fq, 1.f, nullptr);
        else if (pn >= 12 && pn < 16) tile<1>(acc, u, ui, wr, wc, fr, fq, 1.f, (pn < 14 ? lb0 : lb1) + (pn & 1) * BM);
        else { const float s = (pn < 4 || pn == 6 || pn == 7) ? QSCALE : ((pn == 18 || pn == 19) ? CQSCALE : 1.0f); tile<0>(acc, u, ui, wr, wc, fr, fq, s, nullptr); }
    }
};
struct EpiGateQ {
    static constexpr bool PERM = true, AFTER_DRAIN = false;
    unsigned char* G8; int ldg; const float* wsc; const PG8_LAS float* rsl;
    __device__ __forceinline__ void operator()(const Acc& acc, const Unit& u, int ui, int wr, int wc, int fr, int fq) const {
        const int row0 = u.pm * BM + wr * 64 + fr, col0 = u.pn * BM + wc * 32 + 8 * fq;
        float rs[2][4]; row_rstd(rsl, ui, wr, fr, rs);
        f32x4 cs[2][2];
#pragma unroll
        for (int bj = 0; bj < 2; ++bj)
#pragma unroll
            for (int n = 0; n < 2; ++n) cs[bj][n] = *(const GAS f32x4*)(wsc + col0 + bj * HALF + 4 * n) * -LOG2E;
#pragma unroll
        for (int ai = 0; ai < 2; ++ai)
#pragma unroll
            for (int m = 0; m < 4; ++m) {
                unsigned char* rowp = G8 + (size_t)(row0 + ai * HALF + m * 16) * ldg + col0;
#pragma unroll
                for (int bj = 0; bj < 2; ++bj) {
                    unsigned q[2][4];
#pragma unroll
                    for (int n = 0; n < 2; ++n) {
                        const i32x4 iv = __builtin_bit_cast(i32x4, acc[ai][bj][m][n]);
#pragma unroll
                        for (int i = 0; i < 4; ++i) {
                            const float z = (float)iv[i] * rs[ai][m] * cs[bj][n][i];
                            const unsigned t = (unsigned)frcp(__builtin_fmaf(fexp2(z), 1.0f / 256.0f, 1.0f / 256.0f)); q[n][i] = t < 255u ? t : 255u;
                        }
                    }
                    u32x2 w; w.x = q[0][0] | (q[0][1] << 8) | (q[0][2] << 16) | (q[0][3] << 24); w.y = q[1][0] | (q[1][1] << 8) | (q[1][2] << 16) | (q[1][3] << 24);
                    *(GAS u32x2*)(rowp + bj * HALF) = w;
                }
            }
    }
};
template <int MODE> struct EpiGate {
    static constexpr bool PERM = true, AFTER_DRAIN = false;
    const bf16_t* Gt; int ldg; bf16_t* O; int ldc;
    __device__ __forceinline__ void operator()(const Acc& acc, const Unit& u, int ui, int wr, int wc, int fr, int fq) const {
        const int row0 = u.pm * BM + wr * 64 + fr, col0 = u.pn * BM + wc * 32 + 8 * fq;
#pragma unroll
        for (int ai = 0; ai < 2; ++ai)
#pragma unroll
            for (int m = 0; m < 4; ++m) {
                const size_t r = (size_t)(row0 + ai * HALF + m * 16);
#pragma unroll
                for (int bj = 0; bj < 2; ++bj) {
                    const u32x4 c = *(const GAS u32x4*)(Gt + r * ldg + col0 + bj * HALF);
                    f32x4 v0 = acc[ai][bj][m][0], v1 = acc[ai][bj][m][1];
                    v0[0] *= bflo(c.x); v0[1] *= bfhi(c.x); v0[2] *= bflo(c.y); v0[3] *= bfhi(c.y); v1[0] *= bflo(c.z); v1[1] *= bfhi(c.z); v1[2] *= bflo(c.w); v1[3] *= bfhi(c.w);
                    if (MODE) { const u32x4 o = *(const GAS u32x4*)(O + r * ldc + col0 + bj * HALF);
                        v0[0] += bflo(o.x); v0[1] += bfhi(o.x); v0[2] += bflo(o.y); v0[3] += bfhi(o.y); v1[0] += bflo(o.z); v1[1] += bfhi(o.z); v1[2] += bflo(o.w); v1[3] += bfhi(o.w); }
                    u32x4 w; w.x = cvt_pk_bf16(v0[0], v0[1]); w.y = cvt_pk_bf16(v0[2], v0[3]); w.z = cvt_pk_bf16(v1[0], v1[1]); w.w = cvt_pk_bf16(v1[2], v1[3]);
                    *(GAS u32x4*)(O + r * ldc + col0 + bj * HALF) = w;
                }
                if (m & 1) asm volatile("" ::: "memory");
            }
    }
};

struct EpiMerged {
    static constexpr bool PERM = true, AFTER_DRAIN = false;
    const bf16_t* P; int ldp; bf16_t* O; int ldc;
    __device__ __forceinline__ void operator()(Acc& acc, const Unit& u, int ui, int wr, int wc, int fr, int fq) const {
        const int row0 = u.pm * BM + wr * 64 + fr, col0 = u.pn * BM + wc * 32 + 8 * fq;
        const GAS unsigned char* g8 = (const GAS unsigned char*)((const GAS bf16_t*)P + (size_t)row0 * ldp + O_GA) + (col0 - 0);
        const size_t rstep = (size_t)ldp * 2;
        if (u.sub < 2) {
            const GAS unsigned char* rp = g8 + u.sub * 2048;
#pragma unroll
            for (int ai = 0; ai < 2; ++ai) {
                u32x2 ga[4][2], gb[4][2];
#pragma unroll
                for (int m = 0; m < 4; ++m) {
                    const GAS unsigned char* rowp = rp + (size_t)(ai * HALF + m * 16) * rstep;
#pragma unroll
                    for (int bj = 0; bj < 2; ++bj) { ga[m][bj] = *(const GAS u32x2*)(rowp + bj * HALF); gb[m][bj] = *(const GAS u32x2*)(rowp + 2048 + bj * HALF); }
                }
                asm volatile("" ::: "memory");
#pragma unroll
                for (int m = 0; m < 4; ++m)
#pragma unroll
                    for (int bj = 0; bj < 2; ++bj) {
                        const u32x2 a = ga[m][bj], b = gb[m][bj];
                        f32x4 r0, r1;
#pragma unroll
                        for (int i = 0; i < 4; ++i) {
                            r0[i] = ((float)((a.x >> (8 * i)) & 255u) + 0.5f) * frcp((float)((b.x >> (8 * i)) & 255u) + 0.5f);
                            r1[i] = ((float)((a.y >> (8 * i)) & 255u) + 0.5f) * frcp((float)((b.y >> (8 * i)) & 255u) + 0.5f);
                        }
                        acc[ai][bj][m][0] *= r0; acc[ai][bj][m][1] *= r1;
                    }
                asm volatile("" ::: "memory");
            }
        } else {
#pragma unroll
            for (int ai = 0; ai < 2; ++ai)
#pragma unroll
                for (int m = 0; m < 4; ++m) {
                    const size_t r = (size_t)(row0 + ai * HALF + m * 16);
#pragma unroll
                    for (int bj = 0; bj < 2; ++bj) {
                        const u32x2 c = *(const GAS u32x2*)(g8 + (size_t)(ai * HALF + m * 16) * rstep + 4096 + bj * HALF);
                        const f32x4 v0 = acc[ai][bj][m][0], v1 = acc[ai][bj][m][1];
                        float s0[4], s1[4];
#pragma unroll
                        for (int i = 0; i < 4; ++i) { s0[i] = ((float)((c.x >> (8 * i)) & 255u) + 0.5f) * (1.0f / 256.0f); s1[i] = ((float)((c.y >> (8 * i)) & 255u) + 0.5f) * (1.0f / 256.0f); }
                        u32x4 w; w.x = cvt_pk_bf16(v0[0] * s0[0], v0[1] * s0[1]); w.y = cvt_pk_bf16(v0[2] * s0[2], v0[3] * s0[3]);
                        w.z = cvt_pk_bf16(v1[0] * s1[0], v1[1] * s1[1]); w.w = cvt_pk_bf16(v1[2] * s1[2], v1[3] * s1[3]);
                        *(GAS u32x4*)(O + r * ldc + col0 + bj * HALF) = w;
                    }
                    if (m & 1) asm volatile("" ::: "memory");
                }
        }
    }
};

template <class Epi, class Sched, bool ALIGN_EPI = false, bool SP2 = false, bool SUBK = false, bool I8 = false>
__device__ __forceinline__ void gemm_phase(PG8_LAS unsigned char* lds, const Gemm g, const Sched S, const Epi E, int wave) {
    const int wid = wave, lane = lane_id(), tid = wid * 64 + lane, wr = wid >> 2, wc = wid & 3, fr = lane & 15, fq = lane >> 4;
    const int K = g.K, nt = K / BK;
#define PG8_KOFF(u) (SUBK ? ((u).sub == 0 ? 0 : ((u).sub == 1 ? 2048 : 3072)) : 0)
#define PG8_NT(u) (SUBK ? ((u).sub == 0 ? 16 : 8) : nt)
    unsigned voffA[2], voffB[2];
#pragma unroll
    for (int i = 0; i < 2; ++i) { int R, C; stage_rc(tid * 16 + i * 8192, R, C); const int Rb = Epi::PERM ? ((R & ~31) + perm32(R & 31)) : R;
        voffA[i] = (unsigned)(R * g.lda + C) * 2u; voffB[i] = (unsigned)(Rb * g.ldb + C) * 2u; }
    const size_t kstep = (size_t)(BK * 2);
    const size_t hstepA = (size_t)HALF * g.lda * 2, hstepB = (size_t)HALF * g.ldb * 2;
    const size_t tstepA = 2 * hstepA, tstepB = 2 * hstepB;
    const unsigned ldsw = (unsigned)wid * 1024u;
    const int aoff = lds_byte(wr * 64 + fr, fq * 8), boff = lds_byte(wc * 32 + fr, fq * 8);
#define PG8_SA(b, h) (((b) * 2 + (h)) * HTB)
#define PG8_SB(b, h) ((4 + (b) * 2 + (h)) * HTB)
#define PG8_STAGE(bufoff, gbase, voff) do { _Pragma("unroll") for (int _i = 0; _i < 2; ++_i) \
        __builtin_amdgcn_global_load_lds((const unsigned*)((const char*)(gbase) + (voff)[_i]), (PG8_LAS unsigned*)(lds + (bufoff) + ldsw + _i * 8192), 16, 0, 0); } while (0)
#define PG8_LDA(dst, b, h) do { _Pragma("unroll") for (int m = 0; m < 4; ++m) _Pragma("unroll") for (int k = 0; k < 2; ++k) dst[m][k] = *(const PG8_LAS bf16x8*)(lds + PG8_SA(b, h) + aoff + m * 2048 + k * 1024); } while (0)
#define PG8_LDB(dst, b, h) do { _Pragma("unroll") for (int n = 0; n < 2; ++n) _Pragma("unroll") for (int k = 0; k < 2; ++k) dst[n][k] = *(const PG8_LAS bf16x8*)(lds + PG8_SB(b, h) + boff + n * 2048 + k * 1024); } while (0)
#define PG8_MMA(ai, bj, At, Bt) do { __builtin_amdgcn_s_setprio(1); _Pragma("unroll") for (int m = 0; m < 4; ++m) _Pragma("unroll") for (int n = 0; n < 2; ++n) _Pragma("unroll") for (int k = 0; k < 2; ++k) \
        { if constexpr (I8) acc[ai][bj][m][n] = __builtin_bit_cast(f32x4, __builtin_amdgcn_mfma_i32_16x16x64_i8(__builtin_bit_cast(i32x4, Bt[n][k]), __builtin_bit_cast(i32x4, At[m][k]), __builtin_bit_cast(i32x4, acc[ai][bj][m][n]), 0, 0, 0)); \
          else acc[ai][bj][m][n] = __builtin_amdgcn_mfma_f32_16x16x32_bf16(Bt[n][k], At[m][k], acc[ai][bj][m][n], 0, 0, 0); } __builtin_amdgcn_s_setprio(0); } while (0)
#define PG8_WAIT_V(n) asm volatile("s_waitcnt vmcnt(" #n ")" ::: "memory")
#define PG8_WAIT_L(n) asm volatile("s_waitcnt lgkmcnt(" #n ")" ::: "memory")
#define PG8_BAR __builtin_amdgcn_s_barrier()
#define PG8_SCHED __builtin_amdgcn_sched_barrier(0)
    Unit cur, nxt; int ui = 0;
    if (!S.next(0, cur)) return;
    f32x4 acc[2][2][4][2];
#pragma unroll
    for (int a = 0; a < 2; ++a)
#pragma unroll
        for (int b = 0; b < 2; ++b)
#pragma unroll
            for (int m = 0; m < 4; ++m)
#pragma unroll
                for (int n = 0; n < 2; ++n) acc[a][b][m][n] = (f32x4){0.f, 0.f, 0.f, 0.f};
    bf16x8 At[4][2], B0[2][2], B1[2][2];
    const char* cA = (const char*)g.A + (size_t)cur.pm * tstepA + PG8_KOFF(cur); const char* cB = (const char*)g.Bt + (size_t)cur.pn * tstepB + PG8_KOFF(cur);
    S.a_ready(cur);
    if constexpr (SP2) {
        PG8_STAGE(PG8_SB(0, 0), cB, voffB); PG8_STAGE(PG8_SB(0, 1), cB + hstepB, voffB); PG8_STAGE(PG8_SA(0, 0), cA, voffA); PG8_STAGE(PG8_SA(0, 1), cA + hstepA, voffA);
        if (wr == 1) PG8_BAR;
        PG8_WAIT_V(2); PG8_BAR;
        PG8_STAGE(PG8_SB(1, 0), cB + kstep, voffB); PG8_STAGE(PG8_SA(1, 0), cA + kstep, voffA); PG8_STAGE(PG8_SB(1, 1), cB + hstepB + kstep, voffB);
        PG8_WAIT_V(6); PG8_BAR;
    } else {
        PG8_STAGE(PG8_SB(0, 0), cB, voffB); PG8_STAGE(PG8_SA(0, 0), cA, voffA); PG8_STAGE(PG8_SB(0, 1), cB + hstepB, voffB); PG8_STAGE(PG8_SA(0, 1), cA + hstepA, voffA);
        if (wr == 1) PG8_BAR;
        PG8_WAIT_V(4); PG8_BAR;
        PG8_STAGE(PG8_SB(1, 0), cB + kstep, voffB); PG8_STAGE(PG8_SA(1, 0), cA + kstep, voffA); PG8_STAGE(PG8_SB(1, 1), cB + hstepB + kstep, voffB);
        PG8_WAIT_V(6); PG8_BAR;
    }
    for (;;) {
        const bool has_next = S.next(ui + 1, nxt);
        const char* nA = has_next ? (const char*)g.A + (size_t)nxt.pm * tstepA + PG8_KOFF(nxt) : cA; const char* nB = has_next ? (const char*)g.Bt + (size_t)nxt.pn * tstepB + PG8_KOFF(nxt) : cB;
        const int ntc = PG8_NT(cur);
        for (int t = 0; t < ntc; t += 2) {
            const bool last = (t == ntc - 2);
            const char* a1 = cA + (size_t)(t + 1) * kstep;
            const char* a2 = last ? nA : cA + (size_t)(t + 2) * kstep; const char* b2 = last ? nB : cB + (size_t)(t + 2) * kstep;
            const char* a3 = a2 + kstep; const char* b3 = b2 + kstep;
            if (last && has_next) S.a_ready(nxt);
            if constexpr (SP2) {
            PG8_LDB(B0, 0, 0); PG8_LDB(B1, 0, 1); PG8_SCHED; PG8_LDA(At, 0, 0); PG8_STAGE(PG8_SA(1, 1), a1 + hstepA, voffA);
            PG8_WAIT_V(8); PG8_WAIT_L(0); PG8_BAR; PG8_MMA(0, 0, At, B0); PG8_MMA(0, 1, At, B1); PG8_BAR; PG8_SCHED;
            PG8_LDA(At, 0, 1); PG8_STAGE(PG8_SB(0, 0), b2, voffB); PG8_STAGE(PG8_SB(0, 1), b2 + hstepB, voffB); PG8_STAGE(PG8_SA(0, 0), a2, voffA);
            PG8_WAIT_V(8); PG8_WAIT_L(0); PG8_BAR; PG8_MMA(1, 0, At, B0); PG8_MMA(1, 1, At, B1); PG8_BAR; PG8_SCHED;
            PG8_LDB(B0, 1, 0); PG8_LDB(B1, 1, 1); PG8_SCHED; PG8_LDA(At, 1, 0); PG8_STAGE(PG8_SA(0, 1), a2 + hstepA, voffA);
            PG8_WAIT_V(8); PG8_WAIT_L(0); PG8_BAR; PG8_MMA(0, 0, At, B0); PG8_MMA(0, 1, At, B1); PG8_BAR; PG8_SCHED;
            PG8_LDA(At, 1, 1); PG8_STAGE(PG8_SB(1, 0), b3, voffB); PG8_STAGE(PG8_SB(1, 1), b3 + hstepB, voffB); PG8_STAGE(PG8_SA(1, 0), a3, voffA);
            PG8_WAIT_V(8); PG8_WAIT_L(0); PG8_BAR; PG8_MMA(1, 0, At, B0); PG8_MMA(1, 1, At, B1); PG8_BAR; PG8_SCHED;
            } else {
            PG8_LDB(B0, 0, 0); PG8_SCHED; PG8_LDA(At, 0, 0); PG8_STAGE(PG8_SA(1, 1), a1 + hstepA, voffA);
            PG8_WAIT_L(8); PG8_BAR; PG8_WAIT_L(0); PG8_MMA(0, 0, At, B0); PG8_BAR; PG8_SCHED;
            PG8_LDB(B1, 0, 1); PG8_STAGE(PG8_SB(0, 0), b2, voffB);
            PG8_BAR; PG8_WAIT_L(0); PG8_MMA(0, 1, At, B1); PG8_BAR;
            PG8_LDA(At, 0, 1); PG8_STAGE(PG8_SA(0, 0), a2, voffA);
            PG8_BAR; PG8_WAIT_L(0); PG8_MMA(1, 0, At, B0); PG8_BAR; PG8_SCHED;
            PG8_STAGE(PG8_SB(0, 1), b2 + hstepB, voffB);
            PG8_WAIT_V(6); PG8_BAR; PG8_MMA(1, 1, At, B1); PG8_BAR;
            PG8_LDB(B0, 1, 0); PG8_SCHED; PG8_LDA(At, 1, 0); PG8_STAGE(PG8_SA(0, 1), a2 + hstepA, voffA);
            PG8_WAIT_L(8); PG8_BAR; PG8_WAIT_L(0); PG8_MMA(0, 0, At, B0); PG8_BAR; PG8_SCHED;
            PG8_LDB(B1, 1, 1); PG8_STAGE(PG8_SB(1, 0), b3, voffB);
            PG8_BAR; PG8_WAIT_L(0); PG8_MMA(0, 1, At, B1); PG8_BAR;
            PG8_LDA(At, 1, 1); PG8_STAGE(PG8_SA(1, 0), a3, voffA);
            PG8_BAR; PG8_WAIT_L(0); PG8_MMA(1, 0, At, B0); PG8_BAR; PG8_SCHED;
            PG8_STAGE(PG8_SB(1, 1), b3 + hstepB, voffB);
            PG8_WAIT_V(6); PG8_BAR; PG8_MMA(1, 1, At, B1); PG8_BAR;
            }
        }
        if constexpr (ALIGN_EPI) { if (wr == 0) PG8_BAR; }
        E(acc, cur, ui, wr, wc, fr, fq); S.done(cur);
        if (!has_next) break;
        if (!SUBK || nxt.sub == 0) {
#pragma unroll
        for (int a = 0; a < 2; ++a)
#pragma unroll
            for (int b = 0; b < 2; ++b)
#pragma unroll
                for (int m = 0; m < 4; ++m)
#pragma unroll
                    for (int n = 0; n < 2; ++n) acc[a][b][m][n] = (f32x4){0.f, 0.f, 0.f, 0.f};
        }
        cur = nxt; cA = nA; cB = nB; ++ui;
        if constexpr (ALIGN_EPI) { if (wr == 1) PG8_BAR; }
    }
    PG8_WAIT_V(0);
    if constexpr (!ALIGN_EPI) { if (wr == 0) PG8_BAR; }
    PG8_BAR;
#undef PG8_KOFF
#undef PG8_NT
#undef PG8_SA
#undef PG8_SB
#undef PG8_STAGE
#undef PG8_LDA
#undef PG8_LDB
#undef PG8_MMA
#undef PG8_WAIT_V
#undef PG8_WAIT_L
#undef PG8_BAR
#undef PG8_SCHED
}
}

#define XB_TMO      128
#define XB_XCNT(j)  (256  + 64 * (j))
#define XB_XSUB(j)  (1280 + 64 * (j))
#define XB_XGEN(j)  (2304 + 64 * (j))
#define XB_TOP      3328
#define XB_TOPGEN   3392
#define XCD_BAR_WORDS 3456
#define XB_SPIN_CAP (1u << 24)
__device__ __forceinline__ unsigned xb_ld(unsigned* p)              { return __hip_atomic_load(p, __ATOMIC_RELAXED, __HIP_MEMORY_SCOPE_AGENT); }
__device__ __forceinline__ unsigned xb_add(unsigned* p, unsigned v) { return __hip_atomic_fetch_add(p, v, __ATOMIC_RELAXED, __HIP_MEMORY_SCOPE_AGENT); }
__device__ __forceinline__ unsigned xb_xcc_id() { return (unsigned)__builtin_amdgcn_s_getreg((3 << 11) | 20) & 0xFu; }
#define XB_SPIN(cond, bar) do { unsigned _sp = 0; while (cond) { __builtin_amdgcn_s_sleep(1); \
    if ((++_sp & 255u) == 0u) { if (xb_ld(&(bar)[XB_TMO])) break; if (_sp > XB_SPIN_CAP) { atomicAdd(&(bar)[XB_TMO], 1u); break; } } } } while (0)
struct XcdBarrier { unsigned* bar; unsigned x; volatile LAS unsigned* st; };
__device__ __forceinline__ XcdBarrier xcd_barrier_post(unsigned* bar, volatile LAS unsigned* st, bool t0) {
    XcdBarrier b; b.bar = bar; b.x = xb_xcc_id(); b.st = st;
    if (t0) (void)xb_add(&bar[XB_XCNT(b.x)], 1u);
    return b;
}
__device__ __forceinline__ void xcd_barrier_complete(unsigned* bar, unsigned x, unsigned& nloc, unsigned& nx) {
    const unsigned G = gridDim.x * gridDim.y * gridDim.z;
    unsigned sum, cnt, mine, sp = 0u;
    for (;;) {
        sum = 0u; cnt = 0u; mine = 0u;
#pragma unroll
        for (unsigned j = 0; j < 16; ++j) { const unsigned c = xb_ld(&bar[XB_XCNT(j)]); sum += c; cnt += (c > 0u) ? 1u : 0u; mine = (j == x) ? c : mine; }
        if (sum == G) break;
        __builtin_amdgcn_s_sleep(1);
        if ((++sp & 255u) == 0u) { if (xb_ld(&bar[XB_TMO])) break; if (sp > XB_SPIN_CAP) { atomicAdd(&bar[XB_TMO], 1u); break; } }
    }
    nloc = mine > 0u ? mine : 1u; nx = cnt > 0u ? cnt : 1u;
}
__device__ __forceinline__ void xcd_barrier(const XcdBarrier& b, bool t0) {
    asm volatile("s_waitcnt vmcnt(0)" ::: "memory");
    __syncthreads();
    if (t0) {
        unsigned* bar = b.bar;
        __builtin_amdgcn_s_waitcnt(0);
        unsigned nloc = b.st[0], nx = b.st[1];
        if (nloc == 0u) { xcd_barrier_complete(bar, b.x, nloc, nx); b.st[0] = nloc; b.st[1] = nx; }
        const unsigned old = xb_add(&bar[XB_XSUB(b.x)], 1u);
        const unsigned gen = old / nloc;
        if (old + 1u == (gen + 1u) * nloc) {
            __builtin_amdgcn_fence(__ATOMIC_RELEASE, "agent");
            asm volatile("s_waitcnt vmcnt(0)" ::: "memory");
            const unsigned og = xb_add(&bar[XB_TOP], 1u);
            const unsigned tg = og / nx;
            if (og + 1u == (tg + 1u) * nx) xb_add(&bar[XB_TOPGEN], 1u);
            else XB_SPIN(xb_ld(&bar[XB_TOPGEN]) == tg, bar);
            __builtin_amdgcn_fence(__ATOMIC_ACQUIRE, "agent");
            xb_add(&bar[XB_XGEN(b.x)], 1u);
            asm volatile("s_waitcnt vmcnt(0)" ::: "memory");
        } else {
            XB_SPIN(xb_ld(&bar[XB_XGEN(b.x)]) == gen, bar);
            __builtin_amdgcn_fence(__ATOMIC_ACQUIRE, "agent");
            asm volatile("s_waitcnt vmcnt(0)" ::: "memory");
        }
    }
    __syncthreads();
}

struct Args {
    const float* in[22]; float* out; unsigned char* ws;
    int l_lo, l_hi, s_lo, s_hi, ph_lo, ph_hi, do_pro, do_fin, use_bar, pad;
};
struct Frame {
    LAS unsigned char* lds;
    int wave, G, gw, NGW;
};
enum { I_XP = 0, I_XS, I_F1N, I_F1G, I_F1U, I_F1D, I_MN, I_WIN, I_SINK, I_T5, I_NAB, I_LBL, I_HN, I_WA, I_WB, I_WC, I_WO, I_F2N, I_F2G, I_F2U, I_F2D, I_FN };

__device__ __forceinline__ void tr_item(const float* W, int K, int N, bf16* WT, int ld, int koff, int rowmode, LAS float* scr, int item, int lane, const float* gain) {
    const int nblk = N / 32, kb = item / nblk, nb = item % nblk, k0 = 64 * kb, n0 = 32 * nb;
#pragma unroll 8
    for (int i = 0; i < 32; ++i) { const int kk = 2 * i + (lane >> 5); scr[kk * 33 + (lane & 31)] = W[(size_t)(k0 + kk) * N + n0 + (lane & 31)]; }
    LDS_WAIT(); asm volatile("" ::: "memory");
    const int c = lane & 7;
    f32x4 g0 = (f32x4){1.f, 1.f, 1.f, 1.f}, g1 = g0;
    if (gain) { g0 = *(const GAS f32x4*)(gain + k0 + 8 * c); g1 = *(const GAS f32x4*)(gain + k0 + 8 * c + 4); }
#pragma unroll
    for (int j = 0; j < 4; ++j) { const int n = (lane >> 3) + 8 * j; const LAS float* s = scr + (8 * c) * 33 + n;
        v4u o; o.x = pk2(s[0 * 33] * g0[0], s[1 * 33] * g0[1]); o.y = pk2(s[2 * 33] * g0[2], s[3 * 33] * g0[3]); o.z = pk2(s[4 * 33] * g1[0], s[5 * 33] * g1[1]); o.w = pk2(s[6 * 33] * g1[2], s[7 * 33] * g1[3]);
        const int nn = n0 + n; const int drow = rowmode == 0 ? nn : ((nn >> 7) * 256 + (nn & 127) + (rowmode == 2 ? 128 : 0));
        *(GAS v4u*)(WT + (size_t)drow * ld + koff + k0 + 8 * c) = o; }
    LDS_WAIT(); asm volatile("" ::: "memory");
}
__device__ __forceinline__ void tr_matrix(Frame& F, const float* W, int K, int N, bf16* WT, int ld, int koff, int rowmode, const float* gain = nullptr) {
    LAS float* scr = (LAS float*)(F.lds + RING_OFF + F.wave * 16384);
    const int nitems = (K / 64) * (N / 32);
    const int lane = lane_id();
    for (int it = F.gw; it < nitems; it += F.NGW) tr_item(W, K, N, WT, ld, koff, rowmode, scr, it, lane, gain);
}
__device__ __forceinline__ int t5_bucket(int rel) {
    const int n = rel < 0 ? -rel : rel; int b = rel > 0 ? 16 : 0;
    if (n < 8) return b + n;
    int lg = 2 + (31 - __builtin_clz((unsigned)(n * n)));
    if (lg > 15) lg = 15;
    return b + lg;
}
__device__ __forceinline__ void prologue(Frame& F, const __attribute__((address_space(4))) Args* ap) {
    bf16* W = (bf16*)(ap->ws + WS_W);
    for (int l = 0; l < NLAYER; ++l) {
        bf16* Wl = W + (size_t)l * E_LAYER;
        bf16* const T1 = (bf16*)(ap->ws + WS_PROJ) + (size_t)(2 * l) * E_WGU; bf16* const T2 = T1 + E_WGU;
        tr_matrix(F, ap->in[I_F1G] + (size_t)l * DM * DFF, DM, DFF, T1, DM, 0, 1, ap->in[I_F1N] + l * DM);
        tr_matrix(F, ap->in[I_F1U] + (size_t)l * DM * DFF, DM, DFF, T1, DM, 0, 2, ap->in[I_F1N] + l * DM);
        tr_matrix(F, ap->in[I_F1D] + (size_t)l * DFF * DM, DFF, DM, Wl + EO_WD1, DFF, 0, 0);
        tr_matrix(F, ap->in[I_WIN] + (size_t)l * DM * PW, DM, PW, Wl + EO_WIN, DM, 0, 0, ap->in[I_MN] + l * DM);
        tr_matrix(F, ap->in[I_WA] + (size_t)l * 1024 * DM, 1024, DM, Wl + EO_WBR, DM, 0, 0);
        tr_matrix(F, ap->in[I_WB] + (size_t)l * 512 * DM, 512, DM, Wl + EO_WBR, DM, 1024, 0);
        tr_matrix(F, ap->in[I_WC] + (size_t)l * 512 * DM, 512, DM, Wl + EO_WBR, DM, 1536, 0);
        tr_matrix(F, ap->in[I_WO] + (size_t)l * DM * DM, DM, DM, Wl + EO_WOUT, DM, 0, 0);
        tr_matrix(F, ap->in[I_F2G] + (size_t)l * DM * DFF, DM, DFF, T2, DM, 0, 1, ap->in[I_F2N] + l * DM);
        tr_matrix(F, ap->in[I_F2U] + (size_t)l * DM * DFF, DM, DFF, T2, DM, 0, 2, ap->in[I_F2N] + l * DM);
        tr_matrix(F, ap->in[I_F2D] + (size_t)l * DFF * DM, DFF, DM, Wl + EO_WD2, DFF, 0, 0);
    }
    float* tab = (float*)(ap->ws + WS_TAB);
    const int gt = blockIdx.x * 512 + F.wave * 64 + lane_id(), NT = F.G * 512;
    for (int i = gt; i < 8 * 260; i += NT) { const int h = i / 260, j = i % 260; tab[TAB_T5 + i] = j <= 256 ? ap->in[I_T5][t5_bucket(j - 128) * 8 + h] * LOG2E : -1e30f; }
    for (int i = gt; i < 2 * 512; i += NT) {
        const int dir = i / 512, c = i % 512; const float* lg = ap->in[I_LBL] + (size_t)dir * NLAYER * 512 + c;
        float mx = lg[0]; for (int l = 1; l < NLAYER; ++l) mx = fmaxf(mx, lg[l * 512]);
        float e[NLAYER], s = 0.f; for (int l = 0; l < NLAYER; ++l) { e[l] = expf(lg[l * 512] - mx); s += e[l]; }
        float cum = 0.f; for (int l = 0; l < NLAYER; ++l) { cum += e[l] / s; tab[TAB_LB + (dir * NLAYER + l) * 512 + c] = cum - e[0] / s; }
    }
}
__device__ __forceinline__ void quant_rows(Frame& F, const bf16* src, unsigned char* dst, float* scl, int nrows) {
    const int lane = lane_id();
    for (int r0 = F.gw; r0 < nrows; r0 += 4 * F.NGW) {
        pg8::u32x4 v[4][4];
#pragma unroll
        for (int u = 0; u < 4; ++u) { const int r = r0 + u * F.NGW;
            if (r < nrows) { const GAS pg8::u32x4* p = (const GAS pg8::u32x4*)(src + (size_t)r * 2048) + lane * 4;
#pragma unroll
                for (int j = 0; j < 4; ++j) v[u][j] = p[j]; } }
        asm volatile("" ::: "memory");
#pragma unroll
        for (int u = 0; u < 4; ++u) { const int r = r0 + u * F.NGW;
            if (r < nrows) {
                float mx = 0.f;
#pragma unroll
                for (int j = 0; j < 4; ++j)
#pragma unroll
                    for (int e = 0; e < 4; ++e) mx = fmaxf(mx, fmaxf(fabsf(bflo(v[u][j][e])), fabsf(bfhi(v[u][j][e]))));
#pragma unroll
                for (int o = 32; o > 0; o >>= 1) mx = fmaxf(mx, __shfl_xor(mx, o));
                const float sc = mx > 0.f ? mx * (1.0f / 127.0f) : 1.0f, inv = 1.0f / sc;
                pg8::u32x4 w[2];
#pragma unroll
                for (int j = 0; j < 4; ++j)
#pragma unroll
                    for (int h = 0; h < 2; ++h) {
                        const unsigned a = v[u][j][2 * h], b = v[u][j][2 * h + 1];
                        const int q0 = (int)rintf(bflo(a) * inv), q1 = (int)rintf(bfhi(a) * inv), q2 = (int)rintf(bflo(b) * inv), q3 = (int)rintf(bfhi(b) * inv);
                        w[j >> 1][(j & 1) * 2 + h] = (unsigned)(q0 & 255) | ((unsigned)(q1 & 255) << 8) | ((unsigned)(q2 & 255) << 16) | ((unsigned)(q3 & 255) << 24);
                    }
                GAS pg8::u32x4* d = (GAS pg8::u32x4*)(dst + (size_t)r * 2048) + lane * 2;
                d[0] = w[0]; d[1] = w[1];
                if (lane == 0) scl[r] = sc;
            } }
    }
}
__device__ __forceinline__ void quant_gate_weights(Frame& F, const __attribute__((address_space(4))) Args* ap) {
    for (int l = 0; l < NLAYER; ++l) {
        unsigned char* wq = ap->ws + WS_WQ + (size_t)l * WQ_LAYER;
        quant_rows(F, (const bf16*)(ap->ws + WS_W) + (size_t)l * E_LAYER + EO_WIN + (size_t)O_GA * DM, wq, (float*)(wq + WQ_SCALE), 3 * DM);
        for (int j = 0; j < 2; ++j) { unsigned char* d = (unsigned char*)((bf16*)(ap->ws + WS_W) + (size_t)l * E_LAYER + (j ? EO_WGU2 : EO_WGU1));
            quant_rows(F, (const bf16*)(ap->ws + WS_PROJ) + (size_t)(2 * l + j) * E_WGU, d, (float*)(d + WGUQ_SCALE), 2 * DFF); }
    }
}
template <bool OUT_F32> __device__ __forceinline__ void norm_rows(Frame& F, const float* x, const float* gain, void* out, int M) {
    const int lane = lane_id();
    const GAS f32x4* gr = (const GAS f32x4*)gain + lane;
    for (int m = F.gw; m < M; m += F.NGW) {
        const GAS f32x4* xr = (const GAS f32x4*)(x + (size_t)m * DM) + lane;
        f32x4 v[8]; float s = 0.f;
#pragma unroll
        for (int j = 0; j < 8; ++j) { v[j] = xr[64 * j]; s += (v[j].x * v[j].x + v[j].y * v[j].y) + (v[j].z * v[j].z + v[j].w * v[j].w); }
        const float rstd = 1.0f / sqrtf(wave_sum(s) * (1.0f / DM) + EPS);
#pragma unroll
        for (int j = 0; j < 8; ++j) { const f32x4 g = gr[64 * j]; const f32x4 o = v[j] * rstd * g;
            if (OUT_F32) ((GAS f32x4*)((float*)out + (size_t)m * DM) + lane)[64 * j] = o;
            else { v2u w; w.x = pk2(o.x, o.y); w.y = pk2(o.z, o.w); ((GAS v2u*)((bf16*)out + (size_t)m * DM) + lane)[64 * j] = w; } }
    }
}

__device__ __forceinline__ void cast_rows(Frame& F, const float* x, bf16* xb, float* ssq, int M) {
    const int lane = lane_id();
    for (int m = F.gw; m < M; m += F.NGW) {
        const GAS f32x4* xr = (const GAS f32x4*)(x + (size_t)m * DM) + lane; float s = 0.f;
#pragma unroll
        for (int j = 0; j < 8; ++j) { const f32x4 v = xr[64 * j]; s += (v.x * v.x + v.y * v.y) + (v.z * v.z + v.w * v.w);
            v2u w; w.x = pk2(v.x, v.y); w.y = pk2(v.z, v.w); ((GAS v2u*)(xb + (size_t)m * DM) + lane)[64 * j] = w; }
        s = wave_sum(s);
        if (lane < 32) ssq[(size_t)m * 32 + lane] = lane == 0 ? s : 0.f;
    }
}
__device__ __forceinline__ void final_rows(Frame& F, const bf16* xb, const float* gain, float* out, int M) {
    const int lane = lane_id();
    const GAS f32x4* gr = (const GAS f32x4*)gain;
    for (int m = F.gw; m < M; m += F.NGW) {
        const GAS v4u* xr = (const GAS v4u*)(xb + (size_t)m * DM) + lane;
        float v[4][8]; float s = 0.f;
#pragma unroll
        for (int j = 0; j < 4; ++j) { v8(xr[64 * j], v[j]);
#pragma unroll
            for (int k = 0; k < 8; ++k) s += v[j][k] * v[j][k]; }
        const float rstd = 1.0f / sqrtf(wave_sum(s) * (1.0f / DM) + EPS);
#pragma unroll
        for (int j = 0; j < 4; ++j) { const f32x4 g0 = gr[2 * (64 * j + lane)], g1 = gr[2 * (64 * j + lane) + 1];
            GAS f32x4* o = (GAS f32x4*)(out + (size_t)m * DM) + 2 * (64 * j + lane);
            o[0] = (f32x4){v[j][0] * rstd * g0[0], v[j][1] * rstd * g0[1], v[j][2] * rstd * g0[2], v[j][3] * rstd * g0[3]};
            o[1] = (f32x4){v[j][4] * rstd * g1[0], v[j][5] * rstd * g1[1], v[j][6] * rstd * g1[2], v[j][7] * rstd * g1[3]}; }
    }
}
__device__ __forceinline__ void mixA_naive(Frame& F, const bf16* P, bf16* Y, const float* tab, const float* sink, int Ts) {
    LAS float* ql = (LAS float*)(F.lds + RING_OFF + 65536 + F.wave * 2048);
    LAS float* pl = ql + 128;
    const int lane = lane_id();
    for (int it = F.gw; it < MS * 8; it += F.NGW) {
        const int row = it >> 3, h = it & 7, kvh = h >> 2, t = row & (Ts - 1), rb = row - t;
        { const unsigned w = *(const GAS unsigned*)(P + (size_t)row * PW + O_AQ + h * 128 + 2 * lane); ql[2 * lane] = bflo(w); ql[2 * lane + 1] = bfhi(w); }
        LDS_WAIT(); asm volatile("" ::: "memory");
        float sc[5]; float mx = sink[h] * LOG2E;
#pragma unroll
        for (int p = 0; p < 5; ++p) {
            const int j = lane + 64 * p, kpos = t + j - 128; float s = -1e30f;
            if (j <= 256 && kpos >= 0 && kpos < Ts) {
                const GAS v4u* kr = (const GAS v4u*)(P + (size_t)(rb + kpos) * PW + O_AK + kvh * 128); float a = 0.f;
#pragma unroll 4
                for (int d8 = 0; d8 < 16; ++d8) { const v4u w = kr[d8]; const LAS float* q = ql + d8 * 8;
                    a += q[0] * bflo(w.x) + q[1] * bfhi(w.x) + q[2] * bflo(w.y) + q[3] * bfhi(w.y) + q[4] * bflo(w.z) + q[5] * bfhi(w.z) + q[6] * bflo(w.w) + q[7] * bfhi(w.w); }
                s = a + tab[TAB_T5 + h * 260 + j];
            }
            sc[p] = s; mx = fmaxf(mx, s);
        }
        mx = wave_max(mx);
        float sum = 0.f;
#pragma unroll
        for (int p = 0; p < 5; ++p) { const float e = fexp2(sc[p] - mx); pl[lane + 64 * p] = e; sum += e; }
        sum = wave_sum(sum) + fexp2(sink[h] * LOG2E - mx);
        LDS_WAIT(); asm volatile("" ::: "memory");
        float o0 = 0.f, o1 = 0.f;
        const int jlo = t >= 128 ? 0 : 128 - t, jhi = (t + 128 < Ts) ? 256 : (Ts - 1 - t + 128);
        for (int j = jlo; j <= jhi; ++j) { const float pj = pl[j]; const unsigned w = *(const GAS unsigned*)(P + (size_t)(rb + t + j - 128) * PW + O_AV + kvh * 128 + 2 * lane); o0 += pj * bflo(w); o1 += pj * bfhi(w); }
        const float inv = 1.0f / sum;
        *(GAS unsigned*)(Y + (size_t)row * DM + h * 128 + 2 * lane) = pk2(o0 * inv, o1 * inv);
        LDS_WAIT(); asm volatile("" ::: "memory");
    }
}
__device__ __forceinline__ void mixB_naive(Frame& F, const bf16* P, bf16* Y, const float* nab, int Ts) {
    LAS float* ql = (LAS float*)(F.lds + RING_OFF + 65536 + F.wave * 2048);
    LAS float* pl = ql + 128;
    const int lane = lane_id(), rows = Ts >> 6;
    for (int it = F.gw; it < MS * 4; it += F.NGW) {
        const int row = it >> 2, h = it & 3, t = row & (Ts - 1), rb = row - t, r = t >> 6, c = t & 63;
        int rs = r - 4; rs = rs < 0 ? 0 : (rs > rows - 8 ? rows - 8 : rs);
        int cs = c - 8; cs = cs < 0 ? 0 : (cs > 48 ? 48 : cs);
        { const unsigned w = *(const GAS unsigned*)(P + (size_t)row * PW + O_BQ + h * 128 + 2 * lane); ql[2 * lane] = bflo(w); ql[2 * lane + 1] = bfhi(w); }
        LDS_WAIT(); asm volatile("" ::: "memory");
        float sc[2]; float mx = -1e30f;
#pragma unroll
        for (int p = 0; p < 2; ++p) {
            const int i = lane + 64 * p, kr_ = rs + (i >> 4), kc = cs + (i & 15);
            const GAS v4u* kr = (const GAS v4u*)(P + (size_t)(rb + kr_ * 64 + kc) * PW + O_BK + h * 128); float a = 0.f;
#pragma unroll 4
            for (int d8 = 0; d8 < 16; ++d8) { const v4u w = kr[d8]; const LAS float* q = ql + d8 * 8;
                a += q[0] * bflo(w.x) + q[1] * bfhi(w.x) + q[2] * bflo(w.y) + q[3] * bfhi(w.y) + q[4] * bflo(w.z) + q[5] * bfhi(w.z) + q[6] * bflo(w.w) + q[7] * bfhi(w.w); }
            int dc = kc - c; dc = dc < -15 ? -15 : (dc > 15 ? 15 : dc);
            sc[p] = a + nab[(h * 15 + (kr_ - r + 7)) * 31 + dc + 15] * LOG2E; mx = fmaxf(mx, sc[p]);
        }
        mx = wave_max(mx);
        float sum = 0.f;
#pragma unroll
        for (int p = 0; p < 2; ++p) { const float e = fexp2(sc[p] - mx); pl[lane + 64 * p] = e; sum += e; }
        sum = wave_sum(sum);
        LDS_WAIT(); asm volatile("" ::: "memory");
        float o0 = 0.f, o1 = 0.f;
        for (int i = 0; i < 128; ++i) { const float pj = pl[i]; const unsigned w = *(const GAS unsigned*)(P + (size_t)(rb + (rs + (i >> 4)) * 64 + cs + (i & 15)) * PW + O_BV + h * 128 + 2 * lane); o0 += pj * bflo(w); o1 += pj * bfhi(w); }
        const float inv = 1.0f / sum;
        *(GAS unsigned*)(Y + (size_t)row * DM + 1024 + h * 128 + 2 * lane) = pk2(o0 * inv, o1 * inv);
        LDS_WAIT(); asm volatile("" ::: "memory");
    }
}
typedef float f32x16 __attribute__((ext_vector_type(16)));
typedef short s16x4 __attribute__((ext_vector_type(4)));
#define KSWZ(row, colB) ((row) * 256 + ((colB) ^ (((row) & 7) << 4)))
__device__ __forceinline__ int crow(int r, int hi) { return (r & 3) + 8 * (r >> 2) + 4 * hi; }
__device__ __forceinline__ int v_st(int k, int c) { const int kk = (k & ~0xC) | ((k & 4) << 1) | ((k & 8) >> 1); return ((kk >> 3) * 4 + (c >> 5)) * 512 + ((kk & 7) * 32 + (c & 31)) * 2; }
__device__ __forceinline__ int v_rd_base(int lane) { return ((lane & 3) << 3) | (((lane >> 2) & 3) << 6) | (((lane >> 4) & 1) << 5) | (((lane >> 5) & 1) << 8); }
constexpr int v_rd_off(int d0, int ks, int half) { return d0 * 512 + ks * 4096 + half * 2048; }
template <int OFF> __device__ __forceinline__ s16x4 tr_read(int vb) { s16x4 r; asm volatile("ds_read_b64_tr_b16 %0, %1 offset:%2" : "=&v"(r) : "v"(vb), "i"(OFF) : "memory"); return r; }
template <int D0> __device__ __forceinline__ void pv_one(f32x16& od, int vb, bf16x8 pa0, bf16x8 pa1, bf16x8 pa2, bf16x8 pa3) {
    const s16x4 l0 = tr_read<v_rd_off(D0, 0, 0)>(vb), h0 = tr_read<v_rd_off(D0, 0, 1)>(vb), l1 = tr_read<v_rd_off(D0, 1, 0)>(vb), h1 = tr_read<v_rd_off(D0, 1, 1)>(vb);
    const s16x4 l2 = tr_read<v_rd_off(D0, 2, 0)>(vb), h2 = tr_read<v_rd_off(D0, 2, 1)>(vb), l3 = tr_read<v_rd_off(D0, 3, 0)>(vb), h3 = tr_read<v_rd_off(D0, 3, 1)>(vb);
    asm volatile("s_waitcnt lgkmcnt(0)" ::: "memory"); __builtin_amdgcn_sched_barrier(0);
#define PKV(L, H) (bf16x8){L[0], L[1], L[2], L[3], H[0], H[1], H[2], H[3]}
    od = __builtin_amdgcn_mfma_f32_32x32x16_bf16(pa0, PKV(l0, h0), od, 0, 0, 0);
    od = __builtin_amdgcn_mfma_f32_32x32x16_bf16(pa1, PKV(l1, h1), od, 0, 0, 0);
    od = __builtin_amdgcn_mfma_f32_32x32x16_bf16(pa2, PKV(l2, h2), od, 0, 0, 0);
    od = __builtin_amdgcn_mfma_f32_32x32x16_bf16(pa3, PKV(l3, h3), od, 0, 0, 0);
#undef PKV
}
constexpr int AT_K = 0, AT_V = 32768, AT_TAB = 65536, AT_WS = 65536 + 8192, AT_KV = 16384;
__device__ __forceinline__ void attn_tile_update(f32x16& p0, f32x16& p1, f32x16 (&o)[4], float& m_reg, float& l_reg, int vb, LAS float* al_l, int r32, int hi) {
    float pmax = p0[0];
#pragma unroll
    for (int r = 1; r < 16; ++r) pmax = fmaxf(pmax, p0[r]);
#pragma unroll
    for (int r = 0; r < 16; ++r) pmax = fmaxf(pmax, p1[r]);
    pmax = fmaxf(pmax, __shfl_xor(pmax, 32));
    const float mn = fmaxf(m_reg, pmax), alpha = fexp2(m_reg - mn);
    m_reg = mn;
    if (__any(alpha < 1.f)) {
        if (hi == 0) al_l[r32] = alpha;
        asm volatile("s_waitcnt lgkmcnt(0)" ::: "memory");
#pragma unroll
        for (int r = 0; r < 16; ++r) { const float a = al_l[crow(r, hi)];
#pragma unroll
            for (int d = 0; d < 4; ++d) o[d][r] *= a; }
        asm volatile("s_waitcnt lgkmcnt(0)" ::: "memory");
    }
    float ps = 0.f;
#pragma unroll
    for (int r = 0; r < 16; ++r) { p0[r] = fexp2(p0[r] - mn); p1[r] = fexp2(p1[r] - mn); ps += p0[r] + p1[r]; }
    ps += __shfl_xor(ps, 32);
    l_reg = l_reg * alpha + ps;
    bf16x8 pa0, pa1, pa2, pa3;
#define PK4(P, BASE, OUT) do { const unsigned a0 = pg8::cvt_pk_bf16(P[BASE + 0], P[BASE + 1]), a1 = pg8::cvt_pk_bf16(P[BASE + 2], P[BASE + 3]);   \
    const unsigned b0 = pg8::cvt_pk_bf16(P[BASE + 4], P[BASE + 5]), b1 = pg8::cvt_pk_bf16(P[BASE + 6], P[BASE + 7]);                              \
    auto r0 = __builtin_amdgcn_permlane32_swap(a0, b0, false, false); auto r1 = __builtin_amdgcn_permlane32_swap(a1, b1, false, false); \
    v4u wv = {r0[0], r1[0], r0[1], r1[1]}; OUT = __builtin_bit_cast(bf16x8, wv); } while (0)
    PK4(p0, 0, pa0); PK4(p0, 8, pa1); PK4(p1, 0, pa2); PK4(p1, 8, pa3);
#undef PK4
    pv_one<0>(o[0], vb, pa0, pa1, pa2, pa3); pv_one<1>(o[1], vb, pa0, pa1, pa2, pa3); pv_one<2>(o[2], vb, pa0, pa1, pa2, pa3); pv_one<3>(o[3], vb, pa0, pa1, pa2, pa3);
}
__device__ __forceinline__ void attn_qkt(f32x16& p0, f32x16& p1, const LAS unsigned char* Ks, const bf16x8 (&qr)[8], int r32, int hi) {
    p0 = (f32x16){}; p1 = (f32x16){};
#pragma unroll
    for (int d0 = 0; d0 < 8; ++d0) { const int cb = (d0 * 16 + hi * 8) * 2;
        const bf16x8 b0 = *(const LAS bf16x8*)(Ks + KSWZ(r32, cb)), b1 = *(const LAS bf16x8*)(Ks + KSWZ(32 + r32, cb));
        p0 = __builtin_amdgcn_mfma_f32_32x32x16_bf16(b0, qr[d0], p0, 0, 0, 0);
        p1 = __builtin_amdgcn_mfma_f32_32x32x16_bf16(b1, qr[d0], p1, 0, 0, 0); }
}
struct KVStage { v4u k0, k1, v0, v1; };
__device__ __forceinline__ void kv_load(KVStage& st, const bf16* Kp, const bf16* Vp, int row0, int sr, int sc) {
    st.k0 = *(const GAS v4u*)(Kp + (size_t)(row0 + sr) * PW + sc); st.k1 = *(const GAS v4u*)(Kp + (size_t)(row0 + 32 + sr) * PW + sc);
    st.v0 = *(const GAS v4u*)(Vp + (size_t)(row0 + sr) * PW + sc); st.v1 = *(const GAS v4u*)(Vp + (size_t)(row0 + 32 + sr) * PW + sc);
}
__device__ __forceinline__ void kv_write(const KVStage& st, LAS unsigned char* Kb, LAS unsigned char* Vb, int sr, int sc) {
    *(LAS v4u*)(Kb + KSWZ(sr, sc * 2)) = st.k0; *(LAS v4u*)(Kb + KSWZ(32 + sr, sc * 2)) = st.k1;
    *(LAS v4u*)(Vb + v_st(sr, sc)) = st.v0; *(LAS v4u*)(Vb + v_st(32 + sr, sc)) = st.v1;
}
__device__ __forceinline__ void attn_store(const f32x16 (&o)[4], float l_reg, LAS float* li_l, bf16* Yrow0  , int r32, int hi) {
    if (hi == 0) li_l[r32] = l_reg;
    asm volatile("s_waitcnt lgkmcnt(0)" ::: "memory");
#pragma unroll
    for (int r = 0; r < 16; ++r) { const int orow = crow(r, hi); const float rl = frcp(li_l[orow]);
#pragma unroll
        for (int d0 = 0; d0 < 4; ++d0) ((GAS bf16*)Yrow0)[(unsigned)(orow * DM + d0 * 32 + r32)] = (bf16)f2bf(o[d0][r] * rl); }
    asm volatile("s_waitcnt lgkmcnt(0)" ::: "memory");
}
__device__ __forceinline__ void mixA_mfma(Frame& F, const bf16* P, bf16* Y, const float* tab, const float* sink, int Ts) {
    const int lane = lane_id(), w = F.wave, tid = w * 64 + lane, r32 = lane & 31, hi = lane >> 5, sr = tid >> 4, sc = (tid & 15) * 8;
    LAS unsigned char* const L = F.lds + RING_OFF;
    LAS float* const TB = (LAS float*)(L + AT_TAB);
    LAS float* const wsf = (LAS float*)(L + AT_WS) + w * 64;
    const int nqb = Ts >> 7, nitems = (MS >> 7) * 4;
    for (int item = blockIdx.x; item < nitems; item += F.G) {
        const int hp = item & 1, kvh = (item >> 1) & 1, qblk = item >> 2, n = qblk & (nqb - 1), rb = (qblk - n) << 7;
        const int h = kvh * 4 + hp * 2 + (w >> 2), q0 = 128 * n + 32 * (w & 3);
        __syncthreads();
        for (int e = tid; e < 2 * 448; e += 512) { const int hl = e / 448, idx = e % 448 - 96; TB[e] = (idx >= 0 && idx <= 256) ? tab[TAB_T5 + (kvh * 4 + hp * 2 + hl) * 260 + idx] : -1e30f; }
        bf16x8 qr[8];
        { const bf16* qp = P + (size_t)(rb + q0 + r32) * PW + O_AQ + h * 128 + hi * 8;
#pragma unroll
          for (int d0 = 0; d0 < 8; ++d0) qr[d0] = *(const GAS bf16x8*)(qp + d0 * 16); }
        f32x16 o[4] = {}; float m_reg = sink[h] * LOG2E, l_reg = 1.0f;
        const int kt0 = n == 0 ? 0 : 2 * n - 2, kt1 = (n == nqb - 1) ? 2 * n + 2 : 2 * n + 4;
        const bf16* Kp = P + (size_t)rb * PW + O_AK + kvh * 128; const bf16* Vp = P + (size_t)rb * PW + O_AV + kvh * 128;
        KVStage st0, st1; kv_load(st0, Kp, Vp, 64 * kt0, sr, sc);
        if (kt0 + 1 < kt1) kv_load(st1, Kp, Vp, 64 * (kt0 + 1), sr, sc);
        kv_write(st0, L + AT_K, L + AT_V, sr, sc);
        __syncthreads();
        const LAS float* tbh = TB + (w >> 2) * 448;
#define MIXA_STEP(kt, STN, STW) do { const int b = ((kt) - kt0) & 1; \
            if ((kt) + 2 < kt1) kv_load(STN, Kp, Vp, 64 * ((kt) + 2), sr, sc); \
            const int k0 = 64 * (kt); \
            if (k0 + 63 >= q0 - 128 && k0 <= q0 + 31 + 128) { \
                f32x16 p0, p1; attn_qkt(p0, p1, L + AT_K + b * AT_KV, qr, r32, hi); \
                const LAS float* tl = tbh + (k0 - q0 - r32 + 4 * hi + 224); \
                _Pragma("unroll") for (int r = 0; r < 16; ++r) { p0[r] += tl[(r & 3) + 8 * (r >> 2)]; p1[r] += tl[32 + (r & 3) + 8 * (r >> 2)]; } \
                attn_tile_update(p0, p1, o, m_reg, l_reg, (int)(uintptr_t)(L + AT_V + b * AT_KV) + v_rd_base(lane), wsf, r32, hi); } \
            if ((kt) + 1 < kt1) kv_write(STW, L + AT_K + (b ^ 1) * AT_KV, L + AT_V + (b ^ 1) * AT_KV, sr, sc); \
            __syncthreads(); } while (0)
        for (int kt = kt0; kt < kt1; kt += 2) {
            MIXA_STEP(kt, st0, st1);
            MIXA_STEP(kt + 1, st1, st0);
        }
#undef MIXA_STEP
        { bf16* Yq = Y; asm volatile("" : "+s"(Yq)); attn_store(o, l_reg, wsf, Yq + (size_t)(rb + q0) * DM + h * 128, r32, hi); }
    }
    __syncthreads();
}
__device__ __forceinline__ void mixB_mfma(Frame& F, const bf16* P, bf16* Y, const float* nab, int Ts) {
    const int lane = lane_id(), w = F.wave, tid = w * 64 + lane, r32 = lane & 31, hi = lane >> 5, sr = tid >> 4, sc = (tid & 15) * 8;
    LAS unsigned char* const L = F.lds + RING_OFF;
    LAS float* const TB = (LAS float*)(L + AT_TAB);
    LAS float* const wsf = (LAS float*)(L + AT_WS) + w * 64;
    const int rows = Ts >> 6, ngrp = rows >> 2, nitems = (MS >> 8) * 4;
    for (int item = blockIdx.x; item < nitems; item += F.G) {
        const int h = item & 3, g = item >> 2, gi = g & (ngrp - 1), rb = (g - gi) << 8, r0 = 4 * gi, r = r0 + (w >> 1), c = 32 * (w & 1) + r32;
        __syncthreads();
        for (int e = tid; e < 15 * 128; e += 512) { const int dr = e >> 7, dci = (e & 127) - 48; TB[e] = (dci >= 0 && dci <= 30) ? nab[(h * 15 + dr) * 31 + dci] * LOG2E : -1e30f; }
        bf16x8 qr[8];
        { const bf16* qp = P + (size_t)(rb + r * 64 + c) * PW + O_BQ + h * 128 + hi * 8;
#pragma unroll
          for (int d0 = 0; d0 < 8; ++d0) qr[d0] = *(const GAS bf16x8*)(qp + d0 * 16); }
        f32x16 o[4] = {}; float m_reg = -1e30f, l_reg = 0.0f;
        int rs = r - 4; rs = rs < 0 ? 0 : (rs > rows - 8 ? rows - 8 : rs);
        int t0 = r0 - 4; t0 = t0 < 0 ? 0 : (t0 > rows - 8 ? rows - 8 : t0);
        int t1 = r0 + 3 - 4; t1 = (t1 < 0 ? 0 : (t1 > rows - 8 ? rows - 8 : t1)) + 8;
        int cs = c - 8; cs = cs < 0 ? 0 : (cs > 48 ? 48 : cs);
        const unsigned long long vm = (0xFFFFull << cs) >> (4 * hi);
        const unsigned mlo = (unsigned)vm, mhi = (unsigned)(vm >> 32);
        const bf16* Kp = P + (size_t)rb * PW + O_BK + h * 128; const bf16* Vp = P + (size_t)rb * PW + O_BV + h * 128;
        KVStage st0, st1; kv_load(st0, Kp, Vp, 64 * t0, sr, sc);
        if (t0 + 1 < t1) kv_load(st1, Kp, Vp, 64 * (t0 + 1), sr, sc);
        kv_write(st0, L + AT_K, L + AT_V, sr, sc);
        __syncthreads();
#define MIXB_STEP(kr, STN, STW) do { const int b = ((kr) - t0) & 1; \
            if ((kr) + 2 < t1) kv_load(STN, Kp, Vp, 64 * ((kr) + 2), sr, sc); \
            if ((kr) >= rs && (kr) < rs + 8) { \
                f32x16 p0, p1; attn_qkt(p0, p1, L + AT_K + b * AT_KV, qr, r32, hi); \
                const LAS float* tl = TB + ((kr) - r + 7) * 128 + (4 * hi - c + 63); \
                _Pragma("unroll") for (int q = 0; q < 16; ++q) { const int kc = (q & 3) + 8 * (q >> 2); \
                    p0[q] = ((mlo >> kc) & 1u) ? p0[q] + tl[kc] : -1e30f; p1[q] = ((mhi >> kc) & 1u) ? p1[q] + tl[32 + kc] : -1e30f; } \
                attn_tile_update(p0, p1, o, m_reg, l_reg, (int)(uintptr_t)(L + AT_V + b * AT_KV) + v_rd_base(lane), wsf, r32, hi); } \
            if ((kr) + 1 < t1) kv_write(STW, L + AT_K + (b ^ 1) * AT_KV, L + AT_V + (b ^ 1) * AT_KV, sr, sc); \
            __syncthreads(); } while (0)
        for (int kr = t0; kr < t1; kr += 2) {
            MIXB_STEP(kr, st0, st1);
            if (kr + 1 < t1) MIXB_STEP(kr + 1, st1, st0);
        }
#undef MIXB_STEP
        { bf16* Yq = Y; asm volatile("" : "+s"(Yq)); attn_store(o, l_reg, wsf, Yq + (size_t)(rb + r * 64 + 32 * (w & 1)) * DM + 1024 + h * 128, r32, hi); }
    }
    __syncthreads();
}

typedef float f32x4v __attribute__((ext_vector_type(4)));
constexpr int HG_VS = 288;
constexpr int HG_KL = 272;
constexpr int ST_ITEM = 2 * 128 * 128;
template <int SH> __device__ __forceinline__ float dpp_shr(float v) { return __builtin_bit_cast(float, __builtin_amdgcn_update_dpp(0, __builtin_bit_cast(int, v), 0x110 + SH, 0xf, 0xf, true)); }
template <int SH> __device__ __forceinline__ float dpp_shl(float v) { return __builtin_bit_cast(float, __builtin_amdgcn_update_dpp(0, __builtin_bit_cast(int, v), 0x100 + SH, 0xf, 0xf, true)); }
__device__ __forceinline__ float row_scan(float v, int dir) {
    if (dir == 0) { v += dpp_shr<1>(v); v += dpp_shr<2>(v); v += dpp_shr<4>(v); v += dpp_shr<8>(v); }
    else          { v += dpp_shl<1>(v); v += dpp_shl<2>(v); v += dpp_shl<4>(v); v += dpp_shl<8>(v); }
    return v;
}
__device__ __forceinline__ void ld32bf(const bf16* p, float (&o)[32]) {
#pragma unroll
    for (int m = 0; m < 4; ++m) { const v4u w = *(const GAS v4u*)(p + 8 * m);
        o[8 * m + 0] = bflo(w.x); o[8 * m + 1] = bfhi(w.x); o[8 * m + 2] = bflo(w.y); o[8 * m + 3] = bfhi(w.y); o[8 * m + 4] = bflo(w.z); o[8 * m + 5] = bfhi(w.z); o[8 * m + 6] = bflo(w.w); o[8 * m + 7] = bfhi(w.w); }
}
#define HG_PREP(VS_OFF, TOT_OFF) \
    const int lane = lane_id(), tl = lane & 15, kq = lane >> 4, w = F.wave, dir = w >> 2, i = w & 3, tid = w * 64 + lane; \
    LAS unsigned char* const vs = F.lds + RING_OFF + (VS_OFF); LAS float* const TOT = (LAS float*)(F.lds + RING_OFF + (TOT_OFF));
constexpr int HG_TS = 144;
__device__ __forceinline__ void hg_h1(Frame& F, const bf16* P, bf16* ST, float* DEC) {
    const int lane = lane_id(), tl = lane & 15, kq = lane >> 4, w = F.wave, dir = w >> 2, i = w & 3, tid = w * 64 + lane;
    LAS unsigned char* const KT = F.lds + RING_OFF;
    LAS unsigned char* const VT = F.lds + RING_OFF + 36864;
    LAS float* const TOT = (LAS float*)(F.lds + RING_OFF + 55296);
    for (int item = blockIdx.x; item < MS / 64 * 4; item += F.G) {
        const int chunk = item >> 2, h = item & 3, r0 = chunk * 64;
        __syncthreads();
#pragma unroll
        for (int k2 = 0; k2 < 2; ++k2) { const int idx = tid + 512 * k2, row = idx >> 4, c16 = idx & 15;
            const v4u vv = *(const GAS v4u*)(P + (size_t)(r0 + row) * PW + O_CI + h * 128 + 8 * c16);
            LAS unsigned char* vp = VT + (8 * c16) * HG_TS + 2 * row;
            *(LAS unsigned short*)(vp) = (unsigned short)vv.x; *(LAS unsigned short*)(vp + HG_TS) = (unsigned short)(vv.x >> 16);
            *(LAS unsigned short*)(vp + 2 * HG_TS) = (unsigned short)vv.y; *(LAS unsigned short*)(vp + 3 * HG_TS) = (unsigned short)(vv.y >> 16);
            *(LAS unsigned short*)(vp + 4 * HG_TS) = (unsigned short)vv.z; *(LAS unsigned short*)(vp + 5 * HG_TS) = (unsigned short)(vv.z >> 16);
            *(LAS unsigned short*)(vp + 6 * HG_TS) = (unsigned short)vv.w; *(LAS unsigned short*)(vp + 7 * HG_TS) = (unsigned short)(vv.w >> 16); }
        float g[32];
        ld32bf(P + (size_t)(r0 + 16 * i + tl) * PW + O_CFF + dir * 512 + h * 128 + 32 * kq, g);
        float kl[32];
#pragma unroll
        for (int s = 0; s < 32; ++s) { const float c = row_scan(g[s], dir), rc = row_scan(g[s], 1 - dir) - g[s];
            if (tl == (dir == 0 ? 15 : 0)) TOT[(dir * 4 + i) * 128 + 32 * kq + s] = c;
            kl[s] = (1.0f - fexp2(g[s])) * fexp2(rc); if ((s & 3) == 3) asm volatile("" ::: "memory"); }
        __syncthreads();
#pragma unroll
        for (int s4 = 0; s4 < 8; ++s4) {
            f32x4v tv[4];
#pragma unroll
            for (int m = 0; m < 4; ++m) tv[m] = *(const LAS f32x4v*)(TOT + (dir * 4 + m) * 128 + 32 * kq + 4 * s4);
            f32x4v a = (f32x4v){0.f, 0.f, 0.f, 0.f};
#pragma unroll
            for (int m = 0; m < 4; ++m) if (dir == 0 ? m > i : m < i) a += tv[m];
            LAS unsigned char* kp = KT + (dir * 128 + 32 * kq + 4 * s4) * HG_TS + 2 * (16 * i + tl);
#pragma unroll
            for (int k = 0; k < 4; ++k) *(LAS unsigned short*)(kp + k * HG_TS) = (unsigned short)f2bf(kl[4 * s4 + k] * fexp2(a[k]));
            if (i == 0 && tl == 0) { const f32x4v all = (tv[0] + tv[1]) + (tv[2] + tv[3]);
                *(GAS f32x4v*)(DEC + ((size_t)item * 2 + dir) * 128 + 32 * kq + 4 * s4) = (f32x4v){fexp2(all[0]), fexp2(all[1]), fexp2(all[2]), fexp2(all[3])}; }
            asm volatile("" ::: "memory");
        }
        __syncthreads();
        f32x4v acc[2][8];
#pragma unroll
        for (int a = 0; a < 2; ++a)
#pragma unroll
            for (int T = 0; T < 8; ++T) acc[a][T] = (f32x4v){0.f, 0.f, 0.f, 0.f};
#pragma unroll
        for (int m = 0; m < 2; ++m) {
            const bf16x8 a0 = *(const LAS bf16x8*)(KT + (dir * 128 + 32 * i + tl) * HG_TS + 64 * m + 16 * kq), a1 = *(const LAS bf16x8*)(KT + (dir * 128 + 32 * i + 16 + tl) * HG_TS + 64 * m + 16 * kq);
#pragma unroll
            for (int T = 0; T < 8; ++T) { const bf16x8 bv = *(const LAS bf16x8*)(VT + (16 * T + tl) * HG_TS + 64 * m + 16 * kq);
                acc[0][T] = __builtin_amdgcn_mfma_f32_16x16x32_bf16(a0, bv, acc[0][T], 0, 0, 0); acc[1][T] = __builtin_amdgcn_mfma_f32_16x16x32_bf16(a1, bv, acc[1][T], 0, 0, 0); }
        }
        bf16* sp = ST + (size_t)item * ST_ITEM + (size_t)dir * 16384;
#pragma unroll
        for (int a = 0; a < 2; ++a)
#pragma unroll
            for (int T = 0; T < 8; ++T) { v2u wv; wv.x = pk2(acc[a][T][0], acc[a][T][1]); wv.y = pk2(acc[a][T][2], acc[a][T][3]);
                *(GAS v2u*)(sp + (size_t)(16 * T + tl) * 128 + 32 * i + 16 * a + 4 * kq) = wv; }
    }
    __syncthreads();
}
__device__ __forceinline__ void hg_scan(Frame& F, bf16* ST, const float* DEC, int nseq, int nchunk) {
    const int gt = blockIdx.x * 512 + F.wave * 64 + lane_id(), NT = F.G * 512, total = nseq * 16384;
    for (int idx = gt; idx < total; idx += NT) {
        const int d8 = idx & 15, e = (idx >> 4) & 127, dir = (idx >> 11) & 1, h = (idx >> 12) & 3, sq = idx >> 14;
        float S[8];
#pragma unroll
        for (int k = 0; k < 8; ++k) S[k] = 0.f;
#pragma unroll 8
        for (int st = 0; st < nchunk; ++st) {
            const int c = dir == 0 ? st : nchunk - 1 - st; const size_t it2 = ((size_t)(sq * nchunk + c) * 4 + h) * 2 + dir;
            GAS v4u* p = (GAS v4u*)(ST + it2 * 16384 + (size_t)e * 128 + 8 * d8);
            const v4u dl = *p; const f32x4 dc0 = *(const GAS f32x4*)(DEC + it2 * 128 + 8 * d8), dc1 = *(const GAS f32x4*)(DEC + it2 * 128 + 8 * d8 + 4);
            v4u wv; wv.x = pk2(S[0], S[1]); wv.y = pk2(S[2], S[3]); wv.z = pk2(S[4], S[5]); wv.w = pk2(S[6], S[7]);
            *p = wv;
            float df[8]; v8(dl, df);
            S[0] = S[0] * dc0[0] + df[0]; S[1] = S[1] * dc0[1] + df[1]; S[2] = S[2] * dc0[2] + df[2]; S[3] = S[3] * dc0[3] + df[3];
            S[4] = S[4] * dc1[0] + df[4]; S[5] = S[5] * dc1[1] + df[5]; S[6] = S[6] * dc1[2] + df[6]; S[7] = S[7] * dc1[3] + df[7];
        }
    }
}
__device__ __forceinline__ void hg_h3(Frame& F, const bf16* P, const bf16* ST, bf16* Y, const float* gain) {
    HG_PREP(34816, 53248)
    LAS unsigned char* const KL = F.lds + RING_OFF;
    LAS float* const TR = (LAS float*)(F.lds + RING_OFF + 57344) + w * 320;
    LAS float* const OX = (LAS float*)(F.lds + RING_OFF);
    for (int item = blockIdx.x; item < MS / 64 * 4; item += F.G) {
        const int chunk = item >> 2, h = item & 3, r0 = chunk * 64, row = r0 + 16 * i + tl;
        const bf16* sp = ST + (size_t)item * ST_ITEM + (size_t)dir * 16384 + (size_t)(8 * tl) * 128 + 32 * kq;
        v4u sa[8], sb[8];
#define HG_LDS(buf, m_) do { _Pragma("unroll") for (int T_ = 0; T_ < 8; ++T_) buf[T_] = *(const GAS v4u*)(sp + T_ * 128 + 8 * (m_)); } while (0)
#define HG_MMS(buf, m_) do { v4u aw_; aw_.x = pg8::cvt_pk_bf16(qd[8 * (m_)], qd[8 * (m_) + 1]); aw_.y = pg8::cvt_pk_bf16(qd[8 * (m_) + 2], qd[8 * (m_) + 3]); \
        aw_.z = pg8::cvt_pk_bf16(qd[8 * (m_) + 4], qd[8 * (m_) + 5]); aw_.w = pg8::cvt_pk_bf16(qd[8 * (m_) + 6], qd[8 * (m_) + 7]); const bf16x8 af_ = __builtin_bit_cast(bf16x8, aw_); \
        _Pragma("unroll") for (int T_ = 0; T_ < 8; ++T_) o[T_] = __builtin_amdgcn_mfma_f32_16x16x32_bf16(af_, __builtin_bit_cast(bf16x8, buf[T_]), o[T_], 0, 0, 0); } while (0)
        HG_LDS(sa, 0); HG_LDS(sb, 1);
        __syncthreads();
#pragma unroll
        for (int k2 = 0; k2 < 2; ++k2) { const int idx = tid + 512 * k2, rw = idx >> 4, c16 = idx & 15;
            *(LAS v4u*)(vs + rw * HG_VS + c16 * 16) = *(const GAS v4u*)(P + (size_t)(r0 + rw) * PW + O_CI + h * 128 + 8 * c16); }
        float qd[32]; bf16x8 kdp[4];
        { float g[32];
          ld32bf(P + (size_t)row * PW + O_CFF + dir * 512 + h * 128 + 32 * kq, g);
          ld32bf(P + (size_t)row * PW + O_CQ + h * 128 + 32 * kq, qd);
#pragma unroll
          for (int m = 0; m < 4; ++m) { float kd8[8];
#pragma unroll
              for (int j = 0; j < 8; ++j) { const int s = 8 * m + j;
                  const float c = row_scan(g[s], dir), rc = row_scan(g[s], 1 - dir) - g[s];
                  if (tl == (dir == 0 ? 15 : 0)) TOT[(dir * 4 + i) * 128 + 32 * kq + s] = c;
                  const float k = 1.0f - fexp2(g[s]);
                  g[s] = k * fexp2(rc);
                  qd[s] *= fexp2(c); kd8[j] = k * fexp2(fminf(-c, 120.0f)); }
              v4u wv; wv.x = pg8::cvt_pk_bf16(g[8 * m], g[8 * m + 1]); wv.y = pg8::cvt_pk_bf16(g[8 * m + 2], g[8 * m + 3]); wv.z = pg8::cvt_pk_bf16(g[8 * m + 4], g[8 * m + 5]); wv.w = pg8::cvt_pk_bf16(g[8 * m + 6], g[8 * m + 7]);
              *(LAS v4u*)(KL + (dir * 64 + 16 * i + tl) * HG_KL + (32 * kq + 8 * m) * 2) = wv;
              v4u kv; kv.x = pg8::cvt_pk_bf16(kd8[0], kd8[1]); kv.y = pg8::cvt_pk_bf16(kd8[2], kd8[3]); kv.z = pg8::cvt_pk_bf16(kd8[4], kd8[5]); kv.w = pg8::cvt_pk_bf16(kd8[6], kd8[7]);
              kdp[m] = __builtin_bit_cast(bf16x8, kv);
              asm volatile("" ::: "memory"); } }
        __syncthreads();
        f32x4v o[8];
#pragma unroll
        for (int T = 0; T < 8; ++T) o[T] = (f32x4v){0.f, 0.f, 0.f, 0.f};
#define HG_PACK8(x, m_) __builtin_bit_cast(bf16x8, (v4u){pg8::cvt_pk_bf16(x[8 * (m_)], x[8 * (m_) + 1]), pg8::cvt_pk_bf16(x[8 * (m_) + 2], x[8 * (m_) + 3]), pg8::cvt_pk_bf16(x[8 * (m_) + 4], x[8 * (m_) + 5]), pg8::cvt_pk_bf16(x[8 * (m_) + 6], x[8 * (m_) + 7])})
        { f32x4v a4 = (f32x4v){0.f, 0.f, 0.f, 0.f};
#pragma unroll
          for (int m = 0; m < 4; ++m) a4 = __builtin_amdgcn_mfma_f32_16x16x32_bf16(HG_PACK8(qd, m), kdp[m], a4, 0, 0, 0);
#pragma unroll
          for (int r = 0; r < 4; ++r) { const int t = 4 * kq + r; const bool keep = dir == 0 ? (tl <= t) : (tl >= t); TR[t * 20 + tl] = keep ? a4[r] : 0.f; }
          LDS_WAIT(); asm volatile("" ::: "memory");
#pragma unroll
          for (int m = 0; m < 4; ++m) { const float a = TR[tl * 20 + 4 * m + kq]; float vf[8]; v8(*(const LAS v4u*)(vs + (16 * i + 4 * m + kq) * HG_VS + tl * 16), vf);
#pragma unroll
              for (int T = 0; T < 8; ++T) o[T] = __builtin_amdgcn_mfma_f32_16x16x4f32(a, vf[T], o[T], 0, 0, 0); }
          LDS_WAIT(); asm volatile("" ::: "memory"); }
        const int nblk = dir == 0 ? i : 3 - i;
        for (int jj = 1; jj <= nblk; ++jj) {
            const int j = dir == 0 ? i - jj : i + jj;
            if (jj >= 2) { const LAS float* tp = TOT + (dir * 4 + (dir == 0 ? j + 1 : j - 1)) * 128 + 32 * kq;
#pragma unroll
                for (int s4 = 0; s4 < 8; ++s4) { const f32x4v t4 = *(const LAS f32x4v*)(tp + 4 * s4); qd[4 * s4] *= fexp2(t4[0]); qd[4 * s4 + 1] *= fexp2(t4[1]); qd[4 * s4 + 2] *= fexp2(t4[2]); qd[4 * s4 + 3] *= fexp2(t4[3]); } }
            f32x4v a4 = (f32x4v){0.f, 0.f, 0.f, 0.f};
            { const LAS unsigned char* kp = KL + (dir * 64 + 16 * j + tl) * HG_KL + 64 * kq;
#pragma unroll
              for (int m = 0; m < 4; ++m) a4 = __builtin_amdgcn_mfma_f32_16x16x32_bf16(HG_PACK8(qd, m), *(const LAS bf16x8*)(kp + 16 * m), a4, 0, 0, 0); }
#pragma unroll
            for (int r = 0; r < 4; ++r) TR[(4 * kq + r) * 20 + tl] = a4[r];
            LDS_WAIT(); asm volatile("" ::: "memory");
#pragma unroll
            for (int m = 0; m < 4; ++m) { const float a = TR[tl * 20 + 4 * m + kq]; float vf[8]; v8(*(const LAS v4u*)(vs + (16 * j + 4 * m + kq) * HG_VS + tl * 16), vf);
#pragma unroll
                for (int T = 0; T < 8; ++T) o[T] = __builtin_amdgcn_mfma_f32_16x16x4f32(a, vf[T], o[T], 0, 0, 0); }
            LDS_WAIT(); asm volatile("" ::: "memory");
        }
        if (nblk >= 1) { const LAS float* tp = TOT + (dir * 4 + (dir == 0 ? 0 : 3)) * 128 + 32 * kq;
#pragma unroll
            for (int s4 = 0; s4 < 8; ++s4) { const f32x4v t4 = *(const LAS f32x4v*)(tp + 4 * s4); qd[4 * s4] *= fexp2(t4[0]); qd[4 * s4 + 1] *= fexp2(t4[1]); qd[4 * s4 + 2] *= fexp2(t4[2]); qd[4 * s4 + 3] *= fexp2(t4[3]); } }
        HG_MMS(sa, 0); HG_LDS(sa, 2); HG_MMS(sb, 1); HG_LDS(sb, 3); HG_MMS(sa, 2); HG_MMS(sb, 3);
#undef HG_LDS
#undef HG_MMS
#undef HG_PACK8
        __syncthreads();
        if (dir == 1) {
#pragma unroll
            for (int r = 0; r < 4; ++r) { LAS float* q = OX + (i * 16 + 4 * kq + r) * 128 + 8 * tl;
                *(LAS f32x4v*)q = (f32x4v){o[0][r], o[1][r], o[2][r], o[3][r]}; *(LAS f32x4v*)(q + 4) = (f32x4v){o[4][r], o[5][r], o[6][r], o[7][r]}; } }
        __syncthreads();
        if (dir == 0) {
            const f32x4v g0 = *(const GAS f32x4v*)(gain + h * 128 + 8 * tl), g1 = *(const GAS f32x4v*)(gain + h * 128 + 8 * tl + 4);
#pragma unroll
            for (int r = 0; r < 4; ++r) { const LAS float* q = OX + (i * 16 + 4 * kq + r) * 128 + 8 * tl;
                const f32x4v x0 = *(const LAS f32x4v*)q, x1 = *(const LAS f32x4v*)(q + 4);
                float v[8] = {o[0][r] + x0[0], o[1][r] + x0[1], o[2][r] + x0[2], o[3][r] + x0[3], o[4][r] + x1[0], o[5][r] + x1[1], o[6][r] + x1[2], o[7][r] + x1[3]};
                float ss = 0.f;
#pragma unroll
                for (int T = 0; T < 8; ++T) ss += v[T] * v[T];
                ss += __shfl_xor(ss, 1); ss += __shfl_xor(ss, 2); ss += __shfl_xor(ss, 4); ss += __shfl_xor(ss, 8);
                const float rstd = 1.0f / sqrtf(ss * (1.0f / 128.0f) + EPS);
                const size_t orow = (size_t)(r0 + 16 * i + 4 * kq + r);
                float sg[8]; v8(*(const GAS v4u*)(P + orow * PW + O_CG + h * 128 + 8 * tl), sg);
                v4u wv; wv.x = pk2(v[0] * rstd * g0[0] * sg[0], v[1] * rstd * g0[1] * sg[1]); wv.y = pk2(v[2] * rstd * g0[2] * sg[2], v[3] * rstd * g0[3] * sg[3]);
                wv.z = pk2(v[4] * rstd * g1[0] * sg[4], v[5] * rstd * g1[1] * sg[5]); wv.w = pk2(v[6] * rstd * g1[2] * sg[6], v[7] * rstd * g1[3] * sg[7]);
                *(GAS v4u*)(Y + orow * DM + 1536 + h * 128 + 8 * tl) = wv; }
        }
    }
    __syncthreads();
}

constexpr int RS_OFF = MISC_OFF + 128;
static_assert(RS_OFF + 13 * 256 * 4 <= LDS_BYTES, "rstd table");
template <class Sched> __device__ __forceinline__ void rstd_prepass(Frame& F, const Sched& S, const float* ssq, int ubase = 0, const float* rowscale = nullptr) {
    const int lane = lane_id(), tid = F.wave * 64 + lane, row = tid >> 1, half = tid & 1;
    LAS float* RS = (LAS float*)(F.lds + RS_OFF) + ubase * 256;
    pg8::Unit u;
    for (int i = 0; S.next(i, u); ++i) {
        const float* p = ssq + (size_t)(u.pm * 256 + row) * 32 + 16 * half;
        const f32x4 a = *(const GAS f32x4*)p, b = *(const GAS f32x4*)(p + 4), c = *(const GAS f32x4*)(p + 8), d = *(const GAS f32x4*)(p + 12);
        float s = (((a[0] + a[1]) + (a[2] + a[3])) + ((b[0] + b[1]) + (b[2] + b[3]))) + (((c[0] + c[1]) + (c[2] + c[3])) + ((d[0] + d[1]) + (d[2] + d[3])));
        s += __shfl_xor(s, 1);
        if (half == 0) RS[i * 256 + row] = (1.0f / sqrtf(s * (1.0f / 2048.0f) + EPS)) * (rowscale ? rowscale[u.pm * 256 + row] : 1.0f);
    }
    __syncthreads();
}
constexpr int NPH = 12;
typedef const __attribute__((address_space(4))) Args* ArgP;
__device__ __forceinline__ ArgP argp() { ArgP p = (ArgP)__builtin_amdgcn_kernarg_segment_ptr(); asm volatile("" : "+s"(p)); return p; }
#define PH_BEGIN const ArgP A = argp(); const int lq = opq_s(l), sq = opq_s(s); unsigned char* const ws = A->ws; \
    const bf16* const Wl = (const bf16*)(ws + WS_W) + (size_t)lq * E_LAYER; float* const xs = A->out + (size_t)sq * MS * DM; \
    bf16* const XN = (bf16*)(ws + WS_XN); bf16* const PROJ = (bf16*)(ws + WS_PROJ); bf16* const ACT = (bf16*)(ws + WS_PROJ); bf16* const Y = (bf16*)(ws + WS_Y); \
    float* const OC = (float*)(ws + WS_OC); const float* const tab = (const float*)(ws + WS_TAB); const int Ts = sq == 0 ? 8192 : 2048; \
    bf16* const MG = (bf16*)(ws + WS_MG); float* const SSQ = (float*)(ws + WS_SSQ); \
    (void)Wl; (void)xs; (void)XN; (void)PROJ; (void)ACT; (void)Y; (void)OC; (void)tab; (void)Ts; (void)MG; (void)SSQ;
__global__ void __launch_bounds__(512, 2) fwd(Args args_unused) {
    extern __shared__ __attribute__((aligned(16))) unsigned char lds[];
    Frame F;
    F.lds = (LAS unsigned char*)lds;
    F.wave = __builtin_amdgcn_readfirstlane(threadIdx.x >> 6);
    F.G = gridDim.x; F.gw = blockIdx.x * 8 + F.wave; F.NGW = F.G * 8;
    volatile LAS unsigned* MISC = (volatile LAS unsigned*)(F.lds + MISC_OFF);
    for (int u = F.wave * 64 + lane_id(); u < (LDS_BYTES - LDSCTL_OFF) / 4; u += 512) ((LAS unsigned*)(F.lds + LDSCTL_OFF))[u] = 0u;
    __syncthreads();
    const ArgP A0 = argp();
    const int use_bar = A0->use_bar;
    XcdBarrier bar; bar.bar = (unsigned*)(A0->ws + WS_CTL) + CW_BAR; bar.x = 0; bar.st = nullptr;
    if (use_bar) bar = xcd_barrier_post((unsigned*)(A0->ws + WS_CTL) + CW_BAR, MISC + 8, F.wave == 0 && lane_id() == 0);
#define GRID_BAR() do { if (opq_s(use_bar)) xcd_barrier(bar, F.wave == 0 && lane_id() == 0); } while (0)
    LAS unsigned char* ring = F.lds + RING_OFF;

    if (A0->do_pro) { prologue(F, A0); GRID_BAR(); quant_gate_weights(F, A0); GRID_BAR(); }

    const int plo = A0->ph_lo, phi = A0->ph_hi, l_lo = A0->l_lo, l_hi = A0->l_hi, s_hi = A0->s_hi;
#define IN(k) (opq_s(plo) <= (k) && (k) < opq_s(phi))
    for (int s = A0->s_lo; s < s_hi; ++s) {
        for (int l = l_lo; l < l_hi; ++l) {
            if (IN(0)) { PH_BEGIN if (lq == 0) { const float* xin = sq == 0 ? A->in[I_XP] : A->in[I_XS] + (size_t)(sq - 1) * MS * DM; cast_rows(F, xin, XN, SSQ, MS); GRID_BAR(); } }
            if (IN(1)) { PH_BEGIN
                if (lq == 0) { quant_rows(F, XN, ws + WS_OC, (float*)(ws + WS_OC + XQ_SCALE), MS); GRID_BAR(); }
                const unsigned char* wq = (const unsigned char*)(Wl + EO_WGU1);
                pg8::Gemm g{(const pg8::bf16_t*)(ws + WS_OC), (const pg8::bf16_t*)wq, MS, 2 * DFF, DM / 2, DM / 2, DM / 2}; pg8::StaticOrder S; S.init(MS, 2 * DFF, F.G, (int)blockIdx.x);
                rstd_prepass(F, S, SSQ, 0, (const float*)(ws + WS_OC + XQ_SCALE)); pg8::EpiSwiGLUQ E{ACT, DFF, (const float*)(wq + WGUQ_SCALE), (const LAS float*)(F.lds + RS_OFF)};
                pg8::gemm_phase<pg8::EpiSwiGLUQ, pg8::StaticOrder, true, true, false, true>(ring, g, S, E, F.wave); GRID_BAR(); }
            if (IN(2)) { PH_BEGIN pg8::Gemm g{ACT, Wl + EO_WD1, MS, DM, DFF, DFF, DFF}; pg8::StaticOrder S; S.init(MS, DM, F.G, (int)blockIdx.x);
                if (F.wave == 0 && lane_id() == 0) MISC[11] += 1u; __syncthreads(); const unsigned ptgt = 8u * (unsigned)__builtin_amdgcn_readfirstlane((int)MISC[11]);
                pg8::EpiResid E{XN, DM, 0.5f, SSQ, (unsigned*)(ws + WS_CTL), ptgt, ws + WS_OC, (float*)(ws + WS_OC + XQ_SCALE), (LAS unsigned*)(F.lds + RS_OFF)}; pg8::gemm_phase<pg8::EpiResid, pg8::StaticOrder, true, true>(ring, g, S, E, F.wave); GRID_BAR(); }
            if (IN(3)) {
                for (int st = 0; st < 2; ++st) {
                    const int which = __builtin_amdgcn_readfirstlane((st + (int)(blockIdx.x & 1u)) & 1);
                    if (which == 0) { PH_BEGIN
                        pg8::Gemm g{XN, Wl + EO_WIN, MS, O_GA, DM, DM, DM}; pg8::StaticOrder S; S.init(MS, O_GA, F.G, (int)blockIdx.x);
                        rstd_prepass(F, S, SSQ); pg8::EpiProj E{PROJ, PW, tab + TAB_LB + (0 * NLAYER + lq) * 512, tab + TAB_LB + (1 * NLAYER + lq) * 512, (const LAS float*)(F.lds + RS_OFF)};
                        pg8::gemm_phase<pg8::EpiProj, pg8::StaticOrder, true, true>(ring, g, S, E, F.wave);
                    } else { PH_BEGIN
                        const unsigned char* wq = ws + WS_WQ + (size_t)lq * WQ_LAYER;
                        pg8::Gemm g{(const pg8::bf16_t*)(ws + WS_OC), (const pg8::bf16_t*)wq, MS, 3 * DM, DM / 2, DM / 2, DM / 2}; pg8::GateOrder S; S.init(MS, 3 * DM, F.G, (int)blockIdx.x);
                        rstd_prepass(F, S, SSQ, 6, (const float*)(ws + WS_OC + XQ_SCALE));
                        pg8::EpiGateQ E{(unsigned char*)(PROJ + O_GA), PW * 2, (const float*)(wq + WQ_SCALE), (const LAS float*)(F.lds + RS_OFF) + 6 * 256};
                        pg8::gemm_phase<pg8::EpiGateQ, pg8::GateOrder, true, true, false, true>(ring, g, S, E, F.wave);
                    }
                    __syncthreads();
                }
                GRID_BAR(); }
            if (IN(4)) { PH_BEGIN
                for (int st = 0; st < 3; ++st) {
                    const int which = __builtin_amdgcn_readfirstlane((st + (int)(blockIdx.x & 1u)) % 3);
                    if (which == 0) hg_h1(F, PROJ, (bf16*)OC, (float*)(ws + WS_MG));
                    else if (which == 1) mixA_mfma(F, PROJ, Y, tab, A->in[I_SINK] + lq * 8, Ts);
                    else mixB_mfma(F, PROJ, Y, A->in[I_NAB] + (size_t)lq * 4 * 15 * 31, Ts);
                }
                GRID_BAR(); }
            if (IN(5)) { PH_BEGIN hg_scan(F, (bf16*)OC, (const float*)(ws + WS_MG), MS / Ts, Ts / 64); GRID_BAR(); }
            if (IN(6)) { PH_BEGIN hg_h3(F, PROJ, (const bf16*)OC, Y, A->in[I_HN] + lq * 512); GRID_BAR(); }
            if (IN(7)) { PH_BEGIN pg8::SubOrder S; S.init(MS, DM, F.G, (int)blockIdx.x);
                pg8::Gemm g{Y, Wl + EO_WBR, MS, DM, DM, DM, DM}; pg8::EpiMerged E{PROJ, PW, MG, DM};
                pg8::gemm_phase<pg8::EpiMerged, pg8::SubOrder, true, true, true>(ring, g, S, E, F.wave); GRID_BAR(); }
            if (IN(8)) { PH_BEGIN pg8::Gemm g{MG, Wl + EO_WOUT, MS, DM, DM, DM, DM}; pg8::StaticOrder S; S.init(MS, DM, F.G, (int)blockIdx.x);
                if (F.wave == 0 && lane_id() == 0) MISC[11] += 1u; __syncthreads(); const unsigned ptgt = 8u * (unsigned)__builtin_amdgcn_readfirstlane((int)MISC[11]);
                pg8::EpiResid E{XN, DM, 1.0f, SSQ, (unsigned*)(ws + WS_CTL), ptgt, ws + WS_OC, (float*)(ws + WS_OC + XQ_SCALE), (LAS unsigned*)(F.lds + RS_OFF)}; pg8::gemm_phase<pg8::EpiResid, pg8::StaticOrder, true, true>(ring, g, S, E, F.wave); GRID_BAR(); }
            if (IN(9)) { PH_BEGIN
                const unsigned char* wq = (const unsigned char*)(Wl + EO_WGU2);
                pg8::Gemm g{(const pg8::bf16_t*)(ws + WS_OC), (const pg8::bf16_t*)wq, MS, 2 * DFF, DM / 2, DM / 2, DM / 2}; pg8::StaticOrder S; S.init(MS, 2 * DFF, F.G, (int)blockIdx.x);
                rstd_prepass(F, S, SSQ, 0, (const float*)(ws + WS_OC + XQ_SCALE)); pg8::EpiSwiGLUQ E{ACT, DFF, (const float*)(wq + WGUQ_SCALE), (const LAS float*)(F.lds + RS_OFF)};
                pg8::gemm_phase<pg8::EpiSwiGLUQ, pg8::StaticOrder, true, true, false, true>(ring, g, S, E, F.wave); GRID_BAR(); }
            if (IN(10)) { PH_BEGIN pg8::Gemm g{ACT, Wl + EO_WD2, MS, DM, DFF, DFF, DFF}; pg8::StaticOrder S; S.init(MS, DM, F.G, (int)blockIdx.x);
                if (F.wave == 0 && lane_id() == 0) MISC[11] += 1u; __syncthreads(); const unsigned ptgt = 8u * (unsigned)__builtin_amdgcn_readfirstlane((int)MISC[11]);
                pg8::EpiResid E{XN, DM, 0.5f, SSQ, (unsigned*)(ws + WS_CTL), ptgt, ws + WS_OC, (float*)(ws + WS_OC + XQ_SCALE), (LAS unsigned*)(F.lds + RS_OFF)}; pg8::gemm_phase<pg8::EpiResid, pg8::StaticOrder, true, true>(ring, g, S, E, F.wave); GRID_BAR(); }
            if (IN(11)) { PH_BEGIN if (lq == NLAYER - 1) { final_rows(F, XN, A->in[I_FN], xs, MS); GRID_BAR(); } }
        }
    }
#undef IN
}

extern "C" void kernel_launch(void* const* d_in, const int* in_sizes, int n_in, void* d_out, int out_size, void* d_ws, size_t ws_size, hipStream_t stream) {
    static int grid = 0;
    if (grid == 0) {
        if (n_in != 22 || out_size != MTOT * DM || ws_size < WS_END) { fprintf(stderr, "kernel_launch: unexpected shapes (n_in %d out %d ws %zu, need ws >= %zu)\n", n_in, out_size, ws_size, (size_t)WS_END); grid = -1; return; }
        int dev = 0, cus = 0, per_cu = 0;
        if (hipGetDevice(&dev) != hipSuccess || hipDeviceGetAttribute(&cus, hipDeviceAttributeMultiprocessorCount, dev) != hipSuccess) { grid = -1; return; }
        if (hipFuncSetAttribute((const void*)fwd, hipFuncAttributeMaxDynamicSharedMemorySize, LDS_BYTES) != hipSuccess) { fprintf(stderr, "kernel_launch: hipFuncSetAttribute failed\n"); grid = -1; return; }
        if (hipOccupancyMaxActiveBlocksPerMultiprocessor(&per_cu, (const void*)fwd, 512, LDS_BYTES) != hipSuccess || per_cu < 1) fprintf(stderr, "kernel_launch: occupancy query reports %d\n", per_cu);
        (void)hipGetLastError();
        grid = cus;
    }
    if (grid < 0) return;
    (void)hipMemsetAsync((char*)d_ws + WS_CTL, 0, CTL_ZERO_BYTES, stream);
    Args a{};
    for (int i = 0; i < 22; ++i) a.in[i] = (const float*)d_in[i];
    a.out = (float*)d_out; a.ws = (unsigned char*)d_ws;
#if MK_ONE_LAUNCH
    a.l_lo = 0; a.l_hi = NLAYER; a.s_lo = 0; a.s_hi = NSLICE; a.ph_lo = 0; a.ph_hi = NPH; a.do_pro = 1; a.do_fin = 1; a.use_bar = 1;
    hipLaunchKernelGGL(fwd, dim3(grid), dim3(512), LDS_BYTES, stream, a);
#else
    a.use_bar = 0;
    a.do_pro = 1; a.do_fin = 0; a.l_lo = a.l_hi = 0; a.s_lo = a.s_hi = 0; a.ph_lo = a.ph_hi = 0;
    hipLaunchKernelGGL(fwd, dim3(grid), dim3(512), LDS_BYTES, stream, a);
    a.do_pro = 0;
    for (int s = 0; s < NSLICE; ++s) for (int l = 0; l < NLAYER; ++l) for (int p = 0; p < NPH; ++p) {
        a.l_lo = l; a.l_hi = l + 1; a.s_lo = s; a.s_hi = s + 1; a.ph_lo = p; a.ph_hi = p + 1;
        hipLaunchKernelGGL(fwd, dim3(grid), dim3(512), LDS_BYTES, stream, a);
    }
    a.do_fin = 1; a.l_lo = a.l_hi = 0; a.s_lo = a.s_hi = 0; a.ph_lo = a.ph_hi = 0;
    hipLaunchKernelGGL(fwd, dim3(grid), dim3(512), LDS_BYTES, stream, a);
#endif
    const hipError_t le = hipPeekAtLastError();
    if (le != hipSuccess) fprintf(stderr, "kernel_launch: launch failed: %s\n", hipGetErrorName(le));
}
```

```cpp
#include <hip/hip_runtime.h>
#include <cstdio>
#include <cstdint>

#ifndef MK_ONE_LAUNCH
#define MK_ONE_LAUNCH 1
#endif

#define GAS __attribute__((address_space(1)))
#define LAS __attribute__((address_space(3)))
typedef unsigned short bf16;
typedef unsigned v4u __attribute__((ext_vector_type(4)));
typedef unsigned v2u __attribute__((ext_vector_type(2)));
typedef float f32x4 __attribute__((ext_vector_type(4)));
typedef float f32x2 __attribute__((ext_vector_type(2)));
typedef short bf16x8 __attribute__((ext_vector_type(8)));
typedef GAS unsigned gu32;

constexpr int DM = 2048, DFF = 5632, PW = 11776, NLAYER = 4;
constexpr int MS = 16384, NSLICE = 3, MTOT = 49152;
constexpr float EPS = 1e-6f;
constexpr float LOG2E = 1.4426950408889634f, LN2 = 0.6931471805599453f;
constexpr float QSCALE = 0.08838834764831845f * LOG2E;
constexpr float CQSCALE = 0.08838834764831845f;
constexpr int O_AQ = 0, O_AK = 1024, O_AV = 1280, O_BQ = 1536, O_BK = 2048, O_BV = 2560, O_CFF = 3072, O_CFB = 3584, O_CI = 4096, O_CQ = 4608, O_CG = 5120, O_GA = 5632, O_GB = 7680, O_GC = 9728;

constexpr size_t MiB = 1u << 20;
constexpr size_t WS_CTL = 0, CTL_ZERO_BYTES = 1 * MiB;
constexpr size_t WS_TAB = 1 * MiB;
constexpr size_t WS_W = 2 * MiB;
constexpr size_t E_WGU = (size_t)2 * DFF * DM, E_WD = (size_t)DM * DFF, E_WIN = (size_t)PW * DM, E_WBR = (size_t)DM * DM, E_WOUT = (size_t)DM * DM;
constexpr size_t EO_WGU1 = 0, EO_WD1 = EO_WGU1 + E_WGU, EO_WIN = EO_WD1 + E_WD, EO_WBR = EO_WIN + E_WIN, EO_WOUT = EO_WBR + E_WBR, EO_WGU2 = EO_WOUT + E_WOUT, EO_WD2 = EO_WGU2 + E_WGU, E_LAYER = EO_WD2 + E_WD;
static_assert(E_LAYER * 2 == 194 * MiB, "weights per layer");
constexpr size_t WS_XN = WS_W + 4 * 194 * MiB;
constexpr size_t WS_PROJ = WS_XN + 64 * MiB;
constexpr size_t WS_Y = WS_PROJ + 368 * MiB;
constexpr size_t WS_OC = WS_Y + 64 * MiB;
constexpr size_t WS_MG = WS_OC + 128 * MiB;
constexpr size_t WS_SSQ = WS_MG + 64 * MiB;
constexpr size_t WS_WQ = WS_SSQ + 2 * MiB;
constexpr size_t WQ_LAYER = 13 * MiB, WQ_SCALE = 12 * MiB;
constexpr size_t WS_END = WS_WQ + 4 * WQ_LAYER;
constexpr size_t XQ_SCALE = 32 * MiB;
constexpr size_t WGUQ_SCALE = 22 * MiB;
static_assert(8 * E_WGU * 2 <= 368 * MiB && (size_t)2 * DFF * DM <= WGUQ_SCALE, "gate|up temporaries / int8 slot");
constexpr int CW_RMAX = 65536;
constexpr int CW_PCNT = 2048;
constexpr int CW_QCNT = 1024;
constexpr int TAB_T5 = 0, TAB_LB = 8 * 260;
constexpr int CW_TMO = 0, CW_CODE = 1, CW_BAR = 4096;

constexpr int RING_OFF = 0, RING_BYTES = 131072;
constexpr int LDSCTL_OFF = RING_BYTES, MISC_OFF = LDSCTL_OFF + 320;
constexpr int LDS_BYTES = 147456;

#define LDS_WAIT() asm volatile("s_waitcnt lgkmcnt(0)" ::: "memory")
#define VM_WAIT() asm volatile("s_waitcnt vmcnt(0)" ::: "memory")
__device__ __forceinline__ unsigned f2bf(float f) { unsigned u = __builtin_bit_cast(unsigned, f); return (u + 0x7fffu + ((u >> 16) & 1u)) >> 16; }
__device__ __forceinline__ unsigned pk2(float lo, float hi) { return f2bf(lo) | (f2bf(hi) << 16); }
__device__ __forceinline__ float bflo(unsigned w) { return __builtin_bit_cast(float, w << 16); }
__device__ __forceinline__ float bfhi(unsigned w) { return __builtin_bit_cast(float, w & 0xffff0000u); }
__device__ __forceinline__ float bf2f(bf16 b) { return __builtin_bit_cast(float, ((unsigned)b) << 16); }
__device__ __forceinline__ void v8(const v4u w, float (&o)[8]) { o[0] = bflo(w.x); o[1] = bfhi(w.x); o[2] = bflo(w.y); o[3] = bfhi(w.y); o[4] = bflo(w.z); o[5] = bfhi(w.z); o[6] = bflo(w.w); o[7] = bfhi(w.w); }
__device__ __forceinline__ float fexp2(float x) { return __builtin_amdgcn_exp2f(x); }
__device__ __forceinline__ float frcp(float x) { return __builtin_amdgcn_rcpf(x); }
__device__ __forceinline__ float sigmoidf_(float x) { return frcp(1.0f + fexp2(-x * LOG2E)); }
__device__ __forceinline__ float wave_sum(float v) {
#pragma unroll
    for (int o = 1; o < 64; o <<= 1) v += __shfl_xor(v, o);
    return v;
}
__device__ __forceinline__ float wave_max(float v) {
#pragma unroll
    for (int o = 1; o < 64; o <<= 1) v = fmaxf(v, __shfl_xor(v, o));
    return v;
}

__device__ __forceinline__ int opq_v(int x) { asm volatile("" : "+v"(x)); return x; }
__device__ __forceinline__ int opq_s(int x) { asm volatile("" : "+s"(x)); return x; }
__device__ __forceinline__ int lane_id() { const unsigned m = (unsigned)opq_s(-1); return (int)__builtin_amdgcn_mbcnt_hi(m, __builtin_amdgcn_mbcnt_lo(m, 0u)); }

namespace pg8 {
#define PG8_LAS __attribute__((address_space(3)))
typedef unsigned short bf16_t;
typedef unsigned u32x4 __attribute__((ext_vector_type(4)));
typedef unsigned u32x2 __attribute__((ext_vector_type(2)));
typedef int i32x4 __attribute__((ext_vector_type(4)));
typedef unsigned short u16x2 __attribute__((ext_vector_type(2)));
constexpr int BM = 256, BK = 64, HALF = 128, HTB = HALF * BK * 2, STAGE_BYTES = 8 * HTB, NXCD = 8, WGM = 4;
__host__ __device__ __forceinline__ int lds_byte(int r, int c) { const int st = (r >> 4) * 2 + (c >> 5), rr = r & 15, cc = c & 31, ob = rr * 64 + cc * 2; return st * 1024 + (ob ^ (((ob >> 9) & 1) << 5)); }
__host__ __device__ __forceinline__ void stage_rc(int b, int& R, int& C) { const int st = b / 1024, sb = b % 1024, swz = sb ^ (((sb >> 9) & 1) << 5); R = (st >> 1) * 16 + swz / 64; C = (st & 1) * 32 + (swz % 64) / 2; }
__host__ __device__ __forceinline__ int perm32(int rho) { const int n = rho >> 4, i = rho & 15; return 8 * (i >> 2) + 4 * n + (i & 3); }
struct Unit { int pm, pn, sub; };
struct Gemm { const bf16_t* A; const bf16_t* Bt; int M, N, K, lda, ldb; };
struct StaticOrder {
    int nM, nN, nwg, G, c;
    __host__ __device__ void init(int M, int N, int G_, int c_) { nM = M / BM; nN = N / BM; nwg = nM * nN; G = G_; c = c_; }
    __host__ __device__ bool next(int i, Unit& u) const { const long L = (long)i * G + c; if (L >= nwg) return false; at(L, u); return true; }
    __host__ __device__ void at(long L, Unit& u) const {
        int wgid = (int)L; { const int q = nwg / NXCD, r = nwg % NXCD, xcd = wgid % NXCD, off = wgid / NXCD; wgid = (xcd < r ? xcd * (q + 1) : r * (q + 1) + (xcd - r) * q) + off; }
        const int nig = WGM * nN, gid = wgid / nig, fm = gid * WGM, gsz = (nM - fm) < WGM ? (nM - fm) : WGM;
        u.pm = fm + ((wgid % nig) % gsz); u.pn = (wgid % nig) / gsz; u.sub = 0;
    }
    __device__ __forceinline__ void a_ready(const Unit&) const {}
    __device__ __forceinline__ void done(const Unit&) const {}
};
struct GateOrder : StaticOrder {
    __host__ __device__ bool next(int i, Unit& u) const {
        if (G != 256 || nwg != 1536) return StaticOrder::next(i, u);
        if (i < 5) { at((long)i * 256 + c, u); return true; }
        if (c < 128 || i > 6) return false;
        at((long)(1280 + 2 * (c - 128) + (i - 5)), u); return true;
    }
};
struct SubOrder : StaticOrder {
    __device__ __forceinline__ bool next(int i, Unit& u) const { const int t3 = i / 3; if (!StaticOrder::next(t3, u)) return false; u.sub = i - 3 * t3; return true; }
};
typedef __bf16 bf16x2_t __attribute__((ext_vector_type(2)));
__device__ __forceinline__ unsigned cvt_pk_bf16(float lo, float hi) { const f32x2 v = {lo, hi}; const bf16x2_t b = __builtin_convertvector(v, bf16x2_t); return __builtin_bit_cast(unsigned, b); }
typedef f32x4 Acc[2][2][4][2];

__device__ __forceinline__ float silu_(float x) { return x * frcp(1.0f + fexp2(-x * LOG2E)); }

__device__ __forceinline__ void row_rstd(const PG8_LAS float* rsl, int ui, int wr, int fr, float (&rs)[2][4]) {
#pragma unroll
    for (int ai = 0; ai < 2; ++ai)
#pragma unroll
        for (int m = 0; m < 4; ++m) rs[ai][m] = rsl[ui * 256 + ai * HALF + wr * 64 + m * 16 + fr];
}
struct EpiSwiGLU {
    static constexpr bool PERM = true, AFTER_DRAIN = false;
    bf16_t* O; int ldc; const PG8_LAS float* rsl;
    __device__ __forceinline__ void operator()(const Acc& acc, const Unit& u, int ui, int wr, int wc, int fr, int fq) const {
        const int row0 = u.pm * BM + wr * 64 + fr, col0 = u.pn * HALF + wc * 32 + 8 * fq;
        float rs[2][4]; row_rstd(rsl, ui, wr, fr, rs);
#pragma unroll
        for (int ai = 0; ai < 2; ++ai)
#pragma unroll
            for (int m = 0; m < 4; ++m) {
                bf16_t* rowp = O + (size_t)(row0 + ai * HALF + m * 16) * ldc + col0; const float r = rs[ai][m];
                const f32x4 g0 = acc[ai][0][m][0] * r, g1 = acc[ai][0][m][1] * r, u0 = acc[ai][1][m][0] * r, u1 = acc[ai][1][m][1] * r;
                u32x4 w;
                w.x = cvt_pk_bf16(silu_(g0[0]) * u0[0], silu_(g0[1]) * u0[1]); w.y = cvt_pk_bf16(silu_(g0[2]) * u0[2], silu_(g0[3]) * u0[3]);
                w.z = cvt_pk_bf16(silu_(g1[0]) * u1[0], silu_(g1[1]) * u1[1]); w.w = cvt_pk_bf16(silu_(g1[2]) * u1[2], silu_(g1[3]) * u1[3]);
                *(GAS u32x4*)rowp = w;
            }
    }
};
struct EpiSwiGLUQ {
    static constexpr bool PERM = true, AFTER_DRAIN = false;
    bf16_t* O; int ldc; const float* wsc; const PG8_LAS float* rsl;
    __device__ __forceinline__ void operator()(const Acc& acc, const Unit& u, int ui, int wr, int wc, int fr, int fq) const {
        const int row0 = u.pm * BM + wr * 64 + fr, col0 = u.pn * HALF + wc * 32 + 8 * fq;
        float rs[2][4]; row_rstd(rsl, ui, wr, fr, rs);
        const float* sp = wsc + u.pn * BM + wc * 32 + 8 * fq;
        const f32x4 cg0 = *(const GAS f32x4*)sp * -LOG2E, cg1 = *(const GAS f32x4*)(sp + 4) * -LOG2E, cu0 = *(const GAS f32x4*)(sp + HALF) * -LN2, cu1 = *(const GAS f32x4*)(sp + HALF + 4) * -LN2;
#pragma unroll
        for (int ai = 0; ai < 2; ++ai)
#pragma unroll
            for (int m = 0; m < 4; ++m) {
                bf16_t* rowp = O + (size_t)(row0 + ai * HALF + m * 16) * ldc + col0; const float r = rs[ai][m];
                const f32x4 g0 = __builtin_convertvector(__builtin_bit_cast(i32x4, acc[ai][0][m][0]), f32x4) * cg0 * r, g1 = __builtin_convertvector(__builtin_bit_cast(i32x4, acc[ai][0][m][1]), f32x4) * cg1 * r;
                const f32x4 u0 = __builtin_convertvector(__builtin_bit_cast(i32x4, acc[ai][1][m][0]), f32x4) * cu0 * r, u1 = __builtin_convertvector(__builtin_bit_cast(i32x4, acc[ai][1][m][1]), f32x4) * cu1 * r;
                float y0[4], y1[4];
#pragma unroll
                for (int i = 0; i < 4; ++i) { y0[i] = g0[i] * frcp(1.0f + fexp2(g0[i])) * u0[i]; y1[i] = g1[i] * frcp(1.0f + fexp2(g1[i])) * u1[i]; }
                u32x4 w;
                w.x = cvt_pk_bf16(y0[0], y0[1]); w.y = cvt_pk_bf16(y0[2], y0[3]); w.z = cvt_pk_bf16(y1[0], y1[1]); w.w = cvt_pk_bf16(y1[2], y1[3]);
                *(GAS u32x4*)rowp = w;
            }
    }
};
struct EpiResid {
    static constexpr bool PERM = true, AFTER_DRAIN = false;
    bf16_t* x; int ldc; float scale; float* ssq;
    unsigned* ctl; unsigned target; unsigned char* xq; float* xsc; PG8_LAS unsigned* scr;
    __device__ __forceinline__ void operator()(const Acc& acc, const Unit& u, int ui, int wr, int wc, int fr, int fq) const {
        const int row0 = u.pm * BM + wr * 64 + fr, col0 = u.pn * BM + wc * 32 + 8 * fq;
        bf16_t* const x = this->x; float* const ssq = this->ssq; const float scale = this->scale; const int ldc = this->ldc;
        u32x4 wk[2][4][2];
        unsigned mxr[2][4];
#pragma unroll
        for (int ai = 0; ai < 2; ++ai) {
            u32x4 xv[4][2];
#pragma unroll
            for (int m = 0; m < 4; ++m)
#pragma unroll
                for (int bj = 0; bj < 2; ++bj) xv[m][bj] = *(const GAS u32x4*)(x + (size_t)(row0 + ai * HALF + m * 16) * ldc + col0 + bj * HALF);
            asm volatile("" ::: "memory");
#pragma unroll
            for (int m = 0; m < 4; ++m) {
                const size_t off = (size_t)(row0 + ai * HALF + m * 16) * ldc + col0; float s = 0.f; u16x2 mx2 = {0, 0};
#pragma unroll
                for (int bj = 0; bj < 2; ++bj) {
                    const u32x4 w0 = xv[m][bj]; const f32x4 a0 = acc[ai][bj][m][0] * scale, a1 = acc[ai][bj][m][1] * scale;
                    const float v0 = bflo(w0.x) + a0[0], v1 = bfhi(w0.x) + a0[1], v2 = bflo(w0.y) + a0[2], v3 = bfhi(w0.y) + a0[3];
                    const float v4 = bflo(w0.z) + a1[0], v5 = bfhi(w0.z) + a1[1], v6 = bflo(w0.w) + a1[2], v7 = bfhi(w0.w) + a1[3];
                    u32x4 w; w.x = cvt_pk_bf16(v0, v1); w.y = cvt_pk_bf16(v2, v3); w.z = cvt_pk_bf16(v4, v5); w.w = cvt_pk_bf16(v6, v7);
                    *(GAS u32x4*)(x + off + bj * HALF) = w; wk[ai][m][bj] = w;
#pragma unroll
                    for (int e2 = 0; e2 < 4; ++e2) mx2 = __builtin_elementwise_max(mx2, __builtin_bit_cast(u16x2, w[e2] & 0x7fff7fffu));
                    s += ((v0 * v0 + v1 * v1) + (v2 * v2 + v3 * v3)) + ((v4 * v4 + v5 * v5) + (v6 * v6 + v7 * v7));
                }
                s += __shfl_xor(s, 16); s += __shfl_xor(s, 32);
                if (fq == 0) ssq[(size_t)(row0 + ai * HALF + m * 16) * 32 + u.pn * 4 + wc] = s;
                unsigned mh = mx2.x > mx2.y ? (unsigned)mx2.x : (unsigned)mx2.y;
                { const unsigned o = (unsigned)__shfl_xor((int)mh, 16); mh = o > mh ? o : mh; } { const unsigned o = (unsigned)__shfl_xor((int)mh, 32); mh = o > mh ? o : mh; }
                mxr[ai][m] = mh;
            }
            asm volatile("" ::: "memory");
        }
        {
            const int wave = wr * 4 + wc, lane = fq * 16 + fr, tid = wave * 64 + lane;
            PG8_LAS unsigned* const PM = this->scr; PG8_LAS float* const SC = (PG8_LAS float*)(this->scr + 1024);
            const unsigned tg = this->target; unsigned* const cur = this->ctl + CW_RMAX + ((tg >> 3) & 1u) * 16384 + u.pm * BM; unsigned* const nxt = this->ctl + CW_RMAX + (((tg >> 3) & 1u) ^ 1u) * 16384 + u.pm * BM;
            if (fq == 0) {
#pragma unroll
                for (int ai = 0; ai < 2; ++ai)
#pragma unroll
                    for (int m = 0; m < 4; ++m) PM[wc * 256 + ai * HALF + wr * 64 + m * 16 + fr] = mxr[ai][m];
            }
            __syncthreads();
            if (tid < 256) { const unsigned a = PM[tid], b = PM[256 + tid], c = PM[512 + tid], d = PM[768 + tid]; const unsigned ab = a > b ? a : b, cd = c > d ? c : d;
                (void)__hip_atomic_fetch_max(cur + tid, (ab > cd ? ab : cd) << 16, __ATOMIC_RELAXED, __HIP_MEMORY_SCOPE_AGENT); }
            asm volatile("s_waitcnt vmcnt(0)" ::: "memory"); __builtin_amdgcn_s_barrier();
            if (tid == 0) { unsigned* const pc = this->ctl + CW_PCNT + u.pm;
                (void)__hip_atomic_fetch_add(pc, 1u, __ATOMIC_RELAXED, __HIP_MEMORY_SCOPE_AGENT);
                unsigned sp = 0u; while (__hip_atomic_load(pc, __ATOMIC_RELAXED, __HIP_MEMORY_SCOPE_AGENT) < tg && ++sp < (1u << 22)) __builtin_amdgcn_s_sleep(1); }
            __builtin_amdgcn_s_barrier();
            if (tid < 256) { const unsigned mb = __hip_atomic_load(cur + tid, __ATOMIC_RELAXED, __HIP_MEMORY_SCOPE_AGENT);
                const float sc = mb ? __builtin_bit_cast(float, mb) * (1.0f / 127.0f) : 1.0f; SC[tid] = sc;
                if (u.pn == 0) this->xsc[u.pm * BM + tid] = sc;
                __hip_atomic_store(nxt + tid, 0u, __ATOMIC_RELAXED, __HIP_MEMORY_SCOPE_AGENT); }
            __syncthreads();
            unsigned char* const xq = this->xq;
#pragma unroll
            for (int ai = 0; ai < 2; ++ai)
#pragma unroll
                for (int m = 0; m < 4; ++m) {
                    const int rl = ai * HALF + wr * 64 + m * 16 + fr; const float inv = 1.0f / SC[rl];
                    unsigned char* const rp = xq + (size_t)(u.pm * BM + rl) * 2048 + col0;
#pragma unroll
                    for (int bj = 0; bj < 2; ++bj) {
                        const u32x4 w = wk[ai][m][bj]; u32x2 q;
#pragma unroll
                        for (int h = 0; h < 2; ++h) {
                            const unsigned a = w[2 * h], b = w[2 * h + 1];
                            const int q0 = (int)rintf(bflo(a) * inv), q1 = (int)rintf(bfhi(a) * inv), q2 = (int)rintf(bflo(b) * inv), q3 = (int)rintf(bfhi(b) * inv);
                            q[h] = (unsigned)(q0 & 255) | ((unsigned)(q1 & 255) << 8) | ((unsigned)(q2 & 255) << 16) | ((unsigned)(q3 & 255) << 24);
                        }
                        *(GAS u32x2*)(rp + bj * HALF) = q;
                    }
                }
        }
    }
};
struct EpiProj {
    static constexpr bool PERM = true, AFTER_DRAIN = false;
    bf16_t* O; int ldc; const float* lb0; const float* lb1; const PG8_LAS float* rsl;
    template <int MODE> __device__ __forceinline__ void tile(const Acc& acc, const Unit& u, int ui, int wr, int wc, int fr, int fq, float scale, const float* lb) const {
        const int row0 = u.pm * BM + wr * 64 + fr, col0 = u.pn * BM + wc * 32 + 8 * fq;
        float rs[2][4]; row_rstd(rsl, ui, wr, fr, rs);
        f32x4 l[2][2];
        if (MODE == 1) {
#pragma unroll
            for (int bj = 0; bj < 2; ++bj)
#pragma unroll
                for (int n = 0; n < 2; ++n) l[bj][n] = *(const GAS f32x4*)(lb + bj * HALF + wc * 32 + 8 * fq + 4 * n);
        }
#pragma unroll
        for (int ai = 0; ai < 2; ++ai)
#pragma unroll
            for (int m = 0; m < 4; ++m) {
                bf16_t* rowp = O + (size_t)(row0 + ai * HALF + m * 16) * ldc + col0;
#pragma unroll
                for (int bj = 0; bj < 2; ++bj) {
                    f32x4 v[2] = {acc[ai][bj][m][0] * rs[ai][m], acc[ai][bj][m][1] * rs[ai][m]};
#pragma unroll
                    for (int n = 0; n < 2; ++n)
#pragma unroll
                        for (int i = 0; i < 4; ++i) {
                            float x = v[n][i];
                            if (MODE == 0) x *= scale;
                            if (MODE == 1) { const float lbv = l[bj][n][i]; x = __builtin_amdgcn_logf(lbv + (1.0f - lbv) * sigmoidf_(x)); }
                            if (MODE == 2) x = silu_(x);
                            if (MODE == 3) x = sigmoidf_(x);
                            v[n][i] = x;
                        }
                    if (MODE == 3) {
                        unsigned q[2][4];
#pragma unroll
                        for (int n = 0; n < 2; ++n)
#pragma unroll
                            for (int i = 0; i < 4; ++i) { const unsigned t = (unsigned)(v[n][i] * 256.0f); q[n][i] = t < 255u ? t : 255u; }
                        u32x2 w; w.x = q[0][0] | (q[0][1] << 8) | (q[0][2] << 16) | (q[0][3] << 24); w.y = q[1][0] | (q[1][1] << 8) | (q[1][2] << 16) | (q[1][3] << 24);
                        *(GAS u32x2*)((unsigned char*)(rowp - col0 + O_GA) + (col0 - O_GA) + bj * HALF) = w;
                    } else {
                        u32x4 w; w.x = cvt_pk_bf16(v[0][0], v[0][1]); w.y = cvt_pk_bf16(v[0][2], v[0][3]); w.z = cvt_pk_bf16(v[1][0], v[1][1]); w.w = cvt_pk_bf16(v[1][2], v[1][3]);
                        *(GAS u32x4*)(rowp + bj * HALF) = w;
                    }
                }
            }
    }
    __device__ __forceinline__ void operator()(const Acc& acc, const Unit& u, int ui, int wr, int wc, int fr, int fq) const {
        const int pn = u.pn;
        if (pn >= 22) tile<3>(acc, u, ui, wr, wc, fr, fq, 1.f, nullptr);
        else if (pn >= 20) tile<2>(acc, u, ui, wr, wc, fr, fq, 1.f, nullptr);
        else if (pn >= 12 && pn < 16) tile<1>(acc, u, ui, wr, wc, fr, fq, 1.f, (pn < 14 ? lb0 : lb1) + (pn & 1) * BM);
        else { const float s = (pn < 4 || pn == 6 || pn == 7) ? QSCALE : ((pn == 18 || pn == 19) ? CQSCALE : 1.0f); tile<0>(acc, u, ui, wr, wc, fr, fq, s, nullptr); }
    }
};
struct EpiGateQ {
    static constexpr bool PERM = true, AFTER_DRAIN = false;
    unsigned char* G8; int ldg; const float* wsc; const PG8_LAS float* rsl;
    __device__ __forceinline__ void operator()(const Acc& acc, const Unit& u, int ui, int wr, int wc, int fr, int fq) const {
        const int row0 = u.pm * BM + wr * 64 + fr, col0 = u.pn * BM + wc * 32 + 8 * fq;
        float rs[2][4]; row_rstd(rsl, ui, wr, fr, rs);
        f32x4 cs[2][2];
#pragma unroll
        for (int bj = 0; bj < 2; ++bj)
#pragma unroll
            for (int n = 0; n < 2; ++n) cs[bj][n] = *(const GAS f32x4*)(wsc + col0 + bj * HALF + 4 * n) * -LOG2E;
#pragma unroll
        for (int ai = 0; ai < 2; ++ai)
#pragma unroll
            for (int m = 0; m < 4; ++m) {
                unsigned char* rowp = G8 + (size_t)(row0 + ai * HALF + m * 16) * ldg + col0;
#pragma unroll
                for (int bj = 0; bj < 2; ++bj) {
                    unsigned q[2][4];
#pragma unroll
                    for (int n = 0; n < 2; ++n) {
                        const i32x4 iv = __builtin_bit_cast(i32x4, acc[ai][bj][m][n]);
#pragma unroll
                        for (int i = 0; i < 4; ++i) {
                            const float z = (float)iv[i] * rs[ai][m] * cs[bj][n][i];
                            const unsigned t = (unsigned)frcp(__builtin_fmaf(fexp2(z), 1.0f / 256.0f, 1.0f / 256.0f)); q[n][i] = t < 255u ? t : 255u;
                        }
                    }
                    u32x2 w; w.x = q[0][0] | (q[0][1] << 8) | (q[0][2] << 16) | (q[0][3] << 24); w.y = q[1][0] | (q[1][1] << 8) | (q[1][2] << 16) | (q[1][3] << 24);
                    *(GAS u32x2*)(rowp + bj * HALF) = w;
                }
            }
    }
};
template <int MODE> struct EpiGate {
    static constexpr bool PERM = true, AFTER_DRAIN = false;
    const bf16_t* Gt; int ldg; bf16_t* O; int ldc;
    __device__ __forceinline__ void operator()(const Acc& acc, const Unit& u, int ui, int wr, int wc, int fr, int fq) const {
        const int row0 = u.pm * BM + wr * 64 + fr, col0 = u.pn * BM + wc * 32 + 8 * fq;
#pragma unroll
        for (int ai = 0; ai < 2; ++ai)
#pragma unroll
            for (int m = 0; m < 4; ++m) {
                const size_t r = (size_t)(row0 + ai * HALF + m * 16);
#pragma unroll
                for (int bj = 0; bj < 2; ++bj) {
                    const u32x4 c = *(const GAS u32x4*)(Gt + r * ldg + col0 + bj * HALF);
                    f32x4 v0 = acc[ai][bj][m][0], v1 = acc[ai][bj][m][1];
                    v0[0] *= bflo(c.x); v0[1] *= bfhi(c.x); v0[2] *= bflo(c.y); v0[3] *= bfhi(c.y); v1[0] *= bflo(c.z); v1[1] *= bfhi(c.z); v1[2] *= bflo(c.w); v1[3] *= bfhi(c.w);
                    if (MODE) { const u32x4 o = *(const GAS u32x4*)(O + r * ldc + col0 + bj * HALF);
                        v0[0] += bflo(o.x); v0[1] += bfhi(o.x); v0[2] += bflo(o.y); v0[3] += bfhi(o.y); v1[0] += bflo(o.z); v1[1] += bfhi(o.z); v1[2] += bflo(o.w); v1[3] += bfhi(o.w); }
                    u32x4 w; w.x = cvt_pk_bf16(v0[0], v0[1]); w.y = cvt_pk_bf16(v0[2], v0[3]); w.z = cvt_pk_bf16(v1[0], v1[1]); w.w = cvt_pk_bf16(v1[2], v1[3]);
                    *(GAS u32x4*)(O + r * ldc + col0 + bj * HALF) = w;
                }
                if (m & 1) asm volatile("" ::: "memory");
            }
    }
};

struct EpiMerged {
    static constexpr bool PERM = true, AFTER_DRAIN = false;
    const bf16_t* P; int ldp; bf16_t* O; int ldc;
    __device__ __forceinline__ void operator()(Acc& acc, const Unit& u, int ui, int wr, int wc, int fr, int fq) const {
        const int row0 = u.pm * BM + wr * 64 + fr, col0 = u.pn * BM + wc * 32 + 8 * fq;
        const GAS unsigned char* g8 = (const GAS unsigned char*)((const GAS bf16_t*)P + (size_t)row0 * ldp + O_GA) + (col0 - 0);
        const size_t rstep = (size_t)ldp * 2;
        const int seg0 = u.sub + (int)(blockIdx.x & 1u), seg = seg0 >= 3 ? seg0 - 3 : seg0, dseg = seg == 2 ? 0 : seg + 1;
        if (u.sub < 2) {
            const GAS unsigned char* rp = g8 + seg * 2048; const int dofs = (dseg - seg) * 2048;
#pragma unroll
            for (int ai = 0; ai < 2; ++ai) {
                u32x2 ga[4][2], gb[4][2];
#pragma unroll
                for (int m = 0; m < 4; ++m) {
                    const GAS unsigned char* rowp = rp + (size_t)(ai * HALF + m * 16) * rstep;
#pragma unroll
                    for (int bj = 0; bj < 2; ++bj) { ga[m][bj] = *(const GAS u32x2*)(rowp + bj * HALF); gb[m][bj] = *(const GAS u32x2*)(rowp + dofs + bj * HALF); }
                }
                asm volatile("" ::: "memory");
#pragma unroll
                for (int m = 0; m < 4; ++m)
#pragma unroll
                    for (int bj = 0; bj < 2; ++bj) {
                        const u32x2 a = ga[m][bj], b = gb[m][bj];
                        f32x4 r0, r1;
#pragma unroll
                        for (int i = 0; i < 4; ++i) {
                            r0[i] = ((float)((a.x >> (8 * i)) & 255u) + 0.5f) * frcp((float)((b.x >> (8 * i)) & 255u) + 0.5f);
                            r1[i] = ((float)((a.y >> (8 * i)) & 255u) + 0.5f) * frcp((float)((b.y >> (8 * i)) & 255u) + 0.5f);
                        }
                        acc[ai][bj][m][0] *= r0; acc[ai][bj][m][1] *= r1;
                    }
                asm volatile("" ::: "memory");
            }
        } else {
#pragma unroll
            for (int ai = 0; ai < 2; ++ai)
#pragma unroll
                for (int m = 0; m < 4; ++m) {
                    const size_t r = (size_t)(row0 + ai * HALF + m * 16);
#pragma unroll
                    for (int bj = 0; bj < 2; ++bj) {
                        const u32x2 c = *(const GAS u32x2*)(g8 + (size_t)(ai * HALF + m * 16) * rstep + seg * 2048 + bj * HALF);
                        const f32x4 v0 = acc[ai][bj][m][0], v1 = acc[ai][bj][m][1];
                        float s0[4], s1[4];
#pragma unroll
                        for (int i = 0; i < 4; ++i) { s0[i] = ((float)((c.x >> (8 * i)) & 255u) + 0.5f) * (1.0f / 256.0f); s1[i] = ((float)((c.y >> (8 * i)) & 255u) + 0.5f) * (1.0f / 256.0f); }
                        u32x4 w; w.x = cvt_pk_bf16(v0[0] * s0[0], v0[1] * s0[1]); w.y = cvt_pk_bf16(v0[2] * s0[2], v0[3] * s0[3]);
                        w.z = cvt_pk_bf16(v1[0] * s1[0], v1[1] * s1[1]); w.w = cvt_pk_bf16(v1[2] * s1[2], v1[3] * s1[3]);
                        *(GAS u32x4*)(O + r * ldc + col0 + bj * HALF) = w;
                    }
                    if (m & 1) asm volatile("" ::: "memory");
                }
        }
    }
};

template <class Epi, class Sched, bool ALIGN_EPI = false, bool SP2 = false, bool SUBK = false, bool I8 = false>
__device__ __forceinline__ void gemm_phase(PG8_LAS unsigned char* lds, const Gemm g, const Sched S, const Epi E, int wave) {
    const int wid = wave, lane = lane_id(), tid = wid * 64 + lane, wr = wid >> 2, wc = wid & 3, fr = lane & 15, fq = lane >> 4;
    const int K = g.K, nt = K / BK;
    const int krot = SUBK ? (int)(blockIdx.x & 1u) : 0;
#define PG8_SEG(u) (((u).sub + krot) >= 3 ? ((u).sub + krot - 3) : ((u).sub + krot))
#define PG8_KOFF(u) (SUBK ? (PG8_SEG(u) == 0 ? 0 : (PG8_SEG(u) == 1 ? 2048 : 3072)) : 0)
#define PG8_NT(u) (SUBK ? (PG8_SEG(u) == 0 ? 16 : 8) : nt)
    unsigned voffA[2], voffB[2];
#pragma unroll
    for (int i = 0; i < 2; ++i) { int R, C; stage_rc(tid * 16 + i * 8192, R, C); const int Rb = Epi::PERM ? ((R & ~31) + perm32(R & 31)) : R;
        voffA[i] = (unsigned)(R * g.lda + C) * 2u; voffB[i] = (unsigned)(Rb * g.ldb + C) * 2u; }
    const size_t kstep = (size_t)(BK * 2);
    const size_t hstepA = (size_t)HALF * g.lda * 2, hstepB = (size_t)HALF * g.ldb * 2;
    const size_t tstepA = 2 * hstepA, tstepB = 2 * hstepB;
    const unsigned ldsw = (unsigned)wid * 1024u;
    const int aoff = lds_byte(wr * 64 + fr, fq * 8), boff = lds_byte(wc * 32 + fr, fq * 8);
#define PG8_SA(b, h) (((b) * 2 + (h)) * HTB)
#define PG8_SB(b, h) ((4 + (b) * 2 + (h)) * HTB)
#define PG8_STAGE(bufoff, gbase, voff) do { _Pragma("unroll") for (int _i = 0; _i < 2; ++_i) \
        __builtin_amdgcn_global_load_lds((const unsigned*)((const char*)(gbase) + (voff)[_i]), (PG8_LAS unsigned*)(lds + (bufoff) + ldsw + _i * 8192), 16, 0, 0); } while (0)
#define PG8_LDA(dst, b, h) do { _Pragma("unroll") for (int m = 0; m < 4; ++m) _Pragma("unroll") for (int k = 0; k < 2; ++k) dst[m][k] = *(const PG8_LAS bf16x8*)(lds + PG8_SA(b, h) + aoff + m * 2048 + k * 1024); } while (0)
#define PG8_LDB(dst, b, h) do { _Pragma("unroll") for (int n = 0; n < 2; ++n) _Pragma("unroll") for (int k = 0; k < 2; ++k) dst[n][k] = *(const PG8_LAS bf16x8*)(lds + PG8_SB(b, h) + boff + n * 2048 + k * 1024); } while (0)
#define PG8_MMA(ai, bj, At, Bt) do { __builtin_amdgcn_s_setprio(1); _Pragma("unroll") for (int m = 0; m < 4; ++m) _Pragma("unroll") for (int n = 0; n < 2; ++n) _Pragma("unroll") for (int k = 0; k < 2; ++k) \
        { if constexpr (I8) acc[ai][bj][m][n] = __builtin_bit_cast(f32x4, __builtin_amdgcn_mfma_i32_16x16x64_i8(__builtin_bit_cast(i32x4, Bt[n][k]), __builtin_bit_cast(i32x4, At[m][k]), __builtin_bit_cast(i32x4, acc[ai][bj][m][n]), 0, 0, 0)); \
          else acc[ai][bj][m][n] = __builtin_amdgcn_mfma_f32_16x16x32_bf16(Bt[n][k], At[m][k], acc[ai][bj][m][n], 0, 0, 0); } __builtin_amdgcn_s_setprio(0); } while (0)
#define PG8_WAIT_V(n) asm volatile("s_waitcnt vmcnt(" #n ")" ::: "memory")
#define PG8_WAIT_L(n) asm volatile("s_waitcnt lgkmcnt(" #n ")" ::: "memory")
#define PG8_BAR __builtin_amdgcn_s_barrier()
#define PG8_SCHED __builtin_amdgcn_sched_barrier(0)
    Unit cur, nxt; int ui = 0;
    if (!S.next(0, cur)) return;
    f32x4 acc[2][2][4][2];
#pragma unroll
    for (int a = 0; a < 2; ++a)
#pragma unroll
        for (int b = 0; b < 2; ++b)
#pragma unroll
            for (int m = 0; m < 4; ++m)
#pragma unroll
                for (int n = 0; n < 2; ++n) acc[a][b][m][n] = (f32x4){0.f, 0.f, 0.f, 0.f};
    bf16x8 At[4][2], B0[2][2], B1[2][2];
    const char* cA = (const char*)g.A + (size_t)cur.pm * tstepA + PG8_KOFF(cur); const char* cB = (const char*)g.Bt + (size_t)cur.pn * tstepB + PG8_KOFF(cur);
    S.a_ready(cur);
    if constexpr (SP2) {
        PG8_STAGE(PG8_SB(0, 0), cB, voffB); PG8_STAGE(PG8_SB(0, 1), cB + hstepB, voffB); PG8_STAGE(PG8_SA(0, 0), cA, voffA); PG8_STAGE(PG8_SA(0, 1), cA + hstepA, voffA);
        if (wr == 1) PG8_BAR;
        PG8_WAIT_V(2); PG8_BAR;
        PG8_STAGE(PG8_SB(1, 0), cB + kstep, voffB); PG8_STAGE(PG8_SA(1, 0), cA + kstep, voffA); PG8_STAGE(PG8_SB(1, 1), cB + hstepB + kstep, voffB);
        PG8_WAIT_V(6); PG8_BAR;
    } else {
        PG8_STAGE(PG8_SB(0, 0), cB, voffB); PG8_STAGE(PG8_SA(0, 0), cA, voffA); PG8_STAGE(PG8_SB(0, 1), cB + hstepB, voffB); PG8_STAGE(PG8_SA(0, 1), cA + hstepA, voffA);
        if (wr == 1) PG8_BAR;
        PG8_WAIT_V(4); PG8_BAR;
        PG8_STAGE(PG8_SB(1, 0), cB + kstep, voffB); PG8_STAGE(PG8_SA(1, 0), cA + kstep, voffA); PG8_STAGE(PG8_SB(1, 1), cB + hstepB + kstep, voffB);
        PG8_WAIT_V(6); PG8_BAR;
    }
    for (;;) {
        const bool has_next = S.next(ui + 1, nxt);
        const char* nA = has_next ? (const char*)g.A + (size_t)nxt.pm * tstepA + PG8_KOFF(nxt) : cA; const char* nB = has_next ? (const char*)g.Bt + (size_t)nxt.pn * tstepB + PG8_KOFF(nxt) : cB;
        const int ntc = PG8_NT(cur);
        for (int t = 0; t < ntc; t += 2) {
            const bool last = (t == ntc - 2);
            const char* a1 = cA + (size_t)(t + 1) * kstep;
            const char* a2 = last ? nA : cA + (size_t)(t + 2) * kstep; const char* b2 = last ? nB : cB + (size_t)(t + 2) * kstep;
            const char* a3 = a2 + kstep; const char* b3 = b2 + kstep;
            if (last && has_next) S.a_ready(nxt);
            if constexpr (SP2) {
            PG8_LDB(B0, 0, 0); PG8_LDB(B1, 0, 1); PG8_SCHED; PG8_LDA(At, 0, 0); PG8_STAGE(PG8_SA(1, 1), a1 + hstepA, voffA);
            PG8_WAIT_V(8); PG8_WAIT_L(0); PG8_BAR; PG8_MMA(0, 0, At, B0); PG8_MMA(0, 1, At, B1); PG8_BAR; PG8_SCHED;
            PG8_LDA(At, 0, 1); PG8_STAGE(PG8_SB(0, 0), b2, voffB); PG8_STAGE(PG8_SB(0, 1), b2 + hstepB, voffB); PG8_STAGE(PG8_SA(0, 0), a2, voffA);
            PG8_WAIT_V(8); PG8_WAIT_L(0); PG8_BAR; PG8_MMA(1, 0, At, B0); PG8_MMA(1, 1, At, B1); PG8_BAR; PG8_SCHED;
            PG8_LDB(B0, 1, 0); PG8_LDB(B1, 1, 1); PG8_SCHED; PG8_LDA(At, 1, 0); PG8_STAGE(PG8_SA(0, 1), a2 + hstepA, voffA);
            PG8_WAIT_V(8); PG8_WAIT_L(0); PG8_BAR; PG8_MMA(0, 0, At, B0); PG8_MMA(0, 1, At, B1); PG8_BAR; PG8_SCHED;
            PG8_LDA(At, 1, 1); PG8_STAGE(PG8_SB(1, 0), b3, voffB); PG8_STAGE(PG8_SB(1, 1), b3 + hstepB, voffB); PG8_STAGE(PG8_SA(1, 0), a3, voffA);
            PG8_WAIT_V(8); PG8_WAIT_L(0); PG8_BAR; PG8_MMA(1, 0, At, B0); PG8_MMA(1, 1, At, B1); PG8_BAR; PG8_SCHED;
            } else {
            PG8_LDB(B0, 0, 0); PG8_SCHED; PG8_LDA(At, 0, 0); PG8_STAGE(PG8_SA(1, 1), a1 + hstepA, voffA);
            PG8_WAIT_L(8); PG8_BAR; PG8_WAIT_L(0); PG8_MMA(0, 0, At, B0); PG8_BAR; PG8_SCHED;
            PG8_LDB(B1, 0, 1); PG8_STAGE(PG8_SB(0, 0), b2, voffB);
            PG8_BAR; PG8_WAIT_L(0); PG8_MMA(0, 1, At, B1); PG8_BAR;
            PG8_LDA(At, 0, 1); PG8_STAGE(PG8_SA(0, 0), a2, voffA);
            PG8_BAR; PG8_WAIT_L(0); PG8_MMA(1, 0, At, B0); PG8_BAR; PG8_SCHED;
            PG8_STAGE(PG8_SB(0, 1), b2 + hstepB, voffB);
            PG8_WAIT_V(6); PG8_BAR; PG8_MMA(1, 1, At, B1); PG8_BAR;
            PG8_LDB(B0, 1, 0); PG8_SCHED; PG8_LDA(At, 1, 0); PG8_STAGE(PG8_SA(0, 1), a2 + hstepA, voffA);
            PG8_WAIT_L(8); PG8_BAR; PG8_WAIT_L(0); PG8_MMA(0, 0, At, B0); PG8_BAR; PG8_SCHED;
            PG8_LDB(B1, 1, 1); PG8_STAGE(PG8_SB(1, 0), b3, voffB);
            PG8_BAR; PG8_WAIT_L(0); PG8_MMA(0, 1, At, B1); PG8_BAR;
            PG8_LDA(At, 1, 1); PG8_STAGE(PG8_SA(1, 0), a3, voffA);
            PG8_BAR; PG8_WAIT_L(0); PG8_MMA(1, 0, At, B0); PG8_BAR; PG8_SCHED;
            PG8_STAGE(PG8_SB(1, 1), b3 + hstepB, voffB);
            PG8_WAIT_V(6); PG8_BAR; PG8_MMA(1, 1, At, B1); PG8_BAR;
            }
        }
        if constexpr (ALIGN_EPI) { if (wr == 0) PG8_BAR; }
        E(acc, cur, ui, wr, wc, fr, fq); S.done(cur);
        if (!has_next) break;
        if (!SUBK || nxt.sub == 0) {
#pragma unroll
        for (int a = 0; a < 2; ++a)
#pragma unroll
            for (int b = 0; b < 2; ++b)
#pragma unroll
                for (int m = 0; m < 4; ++m)
#pragma unroll
                    for (int n = 0; n < 2; ++n) acc[a][b][m][n] = (f32x4){0.f, 0.f, 0.f, 0.f};
        }
        cur = nxt; cA = nA; cB = nB; ++ui;
        if constexpr (ALIGN_EPI) { if (wr == 1) PG8_BAR; }
    }
    PG8_WAIT_V(0);
    if constexpr (!ALIGN_EPI) { if (wr == 0) PG8_BAR; }
    PG8_BAR;
#undef PG8_KOFF
#undef PG8_NT
#undef PG8_SA
#undef PG8_SB
#undef PG8_STAGE
#undef PG8_LDA
#undef PG8_LDB
#undef PG8_MMA
#undef PG8_WAIT_V
#undef PG8_WAIT_L
#undef PG8_BAR
#undef PG8_SCHED
}
}

#define XB_TMO      128
#define XB_XCNT(j)  (256  + 64 * (j))
#define XB_XSUB(j)  (1280 + 64 * (j))
#define XB_XGEN(j)  (2304 + 64 * (j))
#define XB_TOP      3328
#define XB_TOPGEN   3392
#define XCD_BAR_WORDS 3456
#define XB_SPIN_CAP (1u << 24)
__device__ __forceinline__ unsigned xb_ld(unsigned* p)              { return __hip_atomic_load(p, __ATOMIC_RELAXED, __HIP_MEMORY_SCOPE_AGENT); }
__device__ __forceinline__ unsigned xb_add(unsigned* p, unsigned v) { return __hip_atomic_fetch_add(p, v, __ATOMIC_RELAXED, __HIP_MEMORY_SCOPE_AGENT); }
__device__ __forceinline__ unsigned xb_xcc_id() { return (unsigned)__builtin_amdgcn_s_getreg((3 << 11) | 20) & 0xFu; }
#define XB_SPIN(cond, bar) do { unsigned _sp = 0; while (cond) { __builtin_amdgcn_s_sleep(1); \
    if ((++_sp & 255u) == 0u) { if (xb_ld(&(bar)[XB_TMO])) break; if (_sp > XB_SPIN_CAP) { atomicAdd(&(bar)[XB_TMO], 1u); break; } } } } while (0)
struct XcdBarrier { unsigned* bar; unsigned x; volatile LAS unsigned* st; };
__device__ __forceinline__ XcdBarrier xcd_barrier_post(unsigned* bar, volatile LAS unsigned* st, bool t0) {
    XcdBarrier b; b.bar = bar; b.x = xb_xcc_id(); b.st = st;
    if (t0) (void)xb_add(&bar[XB_XCNT(b.x)], 1u);
    return b;
}
__device__ __forceinline__ void xcd_barrier_complete(unsigned* bar, unsigned x, unsigned& nloc, unsigned& nx) {
    const unsigned G = gridDim.x * gridDim.y * gridDim.z;
    unsigned sum, cnt, mine, sp = 0u;
    for (;;) {
        sum = 0u; cnt = 0u; mine = 0u;
#pragma unroll
        for (unsigned j = 0; j < 16; ++j) { const unsigned c = xb_ld(&bar[XB_XCNT(j)]); sum += c; cnt += (c > 0u) ? 1u : 0u; mine = (j == x) ? c : mine; }
        if (sum == G) break;
        __builtin_amdgcn_s_sleep(1);
        if ((++sp & 255u) == 0u) { if (xb_ld(&bar[XB_TMO])) break; if (sp > XB_SPIN_CAP) { atomicAdd(&bar[XB_TMO], 1u); break; } }
    }
    nloc = mine > 0u ? mine : 1u; nx = cnt > 0u ? cnt : 1u;
}
__device__ __forceinline__ void xcd_barrier(const XcdBarrier& b, bool t0) {
    asm volatile("s_waitcnt vmcnt(0)" ::: "memory");
    __syncthreads();
    if (t0) {
        unsigned* bar = b.bar;
        __builtin_amdgcn_s_waitcnt(0);
        unsigned nloc = b.st[0], nx = b.st[1];
        if (nloc == 0u) { xcd_barrier_complete(bar, b.x, nloc, nx); b.st[0] = nloc; b.st[1] = nx; }
        const unsigned old = xb_add(&bar[XB_XSUB(b.x)], 1u);
        const unsigned gen = old / nloc;
        if (old + 1u == (gen + 1u) * nloc) {
            __builtin_amdgcn_fence(__ATOMIC_RELEASE, "agent");
            asm volatile("s_waitcnt vmcnt(0)" ::: "memory");
            const unsigned og = xb_add(&bar[XB_TOP], 1u);
            const unsigned tg = og / nx;
            if (og + 1u == (tg + 1u) * nx) xb_add(&bar[XB_TOPGEN], 1u);
            else XB_SPIN(xb_ld(&bar[XB_TOPGEN]) == tg, bar);
            __builtin_amdgcn_fence(__ATOMIC_ACQUIRE, "agent");
            xb_add(&bar[XB_XGEN(b.x)], 1u);
            asm volatile("s_waitcnt vmcnt(0)" ::: "memory");
        } else {
            XB_SPIN(xb_ld(&bar[XB_XGEN(b.x)]) == gen, bar);
            __builtin_amdgcn_fence(__ATOMIC_ACQUIRE, "agent");
            asm volatile("s_waitcnt vmcnt(0)" ::: "memory");
        }
    }
    __syncthreads();
}

struct Args {
    const float* in[22]; float* out; unsigned char* ws;
    int l_lo, l_hi, s_lo, s_hi, ph_lo, ph_hi, do_pro, do_fin, use_bar, pad;
};
struct Frame {
    LAS unsigned char* lds;
    int wave, G, gw, NGW;
};
enum { I_XP = 0, I_XS, I_F1N, I_F1G, I_F1U, I_F1D, I_MN, I_WIN, I_SINK, I_T5, I_NAB, I_LBL, I_HN, I_WA, I_WB, I_WC, I_WO, I_F2N, I_F2G, I_F2U, I_F2D, I_FN };

__device__ __forceinline__ void tr_item(const float* W, int K, int N, bf16* WT, int ld, int koff, int rowmode, LAS float* scr, int item, int lane, const float* gain) {
    const int nblk = N / 32, kb = item / nblk, nb = item % nblk, k0 = 64 * kb, n0 = 32 * nb;
#pragma unroll 8
    for (int i = 0; i < 32; ++i) { const int kk = 2 * i + (lane >> 5); scr[kk * 33 + (lane & 31)] = W[(size_t)(k0 + kk) * N + n0 + (lane & 31)]; }
    LDS_WAIT(); asm volatile("" ::: "memory");
    const int c = lane & 7;
    f32x4 g0 = (f32x4){1.f, 1.f, 1.f, 1.f}, g1 = g0;
    if (gain) { g0 = *(const GAS f32x4*)(gain + k0 + 8 * c); g1 = *(const GAS f32x4*)(gain + k0 + 8 * c + 4); }
#pragma unroll
    for (int j = 0; j < 4; ++j) { const int n = (lane >> 3) + 8 * j; const LAS float* s = scr + (8 * c) * 33 + n;
        v4u o; o.x = pk2(s[0 * 33] * g0[0], s[1 * 33] * g0[1]); o.y = pk2(s[2 * 33] * g0[2], s[3 * 33] * g0[3]); o.z = pk2(s[4 * 33] * g1[0], s[5 * 33] * g1[1]); o.w = pk2(s[6 * 33] * g1[2], s[7 * 33] * g1[3]);
        const int nn = n0 + n; const int drow = rowmode == 0 ? nn : ((nn >> 7) * 256 + (nn & 127) + (rowmode == 2 ? 128 : 0));
        *(GAS v4u*)(WT + (size_t)drow * ld + koff + k0 + 8 * c) = o; }
    LDS_WAIT(); asm volatile("" ::: "memory");
}
__device__ __forceinline__ void tr_matrix(Frame& F, const float* W, int K, int N, bf16* WT, int ld, int koff, int rowmode, const float* gain = nullptr) {
    LAS float* scr = (LAS float*)(F.lds + RING_OFF + F.wave * 16384);
    const int nitems = (K / 64) * (N / 32);
    const int lane = lane_id();
    for (int it = F.gw; it < nitems; it += F.NGW) tr_item(W, K, N, WT, ld, koff, rowmode, scr, it, lane, gain);
}
__device__ __forceinline__ int t5_bucket(int rel) {
    const int n = rel < 0 ? -rel : rel; int b = rel > 0 ? 16 : 0;
    if (n < 8) return b + n;
    int lg = 2 + (31 - __builtin_clz((unsigned)(n * n)));
    if (lg > 15) lg = 15;
    return b + lg;
}
__device__ __forceinline__ void prologue(Frame& F, const __attribute__((address_space(4))) Args* ap) {
    bf16* W = (bf16*)(ap->ws + WS_W);
    for (int l = 0; l < NLAYER; ++l) {
        bf16* Wl = W + (size_t)l * E_LAYER;
        bf16* const T1 = (bf16*)(ap->ws + WS_PROJ) + (size_t)(2 * l) * E_WGU; bf16* const T2 = T1 + E_WGU;
        tr_matrix(F, ap->in[I_F1G] + (size_t)l * DM * DFF, DM, DFF, T1, DM, 0, 1, ap->in[I_F1N] + l * DM);
        tr_matrix(F, ap->in[I_F1U] + (size_t)l * DM * DFF, DM, DFF, T1, DM, 0, 2, ap->in[I_F1N] + l * DM);
        tr_matrix(F, ap->in[I_F1D] + (size_t)l * DFF * DM, DFF, DM, Wl + EO_WD1, DFF, 0, 0);
        tr_matrix(F, ap->in[I_WIN] + (size_t)l * DM * PW, DM, PW, Wl + EO_WIN, DM, 0, 0, ap->in[I_MN] + l * DM);
        tr_matrix(F, ap->in[I_WA] + (size_t)l * 1024 * DM, 1024, DM, Wl + EO_WBR, DM, 0, 0);
        tr_matrix(F, ap->in[I_WB] + (size_t)l * 512 * DM, 512, DM, Wl + EO_WBR, DM, 1024, 0);
        tr_matrix(F, ap->in[I_WC] + (size_t)l * 512 * DM, 512, DM, Wl + EO_WBR, DM, 1536, 0);
        tr_matrix(F, ap->in[I_WO] + (size_t)l * DM * DM, DM, DM, Wl + EO_WOUT, DM, 0, 0);
        tr_matrix(F, ap->in[I_F2G] + (size_t)l * DM * DFF, DM, DFF, T2, DM, 0, 1, ap->in[I_F2N] + l * DM);
        tr_matrix(F, ap->in[I_F2U] + (size_t)l * DM * DFF, DM, DFF, T2, DM, 0, 2, ap->in[I_F2N] + l * DM);
        tr_matrix(F, ap->in[I_F2D] + (size_t)l * DFF * DM, DFF, DM, Wl + EO_WD2, DFF, 0, 0);
    }
    float* tab = (float*)(ap->ws + WS_TAB);
    const int gt = blockIdx.x * 512 + F.wave * 64 + lane_id(), NT = F.G * 512;
    for (int i = gt; i < 8 * 260; i += NT) { const int h = i / 260, j = i % 260; tab[TAB_T5 + i] = j <= 256 ? ap->in[I_T5][t5_bucket(j - 128) * 8 + h] * LOG2E : -1e30f; }
    for (int i = gt; i < 2 * 512; i += NT) {
        const int dir = i / 512, c = i % 512; const float* lg = ap->in[I_LBL] + (size_t)dir * NLAYER * 512 + c;
        float mx = lg[0]; for (int l = 1; l < NLAYER; ++l) mx = fmaxf(mx, lg[l * 512]);
        float e[NLAYER], s = 0.f; for (int l = 0; l < NLAYER; ++l) { e[l] = expf(lg[l * 512] - mx); s += e[l]; }
        float cum = 0.f; for (int l = 0; l < NLAYER; ++l) { cum += e[l] / s; tab[TAB_LB + (dir * NLAYER + l) * 512 + c] = cum - e[0] / s; }
    }
}
__device__ __forceinline__ void quant_rows(Frame& F, const bf16* src, unsigned char* dst, float* scl, int nrows) {
    const int lane = lane_id();
    for (int r0 = F.gw; r0 < nrows; r0 += 4 * F.NGW) {
        pg8::u32x4 v[4][4];
#pragma unroll
        for (int u = 0; u < 4; ++u) { const int r = r0 + u * F.NGW;
            if (r < nrows) { const GAS pg8::u32x4* p = (const GAS pg8::u32x4*)(src + (size_t)r * 2048) + lane * 4;
#pragma unroll
                for (int j = 0; j < 4; ++j) v[u][j] = p[j]; } }
        asm volatile("" ::: "memory");
#pragma unroll
        for (int u = 0; u < 4; ++u) { const int r = r0 + u * F.NGW;
            if (r < nrows) {
                float mx = 0.f;
#pragma unroll
                for (int j = 0; j < 4; ++j)
#pragma unroll
                    for (int e = 0; e < 4; ++e) mx = fmaxf(mx, fmaxf(fabsf(bflo(v[u][j][e])), fabsf(bfhi(v[u][j][e]))));
#pragma unroll
                for (int o = 32; o > 0; o >>= 1) mx = fmaxf(mx, __shfl_xor(mx, o));
                const float sc = mx > 0.f ? mx * (1.0f / 127.0f) : 1.0f, inv = 1.0f / sc;
                pg8::u32x4 w[2];
#pragma unroll
                for (int j = 0; j < 4; ++j)
#pragma unroll
                    for (int h = 0; h < 2; ++h) {
                        const unsigned a = v[u][j][2 * h], b = v[u][j][2 * h + 1];
                        const int q0 = (int)rintf(bflo(a) * inv), q1 = (int)rintf(bfhi(a) * inv), q2 = (int)rintf(bflo(b) * inv), q3 = (int)rintf(bfhi(b) * inv);
                        w[j >> 1][(j & 1) * 2 + h] = (unsigned)(q0 & 255) | ((unsigned)(q1 & 255) << 8) | ((unsigned)(q2 & 255) << 16) | ((unsigned)(q3 & 255) << 24);
                    }
                GAS pg8::u32x4* d = (GAS pg8::u32x4*)(dst + (size_t)r * 2048) + lane * 2;
                d[0] = w[0]; d[1] = w[1];
                if (lane == 0) scl[r] = sc;
            } }
    }
}
__device__ __forceinline__ void quant_gate_weights(Frame& F, const __attribute__((address_space(4))) Args* ap) {
    for (int l = 0; l < NLAYER; ++l) {
        unsigned char* wq = ap->ws + WS_WQ + (size_t)l * WQ_LAYER;
        quant_rows(F, (const bf16*)(ap->ws + WS_W) + (size_t)l * E_LAYER + EO_WIN + (size_t)O_GA * DM, wq, (float*)(wq + WQ_SCALE), 3 * DM);
        for (int j = 0; j < 2; ++j) { unsigned char* d = (unsigned char*)((bf16*)(ap->ws + WS_W) + (size_t)l * E_LAYER + (j ? EO_WGU2 : EO_WGU1));
            quant_rows(F, (const bf16*)(ap->ws + WS_PROJ) + (size_t)(2 * l + j) * E_WGU, d, (float*)(d + WGUQ_SCALE), 2 * DFF); }
    }
}
template <bool OUT_F32> __device__ __forceinline__ void norm_rows(Frame& F, const float* x, const float* gain, void* out, int M) {
    const int lane = lane_id();
    const GAS f32x4* gr = (const GAS f32x4*)gain + lane;
    for (int m = F.gw; m < M; m += F.NGW) {
        const GAS f32x4* xr = (const GAS f32x4*)(x + (size_t)m * DM) + lane;
        f32x4 v[8]; float s = 0.f;
#pragma unroll
        for (int j = 0; j < 8; ++j) { v[j] = xr[64 * j]; s += (v[j].x * v[j].x + v[j].y * v[j].y) + (v[j].z * v[j].z + v[j].w * v[j].w); }
        const float rstd = 1.0f / sqrtf(wave_sum(s) * (1.0f / DM) + EPS);
#pragma unroll
        for (int j = 0; j < 8; ++j) { const f32x4 g = gr[64 * j]; const f32x4 o = v[j] * rstd * g;
            if (OUT_F32) ((GAS f32x4*)((float*)out + (size_t)m * DM) + lane)[64 * j] = o;
            else { v2u w; w.x = pk2(o.x, o.y); w.y = pk2(o.z, o.w); ((GAS v2u*)((bf16*)out + (size_t)m * DM) + lane)[64 * j] = w; } }
    }
}

__device__ __forceinline__ void cast_rows(Frame& F, const float* x, bf16* xb, float* ssq, int M) {
    const int lane = lane_id();
    for (int m = F.gw; m < M; m += F.NGW) {
        const GAS f32x4* xr = (const GAS f32x4*)(x + (size_t)m * DM) + lane; float s = 0.f;
#pragma unroll
        for (int j = 0; j < 8; ++j) { const f32x4 v = xr[64 * j]; s += (v.x * v.x + v.y * v.y) + (v.z * v.z + v.w * v.w);
            v2u w; w.x = pk2(v.x, v.y); w.y = pk2(v.z, v.w); ((GAS v2u*)(xb + (size_t)m * DM) + lane)[64 * j] = w; }
        s = wave_sum(s);
        if (lane < 32) ssq[(size_t)m * 32 + lane] = lane == 0 ? s : 0.f;
    }
}
__device__ __forceinline__ void final_rows(Frame& F, const bf16* xb, const float* gain, float* out, int M) {
    const int lane = lane_id();
    const GAS f32x4* gr = (const GAS f32x4*)gain;
    for (int m = F.gw; m < M; m += F.NGW) {
        const GAS v4u* xr = (const GAS v4u*)(xb + (size_t)m * DM) + lane;
        float v[4][8]; float s = 0.f;
#pragma unroll
        for (int j = 0; j < 4; ++j) { v8(xr[64 * j], v[j]);
#pragma unroll
            for (int k = 0; k < 8; ++k) s += v[j][k] * v[j][k]; }
        const float rstd = 1.0f / sqrtf(wave_sum(s) * (1.0f / DM) + EPS);
#pragma unroll
        for (int j = 0; j < 4; ++j) { const f32x4 g0 = gr[2 * (64 * j + lane)], g1 = gr[2 * (64 * j + lane) + 1];
            GAS f32x4* o = (GAS f32x4*)(out + (size_t)m * DM) + 2 * (64 * j + lane);
            o[0] = (f32x4){v[j][0] * rstd * g0[0], v[j][1] * rstd * g0[1], v[j][2] * rstd * g0[2], v[j][3] * rstd * g0[3]};
            o[1] = (f32x4){v[j][4] * rstd * g1[0], v[j][5] * rstd * g1[1], v[j][6] * rstd * g1[2], v[j][7] * rstd * g1[3]}; }
    }
}
__device__ __forceinline__ void mixA_naive(Frame& F, const bf16* P, bf16* Y, const float* tab, const float* sink, int Ts) {
    LAS float* ql = (LAS float*)(F.lds + RING_OFF + 65536 + F.wave * 2048);
    LAS float* pl = ql + 128;
    const int lane = lane_id();
    for (int it = F.gw; it < MS * 8; it += F.NGW) {
        const int row = it >> 3, h = it & 7, kvh = h >> 2, t = row & (Ts - 1), rb = row - t;
        { const unsigned w = *(const GAS unsigned*)(P + (size_t)row * PW + O_AQ + h * 128 + 2 * lane); ql[2 * lane] = bflo(w); ql[2 * lane + 1] = bfhi(w); }
        LDS_WAIT(); asm volatile("" ::: "memory");
        float sc[5]; float mx = sink[h] * LOG2E;
#pragma unroll
        for (int p = 0; p < 5; ++p) {
            const int j = lane + 64 * p, kpos = t + j - 128; float s = -1e30f;
            if (j <= 256 && kpos >= 0 && kpos < Ts) {
                const GAS v4u* kr = (const GAS v4u*)(P + (size_t)(rb + kpos) * PW + O_AK + kvh * 128); float a = 0.f;
#pragma unroll 4
                for (int d8 = 0; d8 < 16; ++d8) { const v4u w = kr[d8]; const LAS float* q = ql + d8 * 8;
                    a += q[0] * bflo(w.x) + q[1] * bfhi(w.x) + q[2] * bflo(w.y) + q[3] * bfhi(w.y) + q[4] * bflo(w.z) + q[5] * bfhi(w.z) + q[6] * bflo(w.w) + q[7] * bfhi(w.w); }
                s = a + tab[TAB_T5 + h * 260 + j];
            }
            sc[p] = s; mx = fmaxf(mx, s);
        }
        mx = wave_max(mx);
        float sum = 0.f;
#pragma unroll
        for (int p = 0; p < 5; ++p) { const float e = fexp2(sc[p] - mx); pl[lane + 64 * p] = e; sum += e; }
        sum = wave_sum(sum) + fexp2(sink[h] * LOG2E - mx);
        LDS_WAIT(); asm volatile("" ::: "memory");
        float o0 = 0.f, o1 = 0.f;
        const int jlo = t >= 128 ? 0 : 128 - t, jhi = (t + 128 < Ts) ? 256 : (Ts - 1 - t + 128);
        for (int j = jlo; j <= jhi; ++j) { const float pj = pl[j]; const unsigned w = *(const GAS unsigned*)(P + (size_t)(rb + t + j - 128) * PW + O_AV + kvh * 128 + 2 * lane); o0 += pj * bflo(w); o1 += pj * bfhi(w); }
        const float inv = 1.0f / sum;
        *(GAS unsigned*)(Y + (size_t)row * DM + h * 128 + 2 * lane) = pk2(o0 * inv, o1 * inv);
        LDS_WAIT(); asm volatile("" ::: "memory");
    }
}
__device__ __forceinline__ void mixB_naive(Frame& F, const bf16* P, bf16* Y, const float* nab, int Ts) {
    LAS float* ql = (LAS float*)(F.lds + RING_OFF + 65536 + F.wave * 2048);
    LAS float* pl = ql + 128;
    const int lane = lane_id(), rows = Ts >> 6;
    for (int it = F.gw; it < MS * 4; it += F.NGW) {
        const int row = it >> 2, h = it & 3, t = row & (Ts - 1), rb = row - t, r = t >> 6, c = t & 63;
        int rs = r - 4; rs = rs < 0 ? 0 : (rs > rows - 8 ? rows - 8 : rs);
        int cs = c - 8; cs = cs < 0 ? 0 : (cs > 48 ? 48 : cs);
        { const unsigned w = *(const GAS unsigned*)(P + (size_t)row * PW + O_BQ + h * 128 + 2 * lane); ql[2 * lane] = bflo(w); ql[2 * lane + 1] = bfhi(w); }
        LDS_WAIT(); asm volatile("" ::: "memory");
        float sc[2]; float mx = -1e30f;
#pragma unroll
        for (int p = 0; p < 2; ++p) {
            const int i = lane + 64 * p, kr_ = rs + (i >> 4), kc = cs + (i & 15);
            const GAS v4u* kr = (const GAS v4u*)(P + (size_t)(rb + kr_ * 64 + kc) * PW + O_BK + h * 128); float a = 0.f;
#pragma unroll 4
            for (int d8 = 0; d8 < 16; ++d8) { const v4u w = kr[d8]; const LAS float* q = ql + d8 * 8;
                a += q[0] * bflo(w.x) + q[1] * bfhi(w.x) + q[2] * bflo(w.y) + q[3] * bfhi(w.y) + q[4] * bflo(w.z) + q[5] * bfhi(w.z) + q[6] * bflo(w.w) + q[7] * bfhi(w.w); }
            int dc = kc - c; dc = dc < -15 ? -15 : (dc > 15 ? 15 : dc);
            sc[p] = a + nab[(h * 15 + (kr_ - r + 7)) * 31 + dc + 15] * LOG2E; mx = fmaxf(mx, sc[p]);
        }
        mx = wave_max(mx);
        float sum = 0.f;
#pragma unroll
        for (int p = 0; p < 2; ++p) { const float e = fexp2(sc[p] - mx); pl[lane + 64 * p] = e; sum += e; }
        sum = wave_sum(sum);
        LDS_WAIT(); asm volatile("" ::: "memory");
        float o0 = 0.f, o1 = 0.f;
        for (int i = 0; i < 128; ++i) { const float pj = pl[i]; const unsigned w = *(const GAS unsigned*)(P + (size_t)(rb + (rs + (i >> 4)) * 64 + cs + (i & 15)) * PW + O_BV + h * 128 + 2 * lane); o0 += pj * bflo(w); o1 += pj * bfhi(w); }
        const float inv = 1.0f / sum;
        *(GAS unsigned*)(Y + (size_t)row * DM + 1024 + h * 128 + 2 * lane) = pk2(o0 * inv, o1 * inv);
        LDS_WAIT(); asm volatile("" ::: "memory");
    }
}
typedef float f32x16 __attribute__((ext_vector_type(16)));
typedef short s16x4 __attribute__((ext_vector_type(4)));
#define KSWZ(row, colB) ((row) * 256 + ((colB) ^ (((row) & 7) << 4)))
__device__ __forceinline__ int crow(int r, int hi) { return (r & 3) + 8 * (r >> 2) + 4 * hi; }
__device__ __forceinline__ int v_st(int k, int c) { const int kk = (k & ~0xC) | ((k & 4) << 1) | ((k & 8) >> 1); return ((kk >> 3) * 4 + (c >> 5)) * 512 + ((kk & 7) * 32 + (c & 31)) * 2; }
__device__ __forceinline__ int v_rd_base(int lane) { return ((lane & 3) << 3) | (((lane >> 2) & 3) << 6) | (((lane >> 4) & 1) << 5) | (((lane >> 5) & 1) << 8); }
constexpr int v_rd_off(int d0, int ks, int half) { return d0 * 512 + ks * 4096 + half * 2048; }
template <int OFF> __device__ __forceinline__ s16x4 tr_read(int vb) { s16x4 r; asm volatile("ds_read_b64_tr_b16 %0, %1 offset:%2" : "=&v"(r) : "v"(vb), "i"(OFF) : "memory"); return r; }
template <int D0> __device__ __forceinline__ void pv_one(f32x16& od, int vb, bf16x8 pa0, bf16x8 pa1, bf16x8 pa2, bf16x8 pa3) {
    const s16x4 l0 = tr_read<v_rd_off(D0, 0, 0)>(vb), h0 = tr_read<v_rd_off(D0, 0, 1)>(vb), l1 = tr_read<v_rd_off(D0, 1, 0)>(vb), h1 = tr_read<v_rd_off(D0, 1, 1)>(vb);
    const s16x4 l2 = tr_read<v_rd_off(D0, 2, 0)>(vb), h2 = tr_read<v_rd_off(D0, 2, 1)>(vb), l3 = tr_read<v_rd_off(D0, 3, 0)>(vb), h3 = tr_read<v_rd_off(D0, 3, 1)>(vb);
    asm volatile("s_waitcnt lgkmcnt(0)" ::: "memory"); __builtin_amdgcn_sched_barrier(0);
#define PKV(L, H) (bf16x8){L[0], L[1], L[2], L[3], H[0], H[1], H[2], H[3]}
    od = __builtin_amdgcn_mfma_f32_32x32x16_bf16(pa0, PKV(l0, h0), od, 0, 0, 0);
    od = __builtin_amdgcn_mfma_f32_32x32x16_bf16(pa1, PKV(l1, h1), od, 0, 0, 0);
    od = __builtin_amdgcn_mfma_f32_32x32x16_bf16(pa2, PKV(l2, h2), od, 0, 0, 0);
    od = __builtin_amdgcn_mfma_f32_32x32x16_bf16(pa3, PKV(l3, h3), od, 0, 0, 0);
#undef PKV
}
constexpr int AT_K = 0, AT_V = 32768, AT_TAB = 65536, AT_WS = 65536 + 8192, AT_KV = 16384;
__device__ __forceinline__ void attn_tile_update(f32x16& p0, f32x16& p1, f32x16 (&o)[4], float& m_reg, float& l_reg, int vb, LAS float* al_l, int r32, int hi) {
    float pmax = p0[0];
#pragma unroll
    for (int r = 1; r < 16; ++r) pmax = fmaxf(pmax, p0[r]);
#pragma unroll
    for (int r = 0; r < 16; ++r) pmax = fmaxf(pmax, p1[r]);
    pmax = fmaxf(pmax, __shfl_xor(pmax, 32));
    const float mn = fmaxf(m_reg, pmax), alpha = fexp2(m_reg - mn);
    m_reg = mn;
    if (__any(alpha < 1.f)) {
        if (hi == 0) al_l[r32] = alpha;
        asm volatile("s_waitcnt lgkmcnt(0)" ::: "memory");
#pragma unroll
        for (int r = 0; r < 16; ++r) { const float a = al_l[crow(r, hi)];
#pragma unroll
            for (int d = 0; d < 4; ++d) o[d][r] *= a; }
        asm volatile("s_waitcnt lgkmcnt(0)" ::: "memory");
    }
    float ps = 0.f;
#pragma unroll
    for (int r = 0; r < 16; ++r) { p0[r] = fexp2(p0[r] - mn); p1[r] = fexp2(p1[r] - mn); ps += p0[r] + p1[r]; }
    ps += __shfl_xor(ps, 32);
    l_reg = l_reg * alpha + ps;
    bf16x8 pa0, pa1, pa2, pa3;
#define PK4(P, BASE, OUT) do { const unsigned a0 = pg8::cvt_pk_bf16(P[BASE + 0], P[BASE + 1]), a1 = pg8::cvt_pk_bf16(P[BASE + 2], P[BASE + 3]);   \
    const unsigned b0 = pg8::cvt_pk_bf16(P[BASE + 4], P[BASE + 5]), b1 = pg8::cvt_pk_bf16(P[BASE + 6], P[BASE + 7]);                              \
    auto r0 = __builtin_amdgcn_permlane32_swap(a0, b0, false, false); auto r1 = __builtin_amdgcn_permlane32_swap(a1, b1, false, false); \
    v4u wv = {r0[0], r1[0], r0[1], r1[1]}; OUT = __builtin_bit_cast(bf16x8, wv); } while (0)
    PK4(p0, 0, pa0); PK4(p0, 8, pa1); PK4(p1, 0, pa2); PK4(p1, 8, pa3);
#undef PK4
    pv_one<0>(o[0], vb, pa0, pa1, pa2, pa3); pv_one<1>(o[1], vb, pa0, pa1, pa2, pa3); pv_one<2>(o[2], vb, pa0, pa1, pa2, pa3); pv_one<3>(o[3], vb, pa0, pa1, pa2, pa3);
}
__device__ __forceinline__ void attn_qkt(f32x16& p0, f32x16& p1, const LAS unsigned char* Ks, const bf16x8 (&qr)[8], int r32, int hi) {
    p0 = (f32x16){}; p1 = (f32x16){};
#pragma unroll
    for (int d0 = 0; d0 < 8; ++d0) { const int cb = (d0 * 16 + hi * 8) * 2;
        const bf16x8 b0 = *(const LAS bf16x8*)(Ks + KSWZ(r32, cb)), b1 = *(const LAS bf16x8*)(Ks + KSWZ(32 + r32, cb));
        p0 = __builtin_amdgcn_mfma_f32_32x32x16_bf16(b0, qr[d0], p0, 0, 0, 0);
        p1 = __builtin_amdgcn_mfma_f32_32x32x16_bf16(b1, qr[d0], p1, 0, 0, 0); }
}
struct KVStage { v4u k0, k1, v0, v1; };
__device__ __forceinline__ void kv_load(KVStage& st, const bf16* Kp, const bf16* Vp, int row0, int sr, int sc) {
    st.k0 = *(const GAS v4u*)(Kp + (size_t)(row0 + sr) * PW + sc); st.k1 = *(const GAS v4u*)(Kp + (size_t)(row0 + 32 + sr) * PW + sc);
    st.v0 = *(const GAS v4u*)(Vp + (size_t)(row0 + sr) * PW + sc); st.v1 = *(const GAS v4u*)(Vp + (size_t)(row0 + 32 + sr) * PW + sc);
}
__device__ __forceinline__ void kv_write(const KVStage& st, LAS unsigned char* Kb, LAS unsigned char* Vb, int sr, int sc) {
    *(LAS v4u*)(Kb + KSWZ(sr, sc * 2)) = st.k0; *(LAS v4u*)(Kb + KSWZ(32 + sr, sc * 2)) = st.k1;
    *(LAS v4u*)(Vb + v_st(sr, sc)) = st.v0; *(LAS v4u*)(Vb + v_st(32 + sr, sc)) = st.v1;
}
__device__ __forceinline__ void attn_store(const f32x16 (&o)[4], float l_reg, LAS float* li_l, bf16* Yrow0  , int r32, int hi) {
    if (hi == 0) li_l[r32] = l_reg;
    asm volatile("s_waitcnt lgkmcnt(0)" ::: "memory");
#pragma unroll
    for (int r = 0; r < 16; ++r) { const int orow = crow(r, hi); const float rl = frcp(li_l[orow]);
#pragma unroll
        for (int d0 = 0; d0 < 4; ++d0) ((GAS bf16*)Yrow0)[(unsigned)(orow * DM + d0 * 32 + r32)] = (bf16)f2bf(o[d0][r] * rl); }
    asm volatile("s_waitcnt lgkmcnt(0)" ::: "memory");
}
__device__ __forceinline__ void mixA_mfma(Frame& F, const bf16* P, bf16* Y, const float* tab, const float* sink, int Ts) {
    const int lane = lane_id(), w = F.wave, tid = w * 64 + lane, r32 = lane & 31, hi = lane >> 5, sr = tid >> 4, sc = (tid & 15) * 8;
    LAS unsigned char* const L = F.lds + RING_OFF;
    LAS float* const TB = (LAS float*)(L + AT_TAB);
    LAS float* const wsf = (LAS float*)(L + AT_WS) + w * 64;
    const int nqb = Ts >> 7, nitems = (MS >> 7) * 4;
    for (int item = blockIdx.x; item < nitems; item += F.G) {
        const int hp = item & 1, kvh = (item >> 1) & 1, qblk = item >> 2, n = qblk & (nqb - 1), rb = (qblk - n) << 7;
        const int h = kvh * 4 + hp * 2 + (w >> 2), q0 = 128 * n + 32 * (w & 3);
        __syncthreads();
        for (int e = tid; e < 2 * 448; e += 512) { const int hl = e / 448, idx = e % 448 - 96; TB[e] = (idx >= 0 && idx <= 256) ? tab[TAB_T5 + (kvh * 4 + hp * 2 + hl) * 260 + idx] : -1e30f; }
        bf16x8 qr[8];
        { const bf16* qp = P + (size_t)(rb + q0 + r32) * PW + O_AQ + h * 128 + hi * 8;
#pragma unroll
          for (int d0 = 0; d0 < 8; ++d0) qr[d0] = *(const GAS bf16x8*)(qp + d0 * 16); }
        f32x16 o[4] = {}; float m_reg = sink[h] * LOG2E, l_reg = 1.0f;
        const int kt0 = n == 0 ? 0 : 2 * n - 2, kt1 = (n == nqb - 1) ? 2 * n + 2 : 2 * n + 4;
        const bf16* Kp = P + (size_t)rb * PW + O_AK + kvh * 128; const bf16* Vp = P + (size_t)rb * PW + O_AV + kvh * 128;
        KVStage st0, st1; kv_load(st0, Kp, Vp, 64 * kt0, sr, sc);
        if (kt0 + 1 < kt1) kv_load(st1, Kp, Vp, 64 * (kt0 + 1), sr, sc);
        kv_write(st0, L + AT_K, L + AT_V, sr, sc);
        __syncthreads();
        const LAS float* tbh = TB + (w >> 2) * 448;
#define MIXA_STEP(kt, STN, STW) do { const int b = ((kt) - kt0) & 1; \
            if ((kt) + 2 < kt1) kv_load(STN, Kp, Vp, 64 * ((kt) + 2), sr, sc); \
            const int k0 = 64 * (kt); \
            if (k0 + 63 >= q0 - 128 && k0 <= q0 + 31 + 128) { \
                f32x16 p0, p1; attn_qkt(p0, p1, L + AT_K + b * AT_KV, qr, r32, hi); \
                const LAS float* tl = tbh + (k0 - q0 - r32 + 4 * hi + 224); \
                _Pragma("unroll") for (int r = 0; r < 16; ++r) { p0[r] += tl[(r & 3) + 8 * (r >> 2)]; p1[r] += tl[32 + (r & 3) + 8 * (r >> 2)]; } \
                attn_tile_update(p0, p1, o, m_reg, l_reg, (int)(uintptr_t)(L + AT_V + b * AT_KV) + v_rd_base(lane), wsf, r32, hi); } \
            if ((kt) + 1 < kt1) kv_write(STW, L + AT_K + (b ^ 1) * AT_KV, L + AT_V + (b ^ 1) * AT_KV, sr, sc); \
            __syncthreads(); } while (0)
        for (int kt = kt0; kt < kt1; kt += 2) {
            MIXA_STEP(kt, st0, st1);
            MIXA_STEP(kt + 1, st1, st0);
        }
#undef MIXA_STEP
        { bf16* Yq = Y; asm volatile("" : "+s"(Yq)); attn_store(o, l_reg, wsf, Yq + (size_t)(rb + q0) * DM + h * 128, r32, hi); }
    }
    __syncthreads();
}
__device__ __forceinline__ void mixB_mfma(Frame& F, const bf16* P, bf16* Y, const float* nab, int Ts) {
    const int lane = lane_id(), w = F.wave, tid = w * 64 + lane, r32 = lane & 31, hi = lane >> 5, sr = tid >> 4, sc = (tid & 15) * 8;
    LAS unsigned char* const L = F.lds + RING_OFF;
    LAS float* const TB = (LAS float*)(L + AT_TAB);
    LAS float* const wsf = (LAS float*)(L + AT_WS) + w * 64;
    const int rows = Ts >> 6, ngrp = rows >> 2, nitems = (MS >> 8) * 4;
    for (int item = blockIdx.x; item < nitems; item += F.G) {
        const int h = item & 3, g = item >> 2, gi = g & (ngrp - 1), rb = (g - gi) << 8, r0 = 4 * gi, r = r0 + (w >> 1), c = 32 * (w & 1) + r32;
        __syncthreads();
        for (int e = tid; e < 15 * 128; e += 512) { const int dr = e >> 7, dci = (e & 127) - 48; TB[e] = (dci >= 0 && dci <= 30) ? nab[(h * 15 + dr) * 31 + dci] * LOG2E : -1e30f; }
        bf16x8 qr[8];
        { const bf16* qp = P + (size_t)(rb + r * 64 + c) * PW + O_BQ + h * 128 + hi * 8;
#pragma unroll
          for (int d0 = 0; d0 < 8; ++d0) qr[d0] = *(const GAS bf16x8*)(qp + d0 * 16); }
        f32x16 o[4] = {}; float m_reg = -1e30f, l_reg = 0.0f;
        int rs = r - 4; rs = rs < 0 ? 0 : (rs > rows - 8 ? rows - 8 : rs);
        int t0 = r0 - 4; t0 = t0 < 0 ? 0 : (t0 > rows - 8 ? rows - 8 : t0);
        int t1 = r0 + 3 - 4; t1 = (t1 < 0 ? 0 : (t1 > rows - 8 ? rows - 8 : t1)) + 8;
        int cs = c - 8; cs = cs < 0 ? 0 : (cs > 48 ? 48 : cs);
        const unsigned long long vm = (0xFFFFull << cs) >> (4 * hi);
        const unsigned mlo = (unsigned)vm, mhi = (unsigned)(vm >> 32);
        const bf16* Kp = P + (size_t)rb * PW + O_BK + h * 128; const bf16* Vp = P + (size_t)rb * PW + O_BV + h * 128;
        KVStage st0, st1; kv_load(st0, Kp, Vp, 64 * t0, sr, sc);
        if (t0 + 1 < t1) kv_load(st1, Kp, Vp, 64 * (t0 + 1), sr, sc);
        kv_write(st0, L + AT_K, L + AT_V, sr, sc);
        __syncthreads();
#define MIXB_STEP(kr, STN, STW) do { const int b = ((kr) - t0) & 1; \
            if ((kr) + 2 < t1) kv_load(STN, Kp, Vp, 64 * ((kr) + 2), sr, sc); \
            if ((kr) >= rs && (kr) < rs + 8) { \
                f32x16 p0, p1; attn_qkt(p0, p1, L + AT_K + b * AT_KV, qr, r32, hi); \
                const LAS float* tl = TB + ((kr) - r + 7) * 128 + (4 * hi - c + 63); \
                _Pragma("unroll") for (int q = 0; q < 16; ++q) { const int kc = (q & 3) + 8 * (q >> 2); \
                    p0[q] = ((mlo >> kc) & 1u) ? p0[q] + tl[kc] : -1e30f; p1[q] = ((mhi >> kc) & 1u) ? p1[q] + tl[32 + kc] : -1e30f; } \
                attn_tile_update(p0, p1, o, m_reg, l_reg, (int)(uintptr_t)(L + AT_V + b * AT_KV) + v_rd_base(lane), wsf, r32, hi); } \
            if ((kr) + 1 < t1) kv_write(STW, L + AT_K + (b ^ 1) * AT_KV, L + AT_V + (b ^ 1) * AT_KV, sr, sc); \
            __syncthreads(); } while (0)
        for (int kr = t0; kr < t1; kr += 2) {
            MIXB_STEP(kr, st0, st1);
            if (kr + 1 < t1) MIXB_STEP(kr + 1, st1, st0);
        }
#undef MIXB_STEP
        { bf16* Yq = Y; asm volatile("" : "+s"(Yq)); attn_store(o, l_reg, wsf, Yq + (size_t)(rb + r * 64 + 32 * (w & 1)) * DM + 1024 + h * 128, r32, hi); }
    }
    __syncthreads();
}

typedef float f32x4v __attribute__((ext_vector_type(4)));
constexpr int HG_VS = 288;
constexpr int HG_KL = 272;
constexpr int ST_ITEM = 2 * 128 * 128;
template <int SH> __device__ __forceinline__ float dpp_shr(float v) { return __builtin_bit_cast(float, __builtin_amdgcn_update_dpp(0, __builtin_bit_cast(int, v), 0x110 + SH, 0xf, 0xf, true)); }
template <int SH> __device__ __forceinline__ float dpp_shl(float v) { return __builtin_bit_cast(float, __builtin_amdgcn_update_dpp(0, __builtin_bit_cast(int, v), 0x100 + SH, 0xf, 0xf, true)); }
__device__ __forceinline__ float row_scan(float v, int dir) {
    if (dir == 0) { v += dpp_shr<1>(v); v += dpp_shr<2>(v); v += dpp_shr<4>(v); v += dpp_shr<8>(v); }
    else          { v += dpp_shl<1>(v); v += dpp_shl<2>(v); v += dpp_shl<4>(v); v += dpp_shl<8>(v); }
    return v;
}
__device__ __forceinline__ void ld32bf(const bf16* p, float (&o)[32]) {
#pragma unroll
    for (int m = 0; m < 4; ++m) { const v4u w = *(const GAS v4u*)(p + 8 * m);
        o[8 * m + 0] = bflo(w.x); o[8 * m + 1] = bfhi(w.x); o[8 * m + 2] = bflo(w.y); o[8 * m + 3] = bfhi(w.y); o[8 * m + 4] = bflo(w.z); o[8 * m + 5] = bfhi(w.z); o[8 * m + 6] = bflo(w.w); o[8 * m + 7] = bfhi(w.w); }
}
#define HG_PREP(VS_OFF, TOT_OFF) \
    const int lane = lane_id(), tl = lane & 15, kq = lane >> 4, w = F.wave, dir = w >> 2, i = w & 3, tid = w * 64 + lane; \
    LAS unsigned char* const vs = F.lds + RING_OFF + (VS_OFF); LAS float* const TOT = (LAS float*)(F.lds + RING_OFF + (TOT_OFF));
constexpr int HG_TS = 144;
__device__ __forceinline__ void hg_h1(Frame& F, const bf16* P, bf16* ST, float* DEC) {
    const int lane = lane_id(), tl = lane & 15, kq = lane >> 4, w = F.wave, dir = w >> 2, i = w & 3, tid = w * 64 + lane;
    LAS unsigned char* const KT = F.lds + RING_OFF;
    LAS unsigned char* const VT = F.lds + RING_OFF + 36864;
    LAS float* const TOT = (LAS float*)(F.lds + RING_OFF + 55296);
    for (int item = blockIdx.x; item < MS / 64 * 4; item += F.G) {
        const int chunk = item >> 2, h = item & 3, r0 = chunk * 64;
        __syncthreads();
#pragma unroll
        for (int k2 = 0; k2 < 2; ++k2) { const int idx = tid + 512 * k2, row = idx >> 4, c16 = idx & 15;
            const v4u vv = *(const GAS v4u*)(P + (size_t)(r0 + row) * PW + O_CI + h * 128 + 8 * c16);
            LAS unsigned char* vp = VT + (8 * c16) * HG_TS + 2 * row;
            *(LAS unsigned short*)(vp) = (unsigned short)vv.x; *(LAS unsigned short*)(vp + HG_TS) = (unsigned short)(vv.x >> 16);
            *(LAS unsigned short*)(vp + 2 * HG_TS) = (unsigned short)vv.y; *(LAS unsigned short*)(vp + 3 * HG_TS) = (unsigned short)(vv.y >> 16);
            *(LAS unsigned short*)(vp + 4 * HG_TS) = (unsigned short)vv.z; *(LAS unsigned short*)(vp + 5 * HG_TS) = (unsigned short)(vv.z >> 16);
            *(LAS unsigned short*)(vp + 6 * HG_TS) = (unsigned short)vv.w; *(LAS unsigned short*)(vp + 7 * HG_TS) = (unsigned short)(vv.w >> 16); }
        float g[32];
        ld32bf(P + (size_t)(r0 + 16 * i + tl) * PW + O_CFF + dir * 512 + h * 128 + 32 * kq, g);
        float kl[32];
#pragma unroll
        for (int s = 0; s < 32; ++s) { const float c = row_scan(g[s], dir), rc = row_scan(g[s], 1 - dir) - g[s];
            if (tl == (dir == 0 ? 15 : 0)) TOT[(dir * 4 + i) * 128 + 32 * kq + s] = c;
            kl[s] = (1.0f - fexp2(g[s])) * fexp2(rc); if ((s & 3) == 3) asm volatile("" ::: "memory"); }
        __syncthreads();
#pragma unroll
        for (int s4 = 0; s4 < 8; ++s4) {
            f32x4v tv[4];
#pragma unroll
            for (int m = 0; m < 4; ++m) tv[m] = *(const LAS f32x4v*)(TOT + (dir * 4 + m) * 128 + 32 * kq + 4 * s4);
            f32x4v a = (f32x4v){0.f, 0.f, 0.f, 0.f};
#pragma unroll
            for (int m = 0; m < 4; ++m) if (dir == 0 ? m > i : m < i) a += tv[m];
            LAS unsigned char* kp = KT + (dir * 128 + 32 * kq + 4 * s4) * HG_TS + 2 * (16 * i + tl);
#pragma unroll
            for (int k = 0; k < 4; ++k) *(LAS unsigned short*)(kp + k * HG_TS) = (unsigned short)f2bf(kl[4 * s4 + k] * fexp2(a[k]));
            if (i == 0 && tl == 0) { const f32x4v all = (tv[0] + tv[1]) + (tv[2] + tv[3]);
                *(GAS f32x4v*)(DEC + ((size_t)item * 2 + dir) * 128 + 32 * kq + 4 * s4) = (f32x4v){fexp2(all[0]), fexp2(all[1]), fexp2(all[2]), fexp2(all[3])}; }
            asm volatile("" ::: "memory");
        }
        __syncthreads();
        f32x4v acc[2][8];
#pragma unroll
        for (int a = 0; a < 2; ++a)
#pragma unroll
            for (int T = 0; T < 8; ++T) acc[a][T] = (f32x4v){0.f, 0.f, 0.f, 0.f};
#pragma unroll
        for (int m = 0; m < 2; ++m) {
            const bf16x8 a0 = *(const LAS bf16x8*)(KT + (dir * 128 + 32 * i + tl) * HG_TS + 64 * m + 16 * kq), a1 = *(const LAS bf16x8*)(KT + (dir * 128 + 32 * i + 16 + tl) * HG_TS + 64 * m + 16 * kq);
#pragma unroll
            for (int T = 0; T < 8; ++T) { const bf16x8 bv = *(const LAS bf16x8*)(VT + (16 * T + tl) * HG_TS + 64 * m + 16 * kq);
                acc[0][T] = __builtin_amdgcn_mfma_f32_16x16x32_bf16(a0, bv, acc[0][T], 0, 0, 0); acc[1][T] = __builtin_amdgcn_mfma_f32_16x16x32_bf16(a1, bv, acc[1][T], 0, 0, 0); }
        }
        bf16* sp = ST + (size_t)item * ST_ITEM + (size_t)dir * 16384;
#pragma unroll
        for (int a = 0; a < 2; ++a)
#pragma unroll
            for (int T = 0; T < 8; ++T) { v2u wv; wv.x = pk2(acc[a][T][0], acc[a][T][1]); wv.y = pk2(acc[a][T][2], acc[a][T][3]);
                *(GAS v2u*)(sp + (size_t)(16 * T + tl) * 128 + 32 * i + 16 * a + 4 * kq) = wv; }
    }
    __syncthreads();
}
__device__ __forceinline__ void hg_scan(Frame& F, bf16* ST, const float* DEC, int nseq, int nchunk) {
    const int gt = blockIdx.x * 512 + F.wave * 64 + lane_id(), NT = F.G * 512, total = nseq * 16384;
    for (int idx = gt; idx < total; idx += NT) {
        const int d8 = idx & 15, e = (idx >> 4) & 127, dir = (idx >> 11) & 1, h = (idx >> 12) & 3, sq = idx >> 14;
        float S[8];
#pragma unroll
        for (int k = 0; k < 8; ++k) S[k] = 0.f;
#pragma unroll 8
        for (int st = 0; st < nchunk; ++st) {
            const int c = dir == 0 ? st : nchunk - 1 - st; const size_t it2 = ((size_t)(sq * nchunk + c) * 4 + h) * 2 + dir;
            GAS v4u* p = (GAS v4u*)(ST + it2 * 16384 + (size_t)e * 128 + 8 * d8);
            const v4u dl = *p; const f32x4 dc0 = *(const GAS f32x4*)(DEC + it2 * 128 + 8 * d8), dc1 = *(const GAS f32x4*)(DEC + it2 * 128 + 8 * d8 + 4);
            v4u wv; wv.x = pk2(S[0], S[1]); wv.y = pk2(S[2], S[3]); wv.z = pk2(S[4], S[5]); wv.w = pk2(S[6], S[7]);
            *p = wv;
            float df[8]; v8(dl, df);
            S[0] = S[0] * dc0[0] + df[0]; S[1] = S[1] * dc0[1] + df[1]; S[2] = S[2] * dc0[2] + df[2]; S[3] = S[3] * dc0[3] + df[3];
            S[4] = S[4] * dc1[0] + df[4]; S[5] = S[5] * dc1[1] + df[5]; S[6] = S[6] * dc1[2] + df[6]; S[7] = S[7] * dc1[3] + df[7];
        }
    }
}
__device__ __forceinline__ void hg_h3(Frame& F, const bf16* P, const bf16* ST, bf16* Y, const float* gain) {
    HG_PREP(34816, 53248)
    LAS unsigned char* const KL = F.lds + RING_OFF;
    LAS float* const TR = (LAS float*)(F.lds + RING_OFF + 57344) + w * 320;
    LAS float* const OX = (LAS float*)(F.lds + RING_OFF);
    for (int item = blockIdx.x; item < MS / 64 * 4; item += F.G) {
        const int chunk = item >> 2, h = item & 3, r0 = chunk * 64, row = r0 + 16 * i + tl;
        const bf16* sp = ST + (size_t)item * ST_ITEM + (size_t)dir * 16384 + (size_t)(8 * tl) * 128 + 32 * kq;
        v4u sa[8], sb[8];
#define HG_LDS(buf, m_) do { _Pragma("unroll") for (int T_ = 0; T_ < 8; ++T_) buf[T_] = *(const GAS v4u*)(sp + T_ * 128 + 8 * (m_)); } while (0)
#define HG_MMS(buf, m_) do { v4u aw_; aw_.x = pg8::cvt_pk_bf16(qd[8 * (m_)], qd[8 * (m_) + 1]); aw_.y = pg8::cvt_pk_bf16(qd[8 * (m_) + 2], qd[8 * (m_) + 3]); \
        aw_.z = pg8::cvt_pk_bf16(qd[8 * (m_) + 4], qd[8 * (m_) + 5]); aw_.w = pg8::cvt_pk_bf16(qd[8 * (m_) + 6], qd[8 * (m_) + 7]); const bf16x8 af_ = __builtin_bit_cast(bf16x8, aw_); \
        _Pragma("unroll") for (int T_ = 0; T_ < 8; ++T_) o[T_] = __builtin_amdgcn_mfma_f32_16x16x32_bf16(af_, __builtin_bit_cast(bf16x8, buf[T_]), o[T_], 0, 0, 0); } while (0)
        HG_LDS(sa, 0); HG_LDS(sb, 1);
        __syncthreads();
#pragma unroll
        for (int k2 = 0; k2 < 2; ++k2) { const int idx = tid + 512 * k2, rw = idx >> 4, c16 = idx & 15;
            *(LAS v4u*)(vs + rw * HG_VS + c16 * 16) = *(const GAS v4u*)(P + (size_t)(r0 + rw) * PW + O_CI + h * 128 + 8 * c16); }
        float qd[32]; bf16x8 kdp[4];
        { float g[32];
          ld32bf(P + (size_t)row * PW + O_CFF + dir * 512 + h * 128 + 32 * kq, g);
          ld32bf(P + (size_t)row * PW + O_CQ + h * 128 + 32 * kq, qd);
#pragma unroll
          for (int m = 0; m < 4; ++m) { float kd8[8];
#pragma unroll
              for (int j = 0; j < 8; ++j) { const int s = 8 * m + j;
                  const float c = row_scan(g[s], dir), rc = row_scan(g[s], 1 - dir) - g[s];
                  if (tl == (dir == 0 ? 15 : 0)) TOT[(dir * 4 + i) * 128 + 32 * kq + s] = c;
                  const float k = 1.0f - fexp2(g[s]);
                  g[s] = k * fexp2(rc);
                  qd[s] *= fexp2(c); kd8[j] = k * fexp2(fminf(-c, 120.0f)); }
              v4u wv; wv.x = pg8::cvt_pk_bf16(g[8 * m], g[8 * m + 1]); wv.y = pg8::cvt_pk_bf16(g[8 * m + 2], g[8 * m + 3]); wv.z = pg8::cvt_pk_bf16(g[8 * m + 4], g[8 * m + 5]); wv.w = pg8::cvt_pk_bf16(g[8 * m + 6], g[8 * m + 7]);
              *(LAS v4u*)(KL + (dir * 64 + 16 * i + tl) * HG_KL + (32 * kq + 8 * m) * 2) = wv;
              v4u kv; kv.x = pg8::cvt_pk_bf16(kd8[0], kd8[1]); kv.y = pg8::cvt_pk_bf16(kd8[2], kd8[3]); kv.z = pg8::cvt_pk_bf16(kd8[4], kd8[5]); kv.w = pg8::cvt_pk_bf16(kd8[6], kd8[7]);
              kdp[m] = __builtin_bit_cast(bf16x8, kv);
              asm volatile("" ::: "memory"); } }
        __syncthreads();
        f32x4v o[8];
#pragma unroll
        for (int T = 0; T < 8; ++T) o[T] = (f32x4v){0.f, 0.f, 0.f, 0.f};
#define HG_PACK8(x, m_) __builtin_bit_cast(bf16x8, (v4u){pg8::cvt_pk_bf16(x[8 * (m_)], x[8 * (m_) + 1]), pg8::cvt_pk_bf16(x[8 * (m_) + 2], x[8 * (m_) + 3]), pg8::cvt_pk_bf16(x[8 * (m_) + 4], x[8 * (m_) + 5]), pg8::cvt_pk_bf16(x[8 * (m_) + 6], x[8 * (m_) + 7])})
        { f32x4v a4 = (f32x4v){0.f, 0.f, 0.f, 0.f};
#pragma unroll
          for (int m = 0; m < 4; ++m) a4 = __builtin_amdgcn_mfma_f32_16x16x32_bf16(HG_PACK8(qd, m), kdp[m], a4, 0, 0, 0);
#pragma unroll
          for (int r = 0; r < 4; ++r) { const int t = 4 * kq + r; const bool keep = dir == 0 ? (tl <= t) : (tl >= t); TR[t * 20 + tl] = keep ? a4[r] : 0.f; }
          LDS_WAIT(); asm volatile("" ::: "memory");
#pragma unroll
          for (int m = 0; m < 4; ++m) { const float a = TR[tl * 20 + 4 * m + kq]; float vf[8]; v8(*(const LAS v4u*)(vs + (16 * i + 4 * m + kq) * HG_VS + tl * 16), vf);
#pragma unroll
              for (int T = 0; T < 8; ++T) o[T] = __builtin_amdgcn_mfma_f32_16x16x4f32(a, vf[T], o[T], 0, 0, 0); }
          LDS_WAIT(); asm volatile("" ::: "memory"); }
        const int nblk = dir == 0 ? i : 3 - i;
        for (int jj = 1; jj <= nblk; ++jj) {
            const int j = dir == 0 ? i - jj : i + jj;
            if (jj >= 2) { const LAS float* tp = TOT + (dir * 4 + (dir == 0 ? j + 1 : j - 1)) * 128 + 32 * kq;
#pragma unroll
                for (int s4 = 0; s4 < 8; ++s4) { const f32x4v t4 = *(const LAS f32x4v*)(tp + 4 * s4); qd[4 * s4] *= fexp2(t4[0]); qd[4 * s4 + 1] *= fexp2(t4[1]); qd[4 * s4 + 2] *= fexp2(t4[2]); qd[4 * s4 + 3] *= fexp2(t4[3]); } }
            f32x4v a4 = (f32x4v){0.f, 0.f, 0.f, 0.f};
            { const LAS unsigned char* kp = KL + (dir * 64 + 16 * j + tl) * HG_KL + 64 * kq;
#pragma unroll
              for (int m = 0; m < 4; ++m) a4 = __builtin_amdgcn_mfma_f32_16x16x32_bf16(HG_PACK8(qd, m), *(const LAS bf16x8*)(kp + 16 * m), a4, 0, 0, 0); }
#pragma unroll
            for (int r = 0; r < 4; ++r) TR[(4 * kq + r) * 20 + tl] = a4[r];
            LDS_WAIT(); asm volatile("" ::: "memory");
#pragma unroll
            for (int m = 0; m < 4; ++m) { const float a = TR[tl * 20 + 4 * m + kq]; float vf[8]; v8(*(const LAS v4u*)(vs + (16 * j + 4 * m + kq) * HG_VS + tl * 16), vf);
#pragma unroll
                for (int T = 0; T < 8; ++T) o[T] = __builtin_amdgcn_mfma_f32_16x16x4f32(a, vf[T], o[T], 0, 0, 0); }
            LDS_WAIT(); asm volatile("" ::: "memory");
        }
        if (nblk >= 1) { const LAS float* tp = TOT + (dir * 4 + (dir == 0 ? 0 : 3)) * 128 + 32 * kq;
#pragma unroll
            for (int s4 = 0; s4 < 8; ++s4) { const f32x4v t4 = *(const LAS f32x4v*)(tp + 4 * s4); qd[4 * s4] *= fexp2(t4[0]); qd[4 * s4 + 1] *= fexp2(t4[1]); qd[4 * s4 + 2] *= fexp2(t4[2]); qd[4 * s4 + 3] *= fexp2(t4[3]); } }
        HG_MMS(sa, 0); HG_LDS(sa, 2); HG_MMS(sb, 1); HG_LDS(sb, 3); HG_MMS(sa, 2); HG_MMS(sb, 3);
#undef HG_LDS
#undef HG_MMS
#undef HG_PACK8
        __syncthreads();
        if (dir == 1) {
#pragma unroll
            for (int r = 0; r < 4; ++r) { LAS float* q = OX + (i * 16 + 4 * kq + r) * 128 + 8 * tl;
                *(LAS f32x4v*)q = (f32x4v){o[0][r], o[1][r], o[2][r], o[3][r]}; *(LAS f32x4v*)(q + 4) = (f32x4v){o[4][r], o[5][r], o[6][r], o[7][r]}; } }
        __syncthreads();
        if (dir == 0) {
            const f32x4v g0 = *(const GAS f32x4v*)(gain + h * 128 + 8 * tl), g1 = *(const GAS f32x4v*)(gain + h * 128 + 8 * tl + 4);
#pragma unroll
            for (int r = 0; r < 4; ++r) { const LAS float* q = OX + (i * 16 + 4 * kq + r) * 128 + 8 * tl;
                const f32x4v x0 = *(const LAS f32x4v*)q, x1 = *(const LAS f32x4v*)(q + 4);
                float v[8] = {o[0][r] + x0[0], o[1][r] + x0[1], o[2][r] + x0[2], o[3][r] + x0[3], o[4][r] + x1[0], o[5][r] + x1[1], o[6][r] + x1[2], o[7][r] + x1[3]};
                float ss = 0.f;
#pragma unroll
                for (int T = 0; T < 8; ++T) ss += v[T] * v[T];
                ss += __shfl_xor(ss, 1); ss += __shfl_xor(ss, 2); ss += __shfl_xor(ss, 4); ss += __shfl_xor(ss, 8);
                const float rstd = 1.0f / sqrtf(ss * (1.0f / 128.0f) + EPS);
                const size_t orow = (size_t)(r0 + 16 * i + 4 * kq + r);
                float sg[8]; v8(*(const GAS v4u*)(P + orow * PW + O_CG + h * 128 + 8 * tl), sg);
                v4u wv; wv.x = pk2(v[0] * rstd * g0[0] * sg[0], v[1] * rstd * g0[1] * sg[1]); wv.y = pk2(v[2] * rstd * g0[2] * sg[2], v[3] * rstd * g0[3] * sg[3]);
                wv.z = pk2(v[4] * rstd * g1[0] * sg[4], v[5] * rstd * g1[1] * sg[5]); wv.w = pk2(v[6] * rstd * g1[2] * sg[6], v[7] * rstd * g1[3] * sg[7]);
                *(GAS v4u*)(Y + orow * DM + 1536 + h * 128 + 8 * tl) = wv; }
        }
    }
    __syncthreads();
}

constexpr int RS_OFF = MISC_OFF + 128;
static_assert(RS_OFF + 13 * 256 * 4 <= LDS_BYTES, "rstd table");
template <class Sched> __device__ __forceinline__ void rstd_prepass(Frame& F, const Sched& S, const float* ssq, int ubase = 0, const float* rowscale = nullptr) {
    const int lane = lane_id(), tid = F.wave * 64 + lane, row = tid >> 1, half = tid & 1;
    LAS float* RS = (LAS float*)(F.lds + RS_OFF) + ubase * 256;
    pg8::Unit u;
    for (int i = 0; S.next(i, u); ++i) {
        const float* p = ssq + (size_t)(u.pm * 256 + row) * 32 + 16 * half;
        const f32x4 a = *(const GAS f32x4*)p, b = *(const GAS f32x4*)(p + 4), c = *(const GAS f32x4*)(p + 8), d = *(const GAS f32x4*)(p + 12);
        float s = (((a[0] + a[1]) + (a[2] + a[3])) + ((b[0] + b[1]) + (b[2] + b[3]))) + (((c[0] + c[1]) + (c[2] + c[3])) + ((d[0] + d[1]) + (d[2] + d[3])));
        s += __shfl_xor(s, 1);
        if (half == 0) RS[i * 256 + row] = (1.0f / sqrtf(s * (1.0f / 2048.0f) + EPS)) * (rowscale ? rowscale[u.pm * 256 + row] : 1.0f);
    }
    __syncthreads();
}
constexpr int NPH = 12;
typedef const __attribute__((address_space(4))) Args* ArgP;
__device__ __forceinline__ ArgP argp() { ArgP p = (ArgP)__builtin_amdgcn_kernarg_segment_ptr(); asm volatile("" : "+s"(p)); return p; }
#define PH_BEGIN const ArgP A = argp(); const int lq = opq_s(l), sq = opq_s(s); unsigned char* const ws = A->ws; \
    const bf16* const Wl = (const bf16*)(ws + WS_W) + (size_t)lq * E_LAYER; float* const xs = A->out + (size_t)sq * MS * DM; \
    bf16* const XN = (bf16*)(ws + WS_XN); bf16* const PROJ = (bf16*)(ws + WS_PROJ); bf16* const ACT = (bf16*)(ws + WS_PROJ); bf16* const Y = (bf16*)(ws + WS_Y); \
    float* const OC = (float*)(ws + WS_OC); const float* const tab = (const float*)(ws + WS_TAB); const int Ts = sq == 0 ? 8192 : 2048; \
    bf16* const MG = (bf16*)(ws + WS_MG); float* const SSQ = (float*)(ws + WS_SSQ); \
    (void)Wl; (void)xs; (void)XN; (void)PROJ; (void)ACT; (void)Y; (void)OC; (void)tab; (void)Ts; (void)MG; (void)SSQ;
__global__ void __launch_bounds__(512, 2) fwd(Args args_unused) {
    extern __shared__ __attribute__((aligned(16))) unsigned char lds[];
    Frame F;
    F.lds = (LAS unsigned char*)lds;
    F.wave = __builtin_amdgcn_readfirstlane(threadIdx.x >> 6);
    F.G = gridDim.x; F.gw = blockIdx.x * 8 + F.wave; F.NGW = F.G * 8;
    volatile LAS unsigned* MISC = (volatile LAS unsigned*)(F.lds + MISC_OFF);
    for (int u = F.wave * 64 + lane_id(); u < (LDS_BYTES - LDSCTL_OFF) / 4; u += 512) ((LAS unsigned*)(F.lds + LDSCTL_OFF))[u] = 0u;
    __syncthreads();
    const ArgP A0 = argp();
    const int use_bar = A0->use_bar;
    XcdBarrier bar; bar.bar = (unsigned*)(A0->ws + WS_CTL) + CW_BAR; bar.x = 0; bar.st = nullptr;
    if (use_bar) bar = xcd_barrier_post((unsigned*)(A0->ws + WS_CTL) + CW_BAR, MISC + 8, F.wave == 0 && lane_id() == 0);
#define GRID_BAR() do { if (opq_s(use_bar)) xcd_barrier(bar, F.wave == 0 && lane_id() == 0); } while (0)
    LAS unsigned char* ring = F.lds + RING_OFF;

    if (A0->do_pro) { prologue(F, A0); GRID_BAR(); quant_gate_weights(F, A0); GRID_BAR(); }

    const int plo = A0->ph_lo, phi = A0->ph_hi, l_lo = A0->l_lo, l_hi = A0->l_hi, s_hi = A0->s_hi;
#define IN(k) (opq_s(plo) <= (k) && (k) < opq_s(phi))
    for (int s = A0->s_lo; s < s_hi; ++s) {
        for (int l = l_lo; l < l_hi; ++l) {
            if (IN(0)) { PH_BEGIN if (lq == 0) { const float* xin = sq == 0 ? A->in[I_XP] : A->in[I_XS] + (size_t)(sq - 1) * MS * DM; cast_rows(F, xin, XN, SSQ, MS); GRID_BAR(); } }
            if (IN(1)) { PH_BEGIN
                if (lq == 0) { quant_rows(F, XN, ws + WS_OC, (float*)(ws + WS_OC + XQ_SCALE), MS); GRID_BAR(); }
                const unsigned char* wq = (const unsigned char*)(Wl + EO_WGU1);
                pg8::Gemm g{(const pg8::bf16_t*)(ws + WS_OC), (const pg8::bf16_t*)wq, MS, 2 * DFF, DM / 2, DM / 2, DM / 2}; pg8::StaticOrder S; S.init(MS, 2 * DFF, F.G, (int)blockIdx.x);
                rstd_prepass(F, S, SSQ, 0, (const float*)(ws + WS_OC + XQ_SCALE)); pg8::EpiSwiGLUQ E{ACT, DFF, (const float*)(wq + WGUQ_SCALE), (const LAS float*)(F.lds + RS_OFF)};
                pg8::gemm_phase<pg8::EpiSwiGLUQ, pg8::StaticOrder, true, true, false, true>(ring, g, S, E, F.wave); GRID_BAR(); }
            if (IN(2)) { PH_BEGIN pg8::Gemm g{ACT, Wl + EO_WD1, MS, DM, DFF, DFF, DFF}; pg8::StaticOrder S; S.init(MS, DM, F.G, (int)blockIdx.x);
                if (F.wave == 0 && lane_id() == 0) MISC[11] += 1u; __syncthreads(); const unsigned ptgt = 8u * (unsigned)__builtin_amdgcn_readfirstlane((int)MISC[11]);
                pg8::EpiResid E{XN, DM, 0.5f, SSQ, (unsigned*)(ws + WS_CTL), ptgt, ws + WS_OC, (float*)(ws + WS_OC + XQ_SCALE), (LAS unsigned*)(F.lds + RS_OFF)}; pg8::gemm_phase<pg8::EpiResid, pg8::StaticOrder, true, true>(ring, g, S, E, F.wave); GRID_BAR(); }
            if (IN(3)) {
                for (int st = 0; st < 2; ++st) {
                    const int which = __builtin_amdgcn_readfirstlane((st + (int)(blockIdx.x & 1u)) & 1);
                    if (which == 0) { PH_BEGIN
                        pg8::Gemm g{XN, Wl + EO_WIN, MS, O_GA, DM, DM, DM}; pg8::StaticOrder S; S.init(MS, O_GA, F.G, (int)blockIdx.x);
                        rstd_prepass(F, S, SSQ); pg8::EpiProj E{PROJ, PW, tab + TAB_LB + (0 * NLAYER + lq) * 512, tab + TAB_LB + (1 * NLAYER + lq) * 512, (const LAS float*)(F.lds + RS_OFF)};
                        pg8::gemm_phase<pg8::EpiProj, pg8::StaticOrder, true, true>(ring, g, S, E, F.wave);
                    } else { PH_BEGIN
                        const unsigned char* wq = ws + WS_WQ + (size_t)lq * WQ_LAYER;
                        pg8::Gemm g{(const pg8::bf16_t*)(ws + WS_OC), (const pg8::bf16_t*)wq, MS, 3 * DM, DM / 2, DM / 2, DM / 2}; pg8::GateOrder S; S.init(MS, 3 * DM, F.G, (int)blockIdx.x);
                        rstd_prepass(F, S, SSQ, 6, (const float*)(ws + WS_OC + XQ_SCALE));
                        pg8::EpiGateQ E{(unsigned char*)(PROJ + O_GA), PW * 2, (const float*)(wq + WQ_SCALE), (const LAS float*)(F.lds + RS_OFF) + 6 * 256};
                        pg8::gemm_phase<pg8::EpiGateQ, pg8::GateOrder, true, true, false, true>(ring, g, S, E, F.wave);
                    }
                    __syncthreads();
                }
                GRID_BAR(); }
            if (IN(4)) { PH_BEGIN
                for (int st = 0; st < 3; ++st) {
                    const int which = __builtin_amdgcn_readfirstlane((st + (int)(blockIdx.x & 1u)) % 3);
                    if (which == 0) hg_h1(F, PROJ, (bf16*)OC, (float*)(ws + WS_MG));
                    else if (which == 1) mixA_mfma(F, PROJ, Y, tab, A->in[I_SINK] + lq * 8, Ts);
                    else mixB_mfma(F, PROJ, Y, A->in[I_NAB] + (size_t)lq * 4 * 15 * 31, Ts);
                }
                GRID_BAR(); }
            if (IN(5)) { PH_BEGIN hg_scan(F, (bf16*)OC, (const float*)(ws + WS_MG), MS / Ts, Ts / 64); GRID_BAR(); }
            if (IN(6)) { PH_BEGIN hg_h3(F, PROJ, (const bf16*)OC, Y, A->in[I_HN] + lq * 512); GRID_BAR(); }
            if (IN(7)) { PH_BEGIN pg8::SubOrder S; S.init(MS, DM, F.G, (int)blockIdx.x);
                pg8::Gemm g{Y, Wl + EO_WBR, MS, DM, DM, DM, DM}; pg8::EpiMerged E{PROJ, PW, MG, DM};
                pg8::gemm_phase<pg8::EpiMerged, pg8::SubOrder, true, true, true>(ring, g, S, E, F.wave); GRID_BAR(); }
            if (IN(8)) { PH_BEGIN pg8::Gemm g{MG, Wl + EO_WOUT, MS, DM, DM, DM, DM}; pg8::StaticOrder S; S.init(MS, DM, F.G, (int)blockIdx.x);
                if (F.wave == 0 && lane_id() == 0) MISC[11] += 1u; __syncthreads(); const unsigned ptgt = 8u * (unsigned)__builtin_amdgcn_readfirstlane((int)MISC[11]);
                pg8::EpiResid E{XN, DM, 1.0f, SSQ, (unsigned*)(ws + WS_CTL), ptgt, ws + WS_OC, (float*)(ws + WS_OC + XQ_SCALE), (LAS unsigned*)(F.lds + RS_OFF)}; pg8::gemm_phase<pg8::EpiResid, pg8::StaticOrder, true, true>(ring, g, S, E, F.wave); GRID_BAR(); }
            if (IN(9)) { PH_BEGIN
                const unsigned char* wq = (const unsigned char*)(Wl + EO_WGU2);
                pg8::Gemm g{(const pg8::bf16_t*)(ws + WS_OC), (const pg8::bf16_t*)wq, MS, 2 * DFF, DM / 2, DM / 2, DM / 2}; pg8::StaticOrder S; S.init(MS, 2 * DFF, F.G, (int)blockIdx.x);
                rstd_prepass(F, S, SSQ, 0, (const float*)(ws + WS_OC + XQ_SCALE)); pg8::EpiSwiGLUQ E{ACT, DFF, (const float*)(wq + WGUQ_SCALE), (const LAS float*)(F.lds + RS_OFF)};
                pg8::gemm_phase<pg8::EpiSwiGLUQ, pg8::StaticOrder, true, true, false, true>(ring, g, S, E, F.wave); GRID_BAR(); }
            if (IN(10)) { PH_BEGIN pg8::Gemm g{ACT, Wl + EO_WD2, MS, DM, DFF, DFF, DFF}; pg8::StaticOrder S; S.init(MS, DM, F.G, (int)blockIdx.x);
                if (F.wave == 0 && lane_id() == 0) MISC[11] += 1u; __syncthreads(); const unsigned ptgt = 8u * (unsigned)__builtin_amdgcn_readfirstlane((int)MISC[11]);
                pg8::EpiResid E{XN, DM, 0.5f, SSQ, (unsigned*)(ws + WS_CTL), ptgt, ws + WS_OC, (float*)(ws + WS_OC + XQ_SCALE), (LAS unsigned*)(F.lds + RS_OFF)}; pg8::gemm_phase<pg8::EpiResid, pg8::StaticOrder, true, true>(ring, g, S, E, F.wave); GRID_BAR(); }
            if (IN(11)) { PH_BEGIN if (lq == NLAYER - 1) { final_rows(F, XN, A->in[I_FN], xs, MS); GRID_BAR(); } }
        }
    }
#undef IN
}

extern "C" void kernel_launch(void* const* d_in, const int* in_sizes, int n_in, void* d_out, int out_size, void* d_ws, size_t ws_size, hipStream_t stream) {
    static int grid = 0;
    if (grid == 0) {
        if (n_in != 22 || out_size != MTOT * DM || ws_size < WS_END) { fprintf(stderr, "kernel_launch: unexpected shapes (n_in %d out %d ws %zu, need ws >= %zu)\n", n_in, out_size, ws_size, (size_t)WS_END); grid = -1; return; }
        int dev = 0, cus = 0, per_cu = 0;
        if (hipGetDevice(&dev) != hipSuccess || hipDeviceGetAttribute(&cus, hipDeviceAttributeMultiprocessorCount, dev) != hipSuccess) { grid = -1; return; }
        if (hipFuncSetAttribute((const void*)fwd, hipFuncAttributeMaxDynamicSharedMemorySize, LDS_BYTES) != hipSuccess) { fprintf(stderr, "kernel_launch: hipFuncSetAttribute failed\n"); grid = -1; return; }
        if (hipOccupancyMaxActiveBlocksPerMultiprocessor(&per_cu, (const void*)fwd, 512, LDS_BYTES) != hipSuccess || per_cu < 1) fprintf(stderr, "kernel_launch: occupancy query reports %d\n", per_cu);
        (void)hipGetLastError();
        grid = cus;
    }
    if (grid < 0) return;
    (void)hipMemsetAsync((char*)d_ws + WS_CTL, 0, CTL_ZERO_BYTES, stream);
    Args a{};
    for (int i = 0; i < 22; ++i) a.in[i] = (const float*)d_in[i];
    a.out = (float*)d_out; a.ws = (unsigned char*)d_ws;
#if MK_ONE_LAUNCH
    a.l_lo = 0; a.l_hi = NLAYER; a.s_lo = 0; a.s_hi = NSLICE; a.ph_lo = 0; a.ph_hi = NPH; a.do_pro = 1; a.do_fin = 1; a.use_bar = 1;
    hipLaunchKernelGGL(fwd, dim3(grid), dim3(512), LDS_BYTES, stream, a);
#else
    a.use_bar = 0;
    a.do_pro = 1; a.do_fin = 0; a.l_lo = a.l_hi = 0; a.s_lo = a.s_hi = 0; a.ph_lo = a.ph_hi = 0;
    hipLaunchKernelGGL(fwd, dim3(grid), dim3(512), LDS_BYTES, stream, a);
    a.do_pro = 0;
    for (int s = 0; s < NSLICE; ++s) for (int l = 0; l < NLAYER; ++l) for (int p = 0; p < NPH; ++p) {
        a.l_lo = l; a.l_hi = l + 1; a.s_lo = s; a.s_hi = s + 1; a.ph_lo = p; a.ph_hi = p + 1;
        hipLaunchKernelGGL(fwd, dim3(grid), dim3(512), LDS_BYTES, stream, a);
    }
    a.do_fin = 1; a.l_lo = a.l_hi = 0; a.s_lo = a.s_hi = 0; a.ph_lo = a.ph_hi = 0;
    hipLaunchKernelGGL(fwd, dim3(grid), dim3(512), LDS_BYTES, stream, a);
#endif
    const hipError_t le = hipPeekAtLastError();
    if (le != hipSuccess) fprintf(stderr, "kernel_launch: launch failed: %s\n", hipGetErrorName(le));
}
```

```cpp
#include <hip/hip_runtime.h>
#include <cstdio>
#include <cstdint>

#ifndef MK_ONE_LAUNCH
#define MK_ONE_LAUNCH 1
#endif

#define GAS __attribute__((address_space(1)))
#define LAS __attribute__((address_space(3)))
typedef unsigned short bf16;
typedef unsigned v4u __attribute__((ext_vector_type(4)));
typedef unsigned v2u __attribute__((ext_vector_type(2)));
typedef float f32x4 __attribute__((ext_vector_type(4)));
typedef float f32x2 __attribute__((ext_vector_type(2)));
typedef short bf16x8 __attribute__((ext_vector_type(8)));
typedef GAS unsigned gu32;

constexpr int DM = 2048, DFF = 5632, PW = 11776, NLAYER = 4;
constexpr int MS = 16384, NSLICE = 3, MTOT = 49152;
constexpr float EPS = 1e-6f;
constexpr float LOG2E = 1.4426950408889634f, LN2 = 0.6931471805599453f;
constexpr float QSCALE = 0.08838834764831845f * LOG2E;
constexpr float CQSCALE = 0.08838834764831845f;
constexpr int O_AQ = 0, O_AK = 1024, O_AV = 1280, O_BQ = 1536, O_BK = 2048, O_BV = 2560, O_CFF = 3072, O_CFB = 3584, O_CI = 4096, O_CQ = 4608, O_CG = 5120, O_GA = 5632, O_GB = 7680, O_GC = 9728;

constexpr size_t MiB = 1u << 20;
constexpr size_t WS_CTL = 0, CTL_ZERO_BYTES = 1 * MiB;
constexpr size_t WS_TAB = 1 * MiB;
constexpr size_t WS_W = 2 * MiB;
constexpr size_t E_WGU = (size_t)2 * DFF * DM, E_WD = (size_t)DM * DFF, E_WIN = (size_t)PW * DM, E_WBR = (size_t)DM * DM, E_WOUT = (size_t)DM * DM;
constexpr size_t EO_WGU1 = 0, EO_WD1 = EO_WGU1 + E_WGU, EO_WIN = EO_WD1 + E_WD, EO_WBR = EO_WIN + E_WIN, EO_WOUT = EO_WBR + E_WBR, EO_WGU2 = EO_WOUT + E_WOUT, EO_WD2 = EO_WGU2 + E_WGU, E_LAYER = EO_WD2 + E_WD;
static_assert(E_LAYER * 2 == 194 * MiB, "weights per layer");
constexpr size_t WS_XN = WS_W + 4 * 194 * MiB;
constexpr size_t WS_PROJ = WS_XN + 64 * MiB;
constexpr size_t WS_Y = WS_PROJ + 368 * MiB;
constexpr size_t WS_OC = WS_Y + 64 * MiB;
constexpr size_t WS_MG = WS_OC + 128 * MiB;
constexpr size_t WS_SSQ = WS_MG + 64 * MiB;
constexpr size_t WS_WQ = WS_SSQ + 2 * MiB;
constexpr size_t WQ_LAYER = 13 * MiB, WQ_SCALE = 12 * MiB;
constexpr size_t WS_END = WS_WQ + 4 * WQ_LAYER;
constexpr size_t XQ_SCALE = 32 * MiB;
constexpr size_t WGUQ_SCALE = 22 * MiB;
static_assert(8 * E_WGU * 2 <= 368 * MiB && (size_t)2 * DFF * DM <= WGUQ_SCALE, "gate|up temporaries / int8 slot");
constexpr int CW_RMAX = 65536;
constexpr int CW_PCNT = 2048;
constexpr int CW_QCNT = 1024;
constexpr int TAB_T5 = 0, TAB_LB = 8 * 260;
constexpr int CW_TMO = 0, CW_CODE = 1, CW_BAR = 4096;

constexpr int RING_OFF = 0, RING_BYTES = 131072;
constexpr int LDSCTL_OFF = RING_BYTES, MISC_OFF = LDSCTL_OFF + 320;
constexpr int LDS_BYTES = 147456;

#define LDS_WAIT() asm volatile("s_waitcnt lgkmcnt(0)" ::: "memory")
#define VM_WAIT() asm volatile("s_waitcnt vmcnt(0)" ::: "memory")
__device__ __forceinline__ unsigned f2bf(float f) { unsigned u = __builtin_bit_cast(unsigned, f); return (u + 0x7fffu + ((u >> 16) & 1u)) >> 16; }
__device__ __forceinline__ unsigned pk2(float lo, float hi) { return f2bf(lo) | (f2bf(hi) << 16); }
__device__ __forceinline__ float bflo(unsigned w) { return __builtin_bit_cast(float, w << 16); }
__device__ __forceinline__ float bfhi(unsigned w) { return __builtin_bit_cast(float, w & 0xffff0000u); }
__device__ __forceinline__ float bf2f(bf16 b) { return __builtin_bit_cast(float, ((unsigned)b) << 16); }
__device__ __forceinline__ void v8(const v4u w, float (&o)[8]) { o[0] = bflo(w.x); o[1] = bfhi(w.x); o[2] = bflo(w.y); o[3] = bfhi(w.y); o[4] = bflo(w.z); o[5] = bfhi(w.z); o[6] = bflo(w.w); o[7] = bfhi(w.w); }
__device__ __forceinline__ float fexp2(float x) { return __builtin_amdgcn_exp2f(x); }
__device__ __forceinline__ float frcp(float x) { return __builtin_amdgcn_rcpf(x); }
__device__ __forceinline__ float sigmoidf_(float x) { return frcp(1.0f + fexp2(-x * LOG2E)); }
__device__ __forceinline__ float wave_sum(float v) {
#pragma unroll
    for (int o = 1; o < 64; o <<= 1) v += __shfl_xor(v, o);
    return v;
}
__device__ __forceinline__ float wave_max(float v) {
#pragma unroll
    for (int o = 1; o < 64; o <<= 1) v = fmaxf(v, __shfl_xor(v, o));
    return v;
}

__device__ __forceinline__ int opq_v(int x) { asm volatile("" : "+v"(x)); return x; }
__device__ __forceinline__ int opq_s(int x) { asm volatile("" : "+s"(x)); return x; }
__device__ __forceinline__ int lane_id() { const unsigned m = (unsigned)opq_s(-1); return (int)__builtin_amdgcn_mbcnt_hi(m, __builtin_amdgcn_mbcnt_lo(m, 0u)); }

namespace pg8 {
#define PG8_LAS __attribute__((address_space(3)))
typedef unsigned short bf16_t;
typedef unsigned u32x4 __attribute__((ext_vector_type(4)));
typedef unsigned u32x2 __attribute__((ext_vector_type(2)));
typedef int i32x4 __attribute__((ext_vector_type(4)));
typedef unsigned short u16x2 __attribute__((ext_vector_type(2)));
constexpr int BM = 256, BK = 64, HALF = 128, HTB = HALF * BK * 2, STAGE_BYTES = 8 * HTB, NXCD = 8, WGM = 4;
__host__ __device__ __forceinline__ int lds_byte(int r, int c) { const int st = (r >> 4) * 2 + (c >> 5), rr = r & 15, cc = c & 31, ob = rr * 64 + cc * 2; return st * 1024 + (ob ^ (((ob >> 9) & 1) << 5)); }
__host__ __device__ __forceinline__ void stage_rc(int b, int& R, int& C) { const int st = b / 1024, sb = b % 1024, swz = sb ^ (((sb >> 9) & 1) << 5); R = (st >> 1) * 16 + swz / 64; C = (st & 1) * 32 + (swz % 64) / 2; }
__host__ __device__ __forceinline__ int perm32(int rho) { const int n = rho >> 4, i = rho & 15; return 8 * (i >> 2) + 4 * n + (i & 3); }
struct Unit { int pm, pn, sub; };
struct Gemm { const bf16_t* A; const bf16_t* Bt; int M, N, K, lda, ldb; };
struct StaticOrder {
    int nM, nN, nwg, G, c;
    __host__ __device__ void init(int M, int N, int G_, int c_) { nM = M / BM; nN = N / BM; nwg = nM * nN; G = G_; c = c_; }
    __host__ __device__ bool next(int i, Unit& u) const { const long L = (long)i * G + c; if (L >= nwg) return false; at(L, u); return true; }
    __host__ __device__ void at(long L, Unit& u) const {
        int wgid = (int)L; { const int q = nwg / NXCD, r = nwg % NXCD, xcd = wgid % NXCD, off = wgid / NXCD; wgid = (xcd < r ? xcd * (q + 1) : r * (q + 1) + (xcd - r) * q) + off; }
        const int nig = WGM * nN, gid = wgid / nig, fm = gid * WGM, gsz = (nM - fm) < WGM ? (nM - fm) : WGM;
        u.pm = fm + ((wgid % nig) % gsz); u.pn = (wgid % nig) / gsz; u.sub = 0;
    }
    __device__ __forceinline__ void a_ready(const Unit&) const {}
    __device__ __forceinline__ void done(const Unit&) const {}
};
struct GateOrder : StaticOrder {
    __host__ __device__ bool next(int i, Unit& u) const {
        if (G != 256 || nwg != 1536) return StaticOrder::next(i, u);
        if (i < 5) { at((long)i * 256 + c, u); return true; }
        if (c < 128 || i > 6) return false;
        at((long)(1280 + 2 * (c - 128) + (i - 5)), u); return true;
    }
};
struct SubOrder : StaticOrder {
    __device__ __forceinline__ bool next(int i, Unit& u) const { const int t3 = i / 3; if (!StaticOrder::next(t3, u)) return false; u.sub = i - 3 * t3; return true; }
};
typedef __bf16 bf16x2_t __attribute__((ext_vector_type(2)));
__device__ __forceinline__ unsigned cvt_pk_bf16(float lo, float hi) { const f32x2 v = {lo, hi}; const bf16x2_t b = __builtin_convertvector(v, bf16x2_t); return __builtin_bit_cast(unsigned, b); }
typedef f32x4 Acc[2][2][4][2];

__device__ __forceinline__ float silu_(float x) { return x * frcp(1.0f + fexp2(-x * LOG2E)); }

__device__ __forceinline__ void row_rstd(const PG8_LAS float* rsl, int ui, int wr, int fr, float (&rs)[2][4]) {
#pragma unroll
    for (int ai = 0; ai < 2; ++ai)
#pragma unroll
        for (int m = 0; m < 4; ++m) rs[ai][m] = rsl[ui * 256 + ai * HALF + wr * 64 + m * 16 + fr];
}
struct EpiSwiGLU {
    static constexpr bool PERM = true, AFTER_DRAIN = false;
    bf16_t* O; int ldc; const PG8_LAS float* rsl;
    __device__ __forceinline__ void operator()(const Acc& acc, const Unit& u, int ui, int wr, int wc, int fr, int fq) const {
        const int row0 = u.pm * BM + wr * 64 + fr, col0 = u.pn * HALF + wc * 32 + 8 * fq;
        float rs[2][4]; row_rstd(rsl, ui, wr, fr, rs);
#pragma unroll
        for (int ai = 0; ai < 2; ++ai)
#pragma unroll
            for (int m = 0; m < 4; ++m) {
                bf16_t* rowp = O + (size_t)(row0 + ai * HALF + m * 16) * ldc + col0; const float r = rs[ai][m];
                const f32x4 g0 = acc[ai][0][m][0] * r, g1 = acc[ai][0][m][1] * r, u0 = acc[ai][1][m][0] * r, u1 = acc[ai][1][m][1] * r;
                u32x4 w;
                w.x = cvt_pk_bf16(silu_(g0[0]) * u0[0], silu_(g0[1]) * u0[1]); w.y = cvt_pk_bf16(silu_(g0[2]) * u0[2], silu_(g0[3]) * u0[3]);
                w.z = cvt_pk_bf16(silu_(g1[0]) * u1[0], silu_(g1[1]) * u1[1]); w.w = cvt_pk_bf16(silu_(g1[2]) * u1[2], silu_(g1[3]) * u1[3]);
                *(GAS u32x4*)rowp = w;
            }
    }
};
struct EpiSwiGLUQ {
    static constexpr bool PERM = true, AFTER_DRAIN = false;
    bf16_t* O; int ldc; const float* wsc; const PG8_LAS float* rsl;
    __device__ __forceinline__ void operator()(const Acc& acc, const Unit& u, int ui, int wr, int wc, int fr, int fq) const {
        const int row0 = u.pm * BM + wr * 64 + fr, col0 = u.pn * HALF + wc * 32 + 8 * fq;
        float rs[2][4]; row_rstd(rsl, ui, wr, fr, rs);
        const float* sp = wsc + u.pn * BM + wc * 32 + 8 * fq;
        const f32x4 cg0 = *(const GAS f32x4*)sp * -LOG2E, cg1 = *(const GAS f32x4*)(sp + 4) * -LOG2E, cu0 = *(const GAS f32x4*)(sp + HALF) * -LN2, cu1 = *(const GAS f32x4*)(sp + HALF + 4) * -LN2;
#pragma unroll
        for (int ai = 0; ai < 2; ++ai)
#pragma unroll
            for (int m = 0; m < 4; ++m) {
                bf16_t* rowp = O + (size_t)(row0 + ai * HALF + m * 16) * ldc + col0; const float r = rs[ai][m];
                const f32x4 g0 = __builtin_convertvector(__builtin_bit_cast(i32x4, acc[ai][0][m][0]), f32x4) * cg0 * r, g1 = __builtin_convertvector(__builtin_bit_cast(i32x4, acc[ai][0][m][1]), f32x4) * cg1 * r;
                const f32x4 u0 = __builtin_convertvector(__builtin_bit_cast(i32x4, acc[ai][1][m][0]), f32x4) * cu0 * r, u1 = __builtin_convertvector(__builtin_bit_cast(i32x4, acc[ai][1][m][1]), f32x4) * cu1 * r;
                float y0[4], y1[4];
#pragma unroll
                for (int i = 0; i < 4; ++i) { y0[i] = g0[i] * frcp(1.0f + fexp2(g0[i])) * u0[i]; y1[i] = g1[i] * frcp(1.0f + fexp2(g1[i])) * u1[i]; }
                u32x4 w;
                w.x = cvt_pk_bf16(y0[0], y0[1]); w.y = cvt_pk_bf16(y0[2], y0[3]); w.z = cvt_pk_bf16(y1[0], y1[1]); w.w = cvt_pk_bf16(y1[2], y1[3]);
                *(GAS u32x4*)rowp = w;
            }
    }
};
struct EpiResid {
    static constexpr bool PERM = true, AFTER_DRAIN = false;
    bf16_t* x; int ldc; float scale; float* ssq;
    unsigned* ctl; unsigned target; unsigned char* xq; float* xsc; PG8_LAS unsigned* scr;
    __device__ __forceinline__ void operator()(const Acc& acc, const Unit& u, int ui, int wr, int wc, int fr, int fq) const {
        const int row0 = u.pm * BM + wr * 64 + fr, col0 = u.pn * BM + wc * 32 + 8 * fq;
        bf16_t* const x = this->x; float* const ssq = this->ssq; const float scale = this->scale; const int ldc = this->ldc;
        u32x4 wk[2][4][2];
        unsigned mxr[2][4];
#pragma unroll
        for (int ai = 0; ai < 2; ++ai) {
            u32x4 xv[4][2];
#pragma unroll
            for (int m = 0; m < 4; ++m)
#pragma unroll
                for (int bj = 0; bj < 2; ++bj) xv[m][bj] = *(const GAS u32x4*)(x + (size_t)(row0 + ai * HALF + m * 16) * ldc + col0 + bj * HALF);
            asm volatile("" ::: "memory");
#pragma unroll
            for (int m = 0; m < 4; ++m) {
                const size_t off = (size_t)(row0 + ai * HALF + m * 16) * ldc + col0; float s = 0.f; u16x2 mx2 = {0, 0};
#pragma unroll
                for (int bj = 0; bj < 2; ++bj) {
                    const u32x4 w0 = xv[m][bj]; const f32x4 a0 = acc[ai][bj][m][0] * scale, a1 = acc[ai][bj][m][1] * scale;
                    const float v0 = bflo(w0.x) + a0[0], v1 = bfhi(w0.x) + a0[1], v2 = bflo(w0.y) + a0[2], v3 = bfhi(w0.y) + a0[3];
                    const float v4 = bflo(w0.z) + a1[0], v5 = bfhi(w0.z) + a1[1], v6 = bflo(w0.w) + a1[2], v7 = bfhi(w0.w) + a1[3];
                    u32x4 w; w.x = cvt_pk_bf16(v0, v1); w.y = cvt_pk_bf16(v2, v3); w.z = cvt_pk_bf16(v4, v5); w.w = cvt_pk_bf16(v6, v7);
                    *(GAS u32x4*)(x + off + bj * HALF) = w; wk[ai][m][bj] = w;
#pragma unroll
                    for (int e2 = 0; e2 < 4; ++e2) mx2 = __builtin_elementwise_max(mx2, __builtin_bit_cast(u16x2, w[e2] & 0x7fff7fffu));
                    s += ((v0 * v0 + v1 * v1) + (v2 * v2 + v3 * v3)) + ((v4 * v4 + v5 * v5) + (v6 * v6 + v7 * v7));
                }
                s += __shfl_xor(s, 16); s += __shfl_xor(s, 32);
                if (fq == 0) ssq[(size_t)(row0 + ai * HALF + m * 16) * 32 + u.pn * 4 + wc] = s;
                unsigned mh = mx2.x > mx2.y ? (unsigned)mx2.x : (unsigned)mx2.y;
                { const unsigned o = (unsigned)__shfl_xor((int)mh, 16); mh = o > mh ? o : mh; } { const unsigned o = (unsigned)__shfl_xor((int)mh, 32); mh = o > mh ? o : mh; }
                mxr[ai][m] = mh;
            }
            asm volatile("" ::: "memory");
        }
        {
            const int wave = wr * 4 + wc, lane = fq * 16 + fr, tid = wave * 64 + lane;
            PG8_LAS unsigned* const PM = this->scr; PG8_LAS float* const SC = (PG8_LAS float*)(this->scr + 1024);
            const unsigned tg = this->target; unsigned* const cur = this->ctl + CW_RMAX + ((tg >> 3) & 1u) * 16384 + u.pm * BM; unsigned* const nxt = this->ctl + CW_RMAX + (((tg >> 3) & 1u) ^ 1u) * 16384 + u.pm * BM;
            if (fq == 0) {
#pragma unroll
                for (int ai = 0; ai < 2; ++ai)
#pragma unroll
                    for (int m = 0; m < 4; ++m) PM[wc * 256 + ai * HALF + wr * 64 + m * 16 + fr] = mxr[ai][m];
            }
            __syncthreads();
            if (tid < 256) { const unsigned a = PM[tid], b = PM[256 + tid], c = PM[512 + tid], d = PM[768 + tid]; const unsigned ab = a > b ? a : b, cd = c > d ? c : d;
                (void)__hip_atomic_fetch_max(cur + tid, (ab > cd ? ab : cd) << 16, __ATOMIC_RELAXED, __HIP_MEMORY_SCOPE_AGENT); }
            asm volatile("s_waitcnt vmcnt(0)" ::: "memory"); __builtin_amdgcn_s_barrier();
            if (tid == 0) { unsigned* const pc = this->ctl + CW_PCNT + u.pm;
                (void)__hip_atomic_fetch_add(pc, 1u, __ATOMIC_RELAXED, __HIP_MEMORY_SCOPE_AGENT);
                unsigned sp = 0u; while (__hip_atomic_load(pc, __ATOMIC_RELAXED, __HIP_MEMORY_SCOPE_AGENT) < tg && ++sp < (1u << 22)) __builtin_amdgcn_s_sleep(1); }
            __builtin_amdgcn_s_barrier();
            if (tid < 256) { const unsigned mb = __hip_atomic_load(cur + tid, __ATOMIC_RELAXED, __HIP_MEMORY_SCOPE_AGENT);
                const float sc = mb ? __builtin_bit_cast(float, mb) * (1.0f / 127.0f) : 1.0f; SC[tid] = sc;
                if (u.pn == 0) this->xsc[u.pm * BM + tid] = sc;
                __hip_atomic_store(nxt + tid, 0u, __ATOMIC_RELAXED, __HIP_MEMORY_SCOPE_AGENT); }
            __syncthreads();
            unsigned char* const xq = this->xq;
#pragma unroll
            for (int ai = 0; ai < 2; ++ai)
#pragma unroll
                for (int m = 0; m < 4; ++m) {
                    const int rl = ai * HALF + wr * 64 + m * 16 + fr; const float inv = 1.0f / SC[rl];
                    unsigned char* const rp = xq + (size_t)(u.pm * BM + rl) * 2048 + col0;
#pragma unroll
                    for (int bj = 0; bj < 2; ++bj) {
                        const u32x4 w = wk[ai][m][bj]; u32x2 q;
#pragma unroll
                        for (int h = 0; h < 2; ++h) {
                            const unsigned a = w[2 * h], b = w[2 * h + 1];
                            const int q0 = (int)rintf(bflo(a) * inv), q1 = (int)rintf(bfhi(a) * inv), q2 = (int)rintf(bflo(b) * inv), q3 = (int)rintf(bfhi(b) * inv);
                            q[h] = (unsigned)(q0 & 255) | ((unsigned)(q1 & 255) << 8) | ((unsigned)(q2 & 255) << 16) | ((unsigned)(q3 & 255) << 24);
                        }
                        *(GAS u32x2*)(rp + bj * HALF) = q;
                    }
                }
        }
    }
};
struct EpiProj {
    static constexpr bool PERM = true, AFTER_DRAIN = false;
    bf16_t* O; int ldc; const float* lb0; const float* lb1; const PG8_LAS float* rsl;
    template <int MODE> __device__ __forceinline__ void tile(const Acc& acc, const Unit& u, int ui, int wr, int wc, int fr, int fq, float scale, const float* lb) const {
        const int row0 = u.pm * BM + wr * 64 + fr, col0 = u.pn * BM + wc * 32 + 8 * fq;
        float rs[2][4]; row_rstd(rsl, ui, wr, fr, rs);
        f32x4 l[2][2];
        if (MODE == 1) {
#pragma unroll
            for (int bj = 0; bj < 2; ++bj)
#pragma unroll
                for (int n = 0; n < 2; ++n) l[bj][n] = *(const GAS f32x4*)(lb + bj * HALF + wc * 32 + 8 * fq + 4 * n);
        }
#pragma unroll
        for (int ai = 0; ai < 2; ++ai)
#pragma unroll
            for (int m = 0; m < 4; ++m) {
                bf16_t* rowp = O + (size_t)(row0 + ai * HALF + m * 16) * ldc + col0;
#pragma unroll
                for (int bj = 0; bj < 2; ++bj) {
                    f32x4 v[2] = {acc[ai][bj][m][0] * rs[ai][m], acc[ai][bj][m][1] * rs[ai][m]};
#pragma unroll
                    for (int n = 0; n < 2; ++n)
#pragma unroll
                        for (int i = 0; i < 4; ++i) {
                            float x = v[n][i];
                            if (MODE == 0) x *= scale;
                            if (MODE == 1) { const float lbv = l[bj][n][i]; x = __builtin_amdgcn_logf(lbv + (1.0f - lbv) * sigmoidf_(x)); }
                            if (MODE == 2) x = silu_(x);
                            if (MODE == 3) x = sigmoidf_(x);
                            v[n][i] = x;
                        }
                    if (MODE == 3) {
                        unsigned q[2][4];
#pragma unroll
                        for (int n = 0; n < 2; ++n)
#pragma unroll
                            for (int i = 0; i < 4; ++i) { const unsigned t = (unsigned)(v[n][i] * 256.0f); q[n][i] = t < 255u ? t : 255u; }
                        u32x2 w; w.x = q[0][0] | (q[0][1] << 8) | (q[0][2] << 16) | (q[0][3] << 24); w.y = q[1][0] | (q[1][1] << 8) | (q[1][2] << 16) | (q[1][3] << 24);
                        *(GAS u32x2*)((unsigned char*)(rowp - col0 + O_GA) + (col0 - O_GA) + bj * HALF) = w;
                    } else {
                        u32x4 w; w.x = cvt_pk_bf16(v[0][0], v[0][1]); w.y = cvt_pk_bf16(v[0][2], v[0][3]); w.z = cvt_pk_bf16(v[1][0], v[1][1]); w.w = cvt_pk_bf16(v[1][2], v[1][3]);
                        *(GAS u32x4*)(rowp + bj * HALF) = w;
                    }
                }
            }
    }
    __device__ __forceinline__ void operator()(const Acc& acc, const Unit& u, int ui, int wr, int wc, int fr, int fq) const {
        const int pn = u.pn;
        if (pn >= 22) tile<3>(acc, u, ui, wr, wc, fr, fq, 1.f, nullptr);
        else if (pn >= 20) tile<2>(acc, u, ui, wr, wc, fr, fq, 1.f, nullptr);
        else if (pn >= 12 && pn < 16) tile<1>(acc, u, ui, wr, wc, fr, fq, 1.f, (pn < 14 ? lb0 : lb1) + (pn & 1) * BM);
        else { const float s = (pn < 4 || pn == 6 || pn == 7) ? QSCALE : ((pn == 18 || pn == 19) ? CQSCALE : 1.0f); tile<0>(acc, u, ui, wr, wc, fr, fq, s, nullptr); }
    }
};
struct EpiGateQ {
    static constexpr bool PERM = true, AFTER_DRAIN = false;
    unsigned char* G8; int ldg; const float* wsc; const PG8_LAS float* rsl;
    __device__ __forceinline__ void operator()(const Acc& acc, const Unit& u, int ui, int wr, int wc, int fr, int fq) const {
        const int row0 = u.pm * BM + wr * 64 + fr, col0 = u.pn * BM + wc * 32 + 8 * fq;
        float rs[2][4]; row_rstd(rsl, ui, wr, fr, rs);
        f32x4 cs[2][2];
#pragma unroll
        for (int bj = 0; bj < 2; ++bj)
#pragma unroll
            for (int n = 0; n < 2; ++n) cs[bj][n] = *(const GAS f32x4*)(wsc + col0 + bj * HALF + 4 * n) * -LOG2E;
#pragma unroll
        for (int ai = 0; ai < 2; ++ai)
#pragma unroll
            for (int m = 0; m < 4; ++m) {
                unsigned char* rowp = G8 + (size_t)(row0 + ai * HALF + m * 16) * ldg + col0;
#pragma unroll
                for (int bj = 0; bj < 2; ++bj) {
                    unsigned q[2][4];
#pragma unroll
                    for (int n = 0; n < 2; ++n) {
                        const i32x4 iv = __builtin_bit_cast(i32x4, acc[ai][bj][m][n]);
#pragma unroll
                        for (int i = 0; i < 4; ++i) {
                            const float z = (float)iv[i] * rs[ai][m] * cs[bj][n][i];
                            const unsigned t = (unsigned)frcp(__builtin_fmaf(fexp2(z), 1.0f / 256.0f, 1.0f / 256.0f)); q[n][i] = t < 255u ? t : 255u;
                        }
                    }
                    u32x2 w; w.x = q[0][0] | (q[0][1] << 8) | (q[0][2] << 16) | (q[0][3] << 24); w.y = q[1][0] | (q[1][1] << 8) | (q[1][2] << 16) | (q[1][3] << 24);
                    *(GAS u32x2*)(rowp + bj * HALF) = w;
                }
            }
    }
};
template <int MODE> struct EpiGate {
    static constexpr bool PERM = true, AFTER_DRAIN = false;
    const bf16_t* Gt; int ldg; bf16_t* O; int ldc;
    __device__ __forceinline__ void operator()(const Acc& acc, const Unit& u, int ui, int wr, int wc, int fr, int fq) const {
        const int row0 = u.pm * BM + wr * 64 + fr, col0 = u.pn * BM + wc * 32 + 8 * fq;
#pragma unroll
        for (int ai = 0; ai < 2; ++ai)
#pragma unroll
            for (int m = 0; m < 4; ++m) {
                const size_t r = (size_t)(row0 + ai * HALF + m * 16);
#pragma unroll
                for (int bj = 0; bj < 2; ++bj) {
                    const u32x4 c = *(const GAS u32x4*)(Gt + r * ldg + col0 + bj * HALF);
                    f32x4 v0 = acc[ai][bj][m][0], v1 = acc[ai][bj][m][1];
                    v0[0] *= bflo(c.x); v0[1] *= bfhi(c.x); v0[2] *= bflo(c.y); v0[3] *= bfhi(c.y); v1[0] *= bflo(c.z); v1[1] *= bfhi(c.z); v1[2] *= bflo(c.w); v1[3] *= bfhi(c.w);
                    if (MODE) { const u32x4 o = *(const GAS u32x4*)(O + r * ldc + col0 + bj * HALF);
                        v0[0] += bflo(o.x); v0[1] += bfhi(o.x); v0[2] += bflo(o.y); v0[3] += bfhi(o.y); v1[0] += bflo(o.z); v1[1] += bfhi(o.z); v1[2] += bflo(o.w); v1[3] += bfhi(o.w); }
                    u32x4 w; w.x = cvt_pk_bf16(v0[0], v0[1]); w.y = cvt_pk_bf16(v0[2], v0[3]); w.z = cvt_pk_bf16(v1[0], v1[1]); w.w = cvt_pk_bf16(v1[2], v1[3]);
                    *(GAS u32x4*)(O + r * ldc + col0 + bj * HALF) = w;
                }
                if (m & 1) asm volatile("" ::: "memory");
            }
    }
};

struct EpiMerged {
    static constexpr bool PERM = true, AFTER_DRAIN = false;
    const bf16_t* P; int ldp; bf16_t* O; int ldc;
    __device__ __forceinline__ void operator()(Acc& acc, const Unit& u, int ui, int wr, int wc, int fr, int fq) const {
        const int row0 = u.pm * BM + wr * 64 + fr, col0 = u.pn * BM + wc * 32 + 8 * fq;
        const GAS unsigned char* g8 = (const GAS unsigned char*)((const GAS bf16_t*)P + (size_t)row0 * ldp + O_GA) + (col0 - 0);
        const size_t rstep = (size_t)ldp * 2;
        const int seg0 = u.sub + (int)(blockIdx.x & 1u), seg = seg0 >= 3 ? seg0 - 3 : seg0, dseg = seg == 2 ? 0 : seg + 1;
        if (u.sub < 2) {
            const GAS unsigned char* rp = g8 + seg * 2048; const int dofs = (dseg - seg) * 2048;
#pragma unroll
            for (int ai = 0; ai < 2; ++ai) {
                u32x2 ga[4][2], gb[4][2];
#pragma unroll
                for (int m = 0; m < 4; ++m) {
                    const GAS unsigned char* rowp = rp + (size_t)(ai * HALF + m * 16) * rstep;
#pragma unroll
                    for (int bj = 0; bj < 2; ++bj) { ga[m][bj] = *(const GAS u32x2*)(rowp + bj * HALF); gb[m][bj] = *(const GAS u32x2*)(rowp + dofs + bj * HALF); }
                }
                asm volatile("" ::: "memory");
#pragma unroll
                for (int m = 0; m < 4; ++m)
#pragma unroll
                    for (int bj = 0; bj < 2; ++bj) {
                        const u32x2 a = ga[m][bj], b = gb[m][bj];
                        f32x4 r0, r1;
#pragma unroll
                        for (int i = 0; i < 4; ++i) {
                            r0[i] = ((float)((a.x >> (8 * i)) & 255u) + 0.5f) * frcp((float)((b.x >> (8 * i)) & 255u) + 0.5f);
                            r1[i] = ((float)((a.y >> (8 * i)) & 255u) + 0.5f) * frcp((float)((b.y >> (8 * i)) & 255u) + 0.5f);
                        }
                        acc[ai][bj][m][0] *= r0; acc[ai][bj][m][1] *= r1;
                    }
                asm volatile("" ::: "memory");
            }
        } else {
#pragma unroll
            for (int ai = 0; ai < 2; ++ai)
#pragma unroll
                for (int m = 0; m < 4; ++m) {
                    const size_t r = (size_t)(row0 + ai * HALF + m * 16);
#pragma unroll
                    for (int bj = 0; bj < 2; ++bj) {
                        const u32x2 c = *(const GAS u32x2*)(g8 + (size_t)(ai * HALF + m * 16) * rstep + seg * 2048 + bj * HALF);
                        const f32x4 v0 = acc[ai][bj][m][0], v1 = acc[ai][bj][m][1];
                        float s0[4], s1[4];
#pragma unroll
                        for (int i = 0; i < 4; ++i) { s0[i] = ((float)((c.x >> (8 * i)) & 255u) + 0.5f) * (1.0f / 256.0f); s1[i] = ((float)((c.y >> (8 * i)) & 255u) + 0.5f) * (1.0f / 256.0f); }
                        u32x4 w; w.x = cvt_pk_bf16(v0[0] * s0[0], v0[1] * s0[1]); w.y = cvt_pk_bf16(v0[2] * s0[2], v0[3] * s0[3]);
                        w.z = cvt_pk_bf16(v1[0] * s1[0], v1[1] * s1[1]); w.w = cvt_pk_bf16(v1[2] * s1[2], v1[3] * s1[3]);
                        *(GAS u32x4*)(O + r * ldc + col0 + bj * HALF) = w;
                    }
                    if (m & 1) asm volatile("" ::: "memory");
                }
        }
    }
};

template <class Epi, class Sched, bool ALIGN_EPI = false, bool SP2 = false, bool SUBK = false, bool I8 = false>
__device__ __forceinline__ void gemm_phase(PG8_LAS unsigned char* lds, const Gemm g, const Sched S, const Epi E, int wave) {
    const int wid = wave, lane = lane_id(), tid = wid * 64 + lane, wr = wid >> 2, wc = wid & 3, fr = lane & 15, fq = lane >> 4;
    const int K = g.K, nt = K / BK;
    const int krot = SUBK ? (int)(blockIdx.x & 1u) : 0;
#define PG8_SEG(u) (((u).sub + krot) >= 3 ? ((u).sub + krot - 3) : ((u).sub + krot))
#define PG8_KOFF(u) (SUBK ? (PG8_SEG(u) == 0 ? 0 : (PG8_SEG(u) == 1 ? 2048 : 3072)) : 0)
#define PG8_NT(u) (SUBK ? (PG8_SEG(u) == 0 ? 16 : 8) : nt)
    unsigned voffA[2], voffB[2];
#pragma unroll
    for (int i = 0; i < 2; ++i) { int R, C; stage_rc(tid * 16 + i * 8192, R, C); const int Rb = Epi::PERM ? ((R & ~31) + perm32(R & 31)) : R;
        voffA[i] = (unsigned)(R * g.lda + C) * 2u; voffB[i] = (unsigned)(Rb * g.ldb + C) * 2u; }
    const size_t kstep = (size_t)(BK * 2);
    const size_t hstepA = (size_t)HALF * g.lda * 2, hstepB = (size_t)HALF * g.ldb * 2;
    const size_t tstepA = 2 * hstepA, tstepB = 2 * hstepB;
    const unsigned ldsw = (unsigned)wid * 1024u;
    const int aoff = lds_byte(wr * 64 + fr, fq * 8), boff = lds_byte(wc * 32 + fr, fq * 8);
#define PG8_SA(b, h) (((b) * 2 + (h)) * HTB)
#define PG8_SB(b, h) ((4 + (b) * 2 + (h)) * HTB)
#define PG8_STAGE(bufoff, gbase, voff) do { _Pragma("unroll") for (int _i = 0; _i < 2; ++_i) \
        __builtin_amdgcn_global_load_lds((const unsigned*)((const char*)(gbase) + (voff)[_i]), (PG8_LAS unsigned*)(lds + (bufoff) + ldsw + _i * 8192), 16, 0, 0); } while (0)
#define PG8_LDA(dst, b, h) do { _Pragma("unroll") for (int m = 0; m < 4; ++m) _Pragma("unroll") for (int k = 0; k < 2; ++k) dst[m][k] = *(const PG8_LAS bf16x8*)(lds + PG8_SA(b, h) + aoff + m * 2048 + k * 1024); } while (0)
#define PG8_LDB(dst, b, h) do { _Pragma("unroll") for (int n = 0; n < 2; ++n) _Pragma("unroll") for (int k = 0; k < 2; ++k) dst[n][k] = *(const PG8_LAS bf16x8*)(lds + PG8_SB(b, h) + boff + n * 2048 + k * 1024); } while (0)
#define PG8_MMA(ai, bj, At, Bt) do { __builtin_amdgcn_s_setprio(1); _Pragma("unroll") for (int m = 0; m < 4; ++m) _Pragma("unroll") for (int n = 0; n < 2; ++n) _Pragma("unroll") for (int k = 0; k < 2; ++k) \
        { if constexpr (I8) acc[ai][bj][m][n] = __builtin_bit_cast(f32x4, __builtin_amdgcn_mfma_i32_16x16x64_i8(__builtin_bit_cast(i32x4, Bt[n][k]), __builtin_bit_cast(i32x4, At[m][k]), __builtin_bit_cast(i32x4, acc[ai][bj][m][n]), 0, 0, 0)); \
          else acc[ai][bj][m][n] = __builtin_amdgcn_mfma_f32_16x16x32_bf16(Bt[n][k], At[m][k], acc[ai][bj][m][n], 0, 0, 0); } __builtin_amdgcn_s_setprio(0); } while (0)
#define PG8_WAIT_V(n) asm volatile("s_waitcnt vmcnt(" #n ")" ::: "memory")
#define PG8_WAIT_L(n) asm volatile("s_waitcnt lgkmcnt(" #n ")" ::: "memory")
#define PG8_BAR __builtin_amdgcn_s_barrier()
#define PG8_SCHED __builtin_amdgcn_sched_barrier(0)
    Unit cur, nxt; int ui = 0;
    if (!S.next(0, cur)) return;
    f32x4 acc[2][2][4][2];
#pragma unroll
    for (int a = 0; a < 2; ++a)
#pragma unroll
        for (int b = 0; b < 2; ++b)
#pragma unroll
            for (int m = 0; m < 4; ++m)
#pragma unroll
                for (int n = 0; n < 2; ++n) acc[a][b][m][n] = (f32x4){0.f, 0.f, 0.f, 0.f};
    bf16x8 At[4][2], B0[2][2], B1[2][2];
    const char* cA = (const char*)g.A + (size_t)cur.pm * tstepA + PG8_KOFF(cur); const char* cB = (const char*)g.Bt + (size_t)cur.pn * tstepB + PG8_KOFF(cur);
    S.a_ready(cur);
    if constexpr (SP2) {
        PG8_STAGE(PG8_SB(0, 0), cB, voffB); PG8_STAGE(PG8_SB(0, 1), cB + hstepB, voffB); PG8_STAGE(PG8_SA(0, 0), cA, voffA); PG8_STAGE(PG8_SA(0, 1), cA + hstepA, voffA);
        if (wr == 1) PG8_BAR;
        PG8_WAIT_V(2); PG8_BAR;
        PG8_STAGE(PG8_SB(1, 0), cB + kstep, voffB); PG8_STAGE(PG8_SA(1, 0), cA + kstep, voffA); PG8_STAGE(PG8_SB(1, 1), cB + hstepB + kstep, voffB);
        PG8_WAIT_V(6); PG8_BAR;
    } else {
        PG8_STAGE(PG8_SB(0, 0), cB, voffB); PG8_STAGE(PG8_SA(0, 0), cA, voffA); PG8_STAGE(PG8_SB(0, 1), cB + hstepB, voffB); PG8_STAGE(PG8_SA(0, 1), cA + hstepA, voffA);
        if (wr == 1) PG8_BAR;
        PG8_WAIT_V(4); PG8_BAR;
        PG8_STAGE(PG8_SB(1, 0), cB + kstep, voffB); PG8_STAGE(PG8_SA(1, 0), cA + kstep, voffA); PG8_STAGE(PG8_SB(1, 1), cB + hstepB + kstep, voffB);
        PG8_WAIT_V(6); PG8_BAR;
    }
    for (;;) {
        const bool has_next = S.next(ui + 1, nxt);
        const char* nA = has_next ? (const char*)g.A + (size_t)nxt.pm * tstepA + PG8_KOFF(nxt) : cA; const char* nB = has_next ? (const char*)g.Bt + (size_t)nxt.pn * tstepB + PG8_KOFF(nxt) : cB;
        const int ntc = PG8_NT(cur);
        for (int t = 0; t < ntc; t += 2) {
            const bool last = (t == ntc - 2);
            const char* a1 = cA + (size_t)(t + 1) * kstep;
            const char* a2 = last ? nA : cA + (size_t)(t + 2) * kstep; const char* b2 = last ? nB : cB + (size_t)(t + 2) * kstep;
            const char* a3 = a2 + kstep; const char* b3 = b2 + kstep;
            if (last && has_next) S.a_ready(nxt);
            if constexpr (SP2) {
            PG8_LDB(B0, 0, 0); PG8_LDB(B1, 0, 1); PG8_SCHED; PG8_LDA(At, 0, 0); PG8_STAGE(PG8_SA(1, 1), a1 + hstepA, voffA);
            PG8_WAIT_V(8); PG8_WAIT_L(0); PG8_BAR; PG8_MMA(0, 0, At, B0); PG8_MMA(0, 1, At, B1); PG8_BAR; PG8_SCHED;
            PG8_LDA(At, 0, 1); PG8_STAGE(PG8_SB(0, 0), b2, voffB); PG8_STAGE(PG8_SB(0, 1), b2 + hstepB, voffB); PG8_STAGE(PG8_SA(0, 0), a2, voffA);
            PG8_WAIT_V(8); PG8_WAIT_L(0); PG8_BAR; PG8_MMA(1, 0, At, B0); PG8_MMA(1, 1, At, B1); PG8_BAR; PG8_SCHED;
            PG8_LDB(B0, 1, 0); PG8_LDB(B1, 1, 1); PG8_SCHED; PG8_LDA(At, 1, 0); PG8_STAGE(PG8_SA(0, 1), a2 + hstepA, voffA);
            PG8_WAIT_V(8); PG8_WAIT_L(0); PG8_BAR; PG8_MMA(0, 0, At, B0); PG8_MMA(0, 1, At, B1); PG8_BAR; PG8_SCHED;
            PG8_LDA(At, 1, 1); PG8_STAGE(PG8_SB(1, 0), b3, voffB); PG8_STAGE(PG8_SB(1, 1), b3 + hstepB, voffB); PG8_STAGE(PG8_SA(1, 0), a3, voffA);
            PG8_WAIT_V(8); PG8_WAIT_L(0); PG8_BAR; PG8_MMA(1, 0, At, B0); PG8_MMA(1, 1, At, B1); PG8_BAR; PG8_SCHED;
            } else {
            PG8_LDB(B0, 0, 0); PG8_SCHED; PG8_LDA(At, 0, 0); PG8_STAGE(PG8_SA(1, 1), a1 + hstepA, voffA);
            PG8_WAIT_L(8); PG8_BAR; PG8_WAIT_L(0); PG8_MMA(0, 0, At, B0); PG8_BAR; PG8_SCHED;
            PG8_LDB(B1, 0, 1); PG8_STAGE(PG8_SB(0, 0), b2, voffB);
            PG8_BAR; PG8_WAIT_L(0); PG8_MMA(0, 1, At, B1); PG8_BAR;
            PG8_LDA(At, 0, 1); PG8_STAGE(PG8_SA(0, 0), a2, voffA);
            PG8_BAR; PG8_WAIT_L(0); PG8_MMA(1, 0, At, B0); PG8_BAR; PG8_SCHED;
            PG8_STAGE(PG8_SB(0, 1), b2 + hstepB, voffB);
            PG8_WAIT_V(6); PG8_BAR; PG8_MMA(1, 1, At, B1); PG8_BAR;
            PG8_LDB(B0, 1, 0); PG8_SCHED; PG8_LDA(At, 1, 0); PG8_STAGE(PG8_SA(0, 1), a2 + hstepA, voffA);
            PG8_WAIT_L(8); PG8_BAR; PG8_WAIT_L(0); PG8_MMA(0, 0, At, B0); PG8_BAR; PG8_SCHED;
            PG8_LDB(B1, 1, 1); PG8_STAGE(PG8_SB(1, 0), b3, voffB);
            PG8_BAR; PG8_WAIT_L(0); PG8_MMA(0, 1, At, B1); PG8_BAR;
            PG8_LDA(At, 1, 1); PG8_STAGE(PG8_SA(1, 0), a3, voffA);
            PG8_BAR; PG8_WAIT_L(0); PG8_MMA(1, 0, At, B0); PG8_BAR; PG8_SCHED;
            PG8_STAGE(PG8_SB(1, 1), b3 + hstepB, voffB);
            PG8_WAIT_V(6); PG8_BAR; PG8_MMA(1, 1, At, B1); PG8_BAR;
            }
        }
        if constexpr (ALIGN_EPI) { if (wr == 0) PG8_BAR; }
        E(acc, cur, ui, wr, wc, fr, fq); S.done(cur);
        if (!has_next) break;
        if (!SUBK || nxt.sub == 0) {
#pragma unroll
        for (int a = 0; a < 2; ++a)
#pragma unroll
            for (int b = 0; b < 2; ++b)
#pragma unroll
                for (int m = 0; m < 4; ++m)
#pragma unroll
                    for (int n = 0; n < 2; ++n) acc[a][b][m][n] = (f32x4){0.f, 0.f, 0.f, 0.f};
        }
        cur = nxt; cA = nA; cB = nB; ++ui;
        if constexpr (ALIGN_EPI) { if (wr == 1) PG8_BAR; }
    }
    PG8_WAIT_V(0);
    if constexpr (!ALIGN_EPI) { if (wr == 0) PG8_BAR; }
    PG8_BAR;
#undef PG8_KOFF
#undef PG8_NT
#undef PG8_SA
#undef PG8_SB
#undef PG8_STAGE
#undef PG8_LDA
#undef PG8_LDB
#undef PG8_MMA
#undef PG8_WAIT_V
#undef PG8_WAIT_L
#undef PG8_BAR
#undef PG8_SCHED
}
}

#define XB_TMO      128
#define XB_XCNT(j)  (256  + 64 * (j))
#define XB_XSUB(j)  (1280 + 64 * (j))
#define XB_XGEN(j)  (2304 + 64 * (j))
#define XB_TOP      3328
#define XB_TOPGEN   3392
#define XCD_BAR_WORDS 3456
#define XB_SPIN_CAP (1u << 24)
__device__ __forceinline__ unsigned xb_ld(unsigned* p)              { return __hip_atomic_load(p, __ATOMIC_RELAXED, __HIP_MEMORY_SCOPE_AGENT); }
__device__ __forceinline__ unsigned xb_add(unsigned* p, unsigned v) { return __hip_atomic_fetch_add(p, v, __ATOMIC_RELAXED, __HIP_MEMORY_SCOPE_AGENT); }
__device__ __forceinline__ unsigned xb_xcc_id() { return (unsigned)__builtin_amdgcn_s_getreg((3 << 11) | 20) & 0xFu; }
#define XB_SPIN(cond, bar) do { unsigned _sp = 0; while (cond) { __builtin_amdgcn_s_sleep(1); \
    if ((++_sp & 255u) == 0u) { if (xb_ld(&(bar)[XB_TMO])) break; if (_sp > XB_SPIN_CAP) { atomicAdd(&(bar)[XB_TMO], 1u); break; } } } } while (0)
struct XcdBarrier { unsigned* bar; unsigned x; volatile LAS unsigned* st; };
__device__ __forceinline__ XcdBarrier xcd_barrier_post(unsigned* bar, volatile LAS unsigned* st, bool t0) {
    XcdBarrier b; b.bar = bar; b.x = xb_xcc_id(); b.st = st;
    if (t0) (void)xb_add(&bar[XB_XCNT(b.x)], 1u);
    return b;
}
__device__ __forceinline__ void xcd_barrier_complete(unsigned* bar, unsigned x, unsigned& nloc, unsigned& nx) {
    const unsigned G = gridDim.x * gridDim.y * gridDim.z;
    unsigned sum, cnt, mine, sp = 0u;
    for (;;) {
        sum = 0u; cnt = 0u; mine = 0u;
#pragma unroll
        for (unsigned j = 0; j < 16; ++j) { const unsigned c = xb_ld(&bar[XB_XCNT(j)]); sum += c; cnt += (c > 0u) ? 1u : 0u; mine = (j == x) ? c : mine; }
        if (sum == G) break;
        __builtin_amdgcn_s_sleep(1);
        if ((++sp & 255u) == 0u) { if (xb_ld(&bar[XB_TMO])) break; if (sp > XB_SPIN_CAP) { atomicAdd(&bar[XB_TMO], 1u); break; } }
    }
    nloc = mine > 0u ? mine : 1u; nx = cnt > 0u ? cnt : 1u;
}
__device__ __forceinline__ void xcd_barrier(const XcdBarrier& b, bool t0) {
    asm volatile("s_waitcnt vmcnt(0)" ::: "memory");
    __syncthreads();
    if (t0) {
        unsigned* bar = b.bar;
        __builtin_amdgcn_s_waitcnt(0);
        unsigned nloc = b.st[0], nx = b.st[1];
        if (nloc == 0u) { xcd_barrier_complete(bar, b.x, nloc, nx); b.st[0] = nloc; b.st[1] = nx; }
        const unsigned old = xb_add(&bar[XB_XSUB(b.x)], 1u);
        const unsigned gen = old / nloc;
        if (old + 1u == (gen + 1u) * nloc) {
            __builtin_amdgcn_fence(__ATOMIC_RELEASE, "agent");
            asm volatile("s_waitcnt vmcnt(0)" ::: "memory");
            const unsigned og = xb_add(&bar[XB_TOP], 1u);
            const unsigned tg = og / nx;
            if (og + 1u == (tg + 1u) * nx) xb_add(&bar[XB_TOPGEN], 1u);
            else XB_SPIN(xb_ld(&bar[XB_TOPGEN]) == tg, bar);
            __builtin_amdgcn_fence(__ATOMIC_ACQUIRE, "agent");
            xb_add(&bar[XB_XGEN(b.x)], 1u);
            asm volatile("s_waitcnt vmcnt(0)" ::: "memory");
        } else {
            XB_SPIN(xb_ld(&bar[XB_XGEN(b.x)]) == gen, bar);
            __builtin_amdgcn_fence(__ATOMIC_ACQUIRE, "agent");
            asm volatile("s_waitcnt vmcnt(0)" ::: "memory");
        }
    }
    __syncthreads();
}

struct Args {
    const float* in[22]; float* out; unsigned char* ws;
    int l_lo, l_hi, s_lo, s_hi, ph_lo, ph_hi, do_pro, do_fin, use_bar, pad;
};
struct Frame {
    LAS unsigned char* lds;
    int wave, G, gw, NGW;
};
enum { I_XP = 0, I_XS, I_F1N, I_F1G, I_F1U, I_F1D, I_MN, I_WIN, I_SINK, I_T5, I_NAB, I_LBL, I_HN, I_WA, I_WB, I_WC, I_WO, I_F2N, I_F2G, I_F2U, I_F2D, I_FN };

__device__ __forceinline__ void tr_item(const float* W, int K, int N, bf16* WT, int ld, int koff, int rowmode, LAS float* scr, int item, int lane, const float* gain) {
    const int nblk = N / 32, kb = item / nblk, nb = item % nblk, k0 = 64 * kb, n0 = 32 * nb;
#pragma unroll 8
    for (int i = 0; i < 32; ++i) { const int kk = 2 * i + (lane >> 5); scr[kk * 33 + (lane & 31)] = W[(size_t)(k0 + kk) * N + n0 + (lane & 31)]; }
    LDS_WAIT(); asm volatile("" ::: "memory");
    const int c = lane & 7;
    f32x4 g0 = (f32x4){1.f, 1.f, 1.f, 1.f}, g1 = g0;
    if (gain) { g0 = *(const GAS f32x4*)(gain + k0 + 8 * c); g1 = *(const GAS f32x4*)(gain + k0 + 8 * c + 4); }
#pragma unroll
    for (int j = 0; j < 4; ++j) { const int n = (lane >> 3) + 8 * j; const LAS float* s = scr + (8 * c) * 33 + n;
        v4u o; o.x = pk2(s[0 * 33] * g0[0], s[1 * 33] * g0[1]); o.y = pk2(s[2 * 33] * g0[2], s[3 * 33] * g0[3]); o.z = pk2(s[4 * 33] * g1[0], s[5 * 33] * g1[1]); o.w = pk2(s[6 * 33] * g1[2], s[7 * 33] * g1[3]);
        const int nn = n0 + n; const int drow = rowmode == 0 ? nn : ((nn >> 7) * 256 + (nn & 127) + (rowmode == 2 ? 128 : 0));
        *(GAS v4u*)(WT + (size_t)drow * ld + koff + k0 + 8 * c) = o; }
    LDS_WAIT(); asm volatile("" ::: "memory");
}
__device__ __forceinline__ void tr_matrix(Frame& F, const float* W, int K, int N, bf16* WT, int ld, int koff, int rowmode, const float* gain = nullptr) {
    LAS float* scr = (LAS float*)(F.lds + RING_OFF + F.wave * 16384);
    const int nitems = (K / 64) * (N / 32);
    const int lane = lane_id();
    for (int it = F.gw; it < nitems; it += F.NGW) tr_item(W, K, N, WT, ld, koff, rowmode, scr, it, lane, gain);
}
__device__ __forceinline__ int t5_bucket(int rel) {
    const int n = rel < 0 ? -rel : rel; int b = rel > 0 ? 16 : 0;
    if (n < 8) return b + n;
    int lg = 2 + (31 - __builtin_clz((unsigned)(n * n)));
    if (lg > 15) lg = 15;
    return b + lg;
}
__device__ __forceinline__ void prologue(Frame& F, const __attribute__((address_space(4))) Args* ap) {
    bf16* W = (bf16*)(ap->ws + WS_W);
    for (int l = 0; l < NLAYER; ++l) {
        bf16* Wl = W + (size_t)l * E_LAYER;
        bf16* const T1 = (bf16*)(ap->ws + WS_PROJ) + (size_t)(2 * l) * E_WGU; bf16* const T2 = T1 + E_WGU;
        tr_matrix(F, ap->in[I_F1G] + (size_t)l * DM * DFF, DM, DFF, T1, DM, 0, 1, ap->in[I_F1N] + l * DM);
        tr_matrix(F, ap->in[I_F1U] + (size_t)l * DM * DFF, DM, DFF, T1, DM, 0, 2, ap->in[I_F1N] + l * DM);
        tr_matrix(F, ap->in[I_F1D] + (size_t)l * DFF * DM, DFF, DM, Wl + EO_WD1, DFF, 0, 0);
        tr_matrix(F, ap->in[I_WIN] + (size_t)l * DM * PW, DM, PW, Wl + EO_WIN, DM, 0, 0, ap->in[I_MN] + l * DM);
        tr_matrix(F, ap->in[I_WA] + (size_t)l * 1024 * DM, 1024, DM, Wl + EO_WBR, DM, 0, 0);
        tr_matrix(F, ap->in[I_WB] + (size_t)l * 512 * DM, 512, DM, Wl + EO_WBR, DM, 1024, 0);
        tr_matrix(F, ap->in[I_WC] + (size_t)l * 512 * DM, 512, DM, Wl + EO_WBR, DM, 1536, 0);
        tr_matrix(F, ap->in[I_WO] + (size_t)l * DM * DM, DM, DM, Wl + EO_WOUT, DM, 0, 0);
        tr_matrix(F, ap->in[I_F2G] + (size_t)l * DM * DFF, DM, DFF, T2, DM, 0, 1, ap->in[I_F2N] + l * DM);
        tr_matrix(F, ap->in[I_F2U] + (size_t)l * DM * DFF, DM, DFF, T2, DM, 0, 2, ap->in[I_F2N] + l * DM);
        tr_matrix(F, ap->in[I_F2D] + (size_t)l * DFF * DM, DFF, DM, Wl + EO_WD2, DFF, 0, 0);
    }
    float* tab = (float*)(ap->ws + WS_TAB);
    const int gt = blockIdx.x * 512 + F.wave * 64 + lane_id(), NT = F.G * 512;
    for (int i = gt; i < 8 * 260; i += NT) { const int h = i / 260, j = i % 260; tab[TAB_T5 + i] = j <= 256 ? ap->in[I_T5][t5_bucket(j - 128) * 8 + h] * LOG2E : -1e30f; }
    for (int i = gt; i < 2 * 512; i += NT) {
        const int dir = i / 512, c = i % 512; const float* lg = ap->in[I_LBL] + (size_t)dir * NLAYER * 512 + c;
        float mx = lg[0]; for (int l = 1; l < NLAYER; ++l) mx = fmaxf(mx, lg[l * 512]);
        float e[NLAYER], s = 0.f; for (int l = 0; l < NLAYER; ++l) { e[l] = expf(lg[l * 512] - mx); s += e[l]; }
        float cum = 0.f; for (int l = 0; l < NLAYER; ++l) { cum += e[l] / s; tab[TAB_LB + (dir * NLAYER + l) * 512 + c] = cum - e[0] / s; }
    }
}
__device__ __forceinline__ void quant_rows(Frame& F, const bf16* src, unsigned char* dst, float* scl, int nrows) {
    const int lane = lane_id();
    for (int r0 = F.gw; r0 < nrows; r0 += 4 * F.NGW) {
        pg8::u32x4 v[4][4];
#pragma unroll
        for (int u = 0; u < 4; ++u) { const int r = r0 + u * F.NGW;
            if (r < nrows) { const GAS pg8::u32x4* p = (const GAS pg8::u32x4*)(src + (size_t)r * 2048) + lane * 4;
#pragma unroll
                for (int j = 0; j < 4; ++j) v[u][j] = p[j]; } }
        asm volatile("" ::: "memory");
#pragma unroll
        for (int u = 0; u < 4; ++u) { const int r = r0 + u * F.NGW;
            if (r < nrows) {
                float mx = 0.f;
#pragma unroll
                for (int j = 0; j < 4; ++j)
#pragma unroll
                    for (int e = 0; e < 4; ++e) mx = fmaxf(mx, fmaxf(fabsf(bflo(v[u][j][e])), fabsf(bfhi(v[u][j][e]))));
#pragma unroll
                for (int o = 32; o > 0; o >>= 1) mx = fmaxf(mx, __shfl_xor(mx, o));
                const float sc = mx > 0.f ? mx * (1.0f / 127.0f) : 1.0f, inv = 1.0f / sc;
                pg8::u32x4 w[2];
#pragma unroll
                for (int j = 0; j < 4; ++j)
#pragma unroll
                    for (int h = 0; h < 2; ++h) {
                        const unsigned a = v[u][j][2 * h], b = v[u][j][2 * h + 1];
                        const int q0 = (int)rintf(bflo(a) * inv), q1 = (int)rintf(bfhi(a) * inv), q2 = (int)rintf(bflo(b) * inv), q3 = (int)rintf(bfhi(b) * inv);
                        w[j >> 1][(j & 1) * 2 + h] = (unsigned)(q0 & 255) | ((unsigned)(q1 & 255) << 8) | ((unsigned)(q2 & 255) << 16) | ((unsigned)(q3 & 255) << 24);
                    }
                GAS pg8::u32x4* d = (GAS pg8::u32x4*)(dst + (size_t)r * 2048) + lane * 2;
                d[0] = w[0]; d[1] = w[1];
                if (lane == 0) scl[r] = sc;
            } }
    }
}
__device__ __forceinline__ void quant_gate_weights(Frame& F, const __attribute__((address_space(4))) Args* ap) {
    for (int l = 0; l < NLAYER; ++l) {
        unsigned char* wq = ap->ws + WS_WQ + (size_t)l * WQ_LAYER;
        quant_rows(F, (const bf16*)(ap->ws + WS_W) + (size_t)l * E_LAYER + EO_WIN + (size_t)O_GA * DM, wq, (float*)(wq + WQ_SCALE), 3 * DM);
        for (int j = 0; j < 2; ++j) { unsigned char* d = (unsigned char*)((bf16*)(ap->ws + WS_W) + (size_t)l * E_LAYER + (j ? EO_WGU2 : EO_WGU1));
            quant_rows(F, (const bf16*)(ap->ws + WS_PROJ) + (size_t)(2 * l + j) * E_WGU, d, (float*)(d + WGUQ_SCALE), 2 * DFF); }
    }
}
template <bool OUT_F32> __device__ __forceinline__ void norm_rows(Frame& F, const float* x, const float* gain, void* out, int M) {
    const int lane = lane_id();
    const GAS f32x4* gr = (const GAS f32x4*)gain + lane;
    for (int m = F.gw; m < M; m += F.NGW) {
        const GAS f32x4* xr = (const GAS f32x4*)(x + (size_t)m * DM) + lane;
        f32x4 v[8]; float s = 0.f;
#pragma unroll
        for (int j = 0; j < 8; ++j) { v[j] = xr[64 * j]; s += (v[j].x * v[j].x + v[j].y * v[j].y) + (v[j].z * v[j].z + v[j].w * v[j].w); }
        const float rstd = 1.0f / sqrtf(wave_sum(s) * (1.0f / DM) + EPS);
#pragma unroll
        for (int j = 0; j < 8; ++j) { const f32x4 g = gr[64 * j]; const f32x4 o = v[j] * rstd * g;
            if (OUT_F32) ((GAS f32x4*)((float*)out + (size_t)m * DM) + lane)[64 * j] = o;
            else { v2u w; w.x = pk2(o.x, o.y); w.y = pk2(o.z, o.w); ((GAS v2u*)((bf16*)out + (size_t)m * DM) + lane)[64 * j] = w; } }
    }
}

__device__ __forceinline__ void cast_rows(Frame& F, const float* x, bf16* xb, float* ssq, int M) {
    const int lane = lane_id();
    for (int m = F.gw; m < M; m += F.NGW) {
        const GAS f32x4* xr = (const GAS f32x4*)(x + (size_t)m * DM) + lane; float s = 0.f;
#pragma unroll
        for (int j = 0; j < 8; ++j) { const f32x4 v = xr[64 * j]; s += (v.x * v.x + v.y * v.y) + (v.z * v.z + v.w * v.w);
            v2u w; w.x = pk2(v.x, v.y); w.y = pk2(v.z, v.w); ((GAS v2u*)(xb + (size_t)m * DM) + lane)[64 * j] = w; }
        s = wave_sum(s);
        if (lane < 32) ssq[(size_t)m * 32 + lane] = lane == 0 ? s : 0.f;
    }
}
__device__ __forceinline__ void final_rows(Frame& F, const bf16* xb, const float* gain, float* out, int M) {
    const int lane = lane_id();
    const GAS f32x4* gr = (const GAS f32x4*)gain;
    for (int m = F.gw; m < M; m += F.NGW) {
        const GAS v4u* xr = (const GAS v4u*)(xb + (size_t)m * DM) + lane;
        float v[4][8]; float s = 0.f;
#pragma unroll
        for (int j = 0; j < 4; ++j) { v8(xr[64 * j], v[j]);
#pragma unroll
            for (int k = 0; k < 8; ++k) s += v[j][k] * v[j][k]; }
        const float rstd = 1.0f / sqrtf(wave_sum(s) * (1.0f / DM) + EPS);
#pragma unroll
        for (int j = 0; j < 4; ++j) { const f32x4 g0 = gr[2 * (64 * j + lane)], g1 = gr[2 * (64 * j + lane) + 1];
            GAS f32x4* o = (GAS f32x4*)(out + (size_t)m * DM) + 2 * (64 * j + lane);
            o[0] = (f32x4){v[j][0] * rstd * g0[0], v[j][1] * rstd * g0[1], v[j][2] * rstd * g0[2], v[j][3] * rstd * g0[3]};
            o[1] = (f32x4){v[j][4] * rstd * g1[0], v[j][5] * rstd * g1[1], v[j][6] * rstd * g1[2], v[j][7] * rstd * g1[3]}; }
    }
}
__device__ __forceinline__ void mixA_naive(Frame& F, const bf16* P, bf16* Y, const float* tab, const float* sink, int Ts) {
    LAS float* ql = (LAS float*)(F.lds + RING_OFF + 65536 + F.wave * 2048);
    LAS float* pl = ql + 128;
    const int lane = lane_id();
    for (int it = F.gw; it < MS * 8; it += F.NGW) {
        const int row = it >> 3, h = it & 7, kvh = h >> 2, t = row & (Ts - 1), rb = row - t;
        { const unsigned w = *(const GAS unsigned*)(P + (size_t)row * PW + O_AQ + h * 128 + 2 * lane); ql[2 * lane] = bflo(w); ql[2 * lane + 1] = bfhi(w); }
        LDS_WAIT(); asm volatile("" ::: "memory");
        float sc[5]; float mx = sink[h] * LOG2E;
#pragma unroll
        for (int p = 0; p < 5; ++p) {
            const int j = lane + 64 * p, kpos = t + j - 128; float s = -1e30f;
            if (j <= 256 && kpos >= 0 && kpos < Ts) {
                const GAS v4u* kr = (const GAS v4u*)(P + (size_t)(rb + kpos) * PW + O_AK + kvh * 128); float a = 0.f;
#pragma unroll 4
                for (int d8 = 0; d8 < 16; ++d8) { const v4u w = kr[d8]; const LAS float* q = ql + d8 * 8;
                    a += q[0] * bflo(w.x) + q[1] * bfhi(w.x) + q[2] * bflo(w.y) + q[3] * bfhi(w.y) + q[4] * bflo(w.z) + q[5] * bfhi(w.z) + q[6] * bflo(w.w) + q[7] * bfhi(w.w); }
                s = a + tab[TAB_T5 + h * 260 + j];
            }
            sc[p] = s; mx = fmaxf(mx, s);
        }
        mx = wave_max(mx);
        float sum = 0.f;
#pragma unroll
        for (int p = 0; p < 5; ++p) { const float e = fexp2(sc[p] - mx); pl[lane + 64 * p] = e; sum += e; }
        sum = wave_sum(sum) + fexp2(sink[h] * LOG2E - mx);
        LDS_WAIT(); asm volatile("" ::: "memory");
        float o0 = 0.f, o1 = 0.f;
        const int jlo = t >= 128 ? 0 : 128 - t, jhi = (t + 128 < Ts) ? 256 : (Ts - 1 - t + 128);
        for (int j = jlo; j <= jhi; ++j) { const float pj = pl[j]; const unsigned w = *(const GAS unsigned*)(P + (size_t)(rb + t + j - 128) * PW + O_AV + kvh * 128 + 2 * lane); o0 += pj * bflo(w); o1 += pj * bfhi(w); }
        const float inv = 1.0f / sum;
        *(GAS unsigned*)(Y + (size_t)row * DM + h * 128 + 2 * lane) = pk2(o0 * inv, o1 * inv);
        LDS_WAIT(); asm volatile("" ::: "memory");
    }
}
__device__ __forceinline__ void mixB_naive(Frame& F, const bf16* P, bf16* Y, const float* nab, int Ts) {
    LAS float* ql = (LAS float*)(F.lds + RING_OFF + 65536 + F.wave * 2048);
    LAS float* pl = ql + 128;
    const int lane = lane_id(), rows = Ts >> 6;
    for (int it = F.gw; it < MS * 4; it += F.NGW) {
        const int row = it >> 2, h = it & 3, t = row & (Ts - 1), rb = row - t, r = t >> 6, c = t & 63;
        int rs = r - 4; rs = rs < 0 ? 0 : (rs > rows - 8 ? rows - 8 : rs);
        int cs = c - 8; cs = cs < 0 ? 0 : (cs > 48 ? 48 : cs);
        { const unsigned w = *(const GAS unsigned*)(P + (size_t)row * PW + O_BQ + h * 128 + 2 * lane); ql[2 * lane] = bflo(w); ql[2 * lane + 1] = bfhi(w); }
        LDS_WAIT(); asm volatile("" ::: "memory");
        float sc[2]; float mx = -1e30f;
#pragma unroll
        for (int p = 0; p < 2; ++p) {
            const int i = lane + 64 * p, kr_ = rs + (i >> 4), kc = cs + (i & 15);
            const GAS v4u* kr = (const GAS v4u*)(P + (size_t)(rb + kr_ * 64 + kc) * PW + O_BK + h * 128); float a = 0.f;
#pragma unroll 4
            for (int d8 = 0; d8 < 16; ++d8) { const v4u w = kr[d8]; const LAS float* q = ql + d8 * 8;
                a += q[0] * bflo(w.x) + q[1] * bfhi(w.x) + q[2] * bflo(w.y) + q[3] * bfhi(w.y) + q[4] * bflo(w.z) + q[5] * bfhi(w.z) + q[6] * bflo(w.w) + q[7] * bfhi(w.w); }
            int dc = kc - c; dc = dc < -15 ? -15 : (dc > 15 ? 15 : dc);
            sc[p] = a + nab[(h * 15 + (kr_ - r + 7)) * 31 + dc + 15] * LOG2E; mx = fmaxf(mx, sc[p]);
        }
        mx = wave_max(mx);
        float sum = 0.f;
#pragma unroll
        for (int p = 0; p < 2; ++p) { const float e = fexp2(sc[p] - mx); pl[lane + 64 * p] = e; sum += e; }
        sum = wave_sum(sum);
        LDS_WAIT(); asm volatile("" ::: "memory");
        float o0 = 0.f, o1 = 0.f;
        for (int i = 0; i < 128; ++i) { const float pj = pl[i]; const unsigned w = *(const GAS unsigned*)(P + (size_t)(rb + (rs + (i >> 4)) * 64 + cs + (i & 15)) * PW + O_BV + h * 128 + 2 * lane); o0 += pj * bflo(w); o1 += pj * bfhi(w); }
        const float inv = 1.0f / sum;
        *(GAS unsigned*)(Y + (size_t)row * DM + 1024 + h * 128 + 2 * lane) = pk2(o0 * inv, o1 * inv);
        LDS_WAIT(); asm volatile("" ::: "memory");
    }
}
typedef float f32x16 __attribute__((ext_vector_type(16)));
typedef short s16x4 __attribute__((ext_vector_type(4)));
#define KSWZ(row, colB) ((row) * 256 + ((colB) ^ (((row) & 7) << 4)))
__device__ __forceinline__ int crow(int r, int hi) { return (r & 3) + 8 * (r >> 2) + 4 * hi; }
__device__ __forceinline__ int v_st(int k, int c) { const int kk = (k & ~0xC) | ((k & 4) << 1) | ((k & 8) >> 1); return ((kk >> 3) * 4 + (c >> 5)) * 512 + ((kk & 7) * 32 + (c & 31)) * 2; }
__device__ __forceinline__ int v_rd_base(int lane) { return ((lane & 3) << 3) | (((lane >> 2) & 3) << 6) | (((lane >> 4) & 1) << 5) | (((lane >> 5) & 1) << 8); }
constexpr int v_rd_off(int d0, int ks, int half) { return d0 * 512 + ks * 4096 + half * 2048; }
template <int OFF> __device__ __forceinline__ s16x4 tr_read(int vb) { s16x4 r; asm volatile("ds_read_b64_tr_b16 %0, %1 offset:%2" : "=&v"(r) : "v"(vb), "i"(OFF) : "memory"); return r; }
template <int D0> __device__ __forceinline__ void pv_one(f32x16& od, int vb, bf16x8 pa0, bf16x8 pa1, bf16x8 pa2, bf16x8 pa3) {
    const s16x4 l0 = tr_read<v_rd_off(D0, 0, 0)>(vb), h0 = tr_read<v_rd_off(D0, 0, 1)>(vb), l1 = tr_read<v_rd_off(D0, 1, 0)>(vb), h1 = tr_read<v_rd_off(D0, 1, 1)>(vb);
    const s16x4 l2 = tr_read<v_rd_off(D0, 2, 0)>(vb), h2 = tr_read<v_rd_off(D0, 2, 1)>(vb), l3 = tr_read<v_rd_off(D0, 3, 0)>(vb), h3 = tr_read<v_rd_off(D0, 3, 1)>(vb);
    asm volatile("s_waitcnt lgkmcnt(0)" ::: "memory"); __builtin_amdgcn_sched_barrier(0);
#define PKV(L, H) (bf16x8){L[0], L[1], L[2], L[3], H[0], H[1], H[2], H[3]}
    od = __builtin_amdgcn_mfma_f32_32x32x16_bf16(pa0, PKV(l0, h0), od, 0, 0, 0);
    od = __builtin_amdgcn_mfma_f32_32x32x16_bf16(pa1, PKV(l1, h1), od, 0, 0, 0);
    od = __builtin_amdgcn_mfma_f32_32x32x16_bf16(pa2, PKV(l2, h2), od, 0, 0, 0);
    od = __builtin_amdgcn_mfma_f32_32x32x16_bf16(pa3, PKV(l3, h3), od, 0, 0, 0);
#undef PKV
}
constexpr int AT_K = 0, AT_V = 32768, AT_TAB = 65536, AT_WS = 65536 + 8192, AT_KV = 16384;
__device__ __forceinline__ void attn_tile_update(f32x16& p0, f32x16& p1, f32x16 (&o)[4], float& m_reg, float& l_reg, int vb, LAS float* al_l, int r32, int hi) {
    float pmax = p0[0];
#pragma unroll
    for (int r = 1; r < 16; ++r) pmax = fmaxf(pmax, p0[r]);
#pragma unroll
    for (int r = 0; r < 16; ++r) pmax = fmaxf(pmax, p1[r]);
    pmax = fmaxf(pmax, __shfl_xor(pmax, 32));
    const float mn = pmax > m_reg + 8.0f ? pmax : m_reg, alpha = fexp2(m_reg - mn);
    m_reg = mn;
    if (__any(alpha < 1.f)) {
        if (hi == 0) al_l[r32] = alpha;
        asm volatile("s_waitcnt lgkmcnt(0)" ::: "memory");
#pragma unroll
        for (int r = 0; r < 16; ++r) { const float a = al_l[crow(r, hi)];
#pragma unroll
            for (int d = 0; d < 4; ++d) o[d][r] *= a; }
        asm volatile("s_waitcnt lgkmcnt(0)" ::: "memory");
    }
    float ps = 0.f;
#pragma unroll
    for (int r = 0; r < 16; ++r) { p0[r] = fexp2(p0[r] - mn); p1[r] = fexp2(p1[r] - mn); ps += p0[r] + p1[r]; }
    ps += __shfl_xor(ps, 32);
    l_reg = l_reg * alpha + ps;
    bf16x8 pa0, pa1, pa2, pa3;
#define PK4(P, BASE, OUT) do { const unsigned a0 = pg8::cvt_pk_bf16(P[BASE + 0], P[BASE + 1]), a1 = pg8::cvt_pk_bf16(P[BASE + 2], P[BASE + 3]);   \
    const unsigned b0 = pg8::cvt_pk_bf16(P[BASE + 4], P[BASE + 5]), b1 = pg8::cvt_pk_bf16(P[BASE + 6], P[BASE + 7]);                              \
    auto r0 = __builtin_amdgcn_permlane32_swap(a0, b0, false, false); auto r1 = __builtin_amdgcn_permlane32_swap(a1, b1, false, false); \
    v4u wv = {r0[0], r1[0], r0[1], r1[1]}; OUT = __builtin_bit_cast(bf16x8, wv); } while (0)
    PK4(p0, 0, pa0); PK4(p0, 8, pa1); PK4(p1, 0, pa2); PK4(p1, 8, pa3);
#undef PK4
    pv_one<0>(o[0], vb, pa0, pa1, pa2, pa3); pv_one<1>(o[1], vb, pa0, pa1, pa2, pa3); pv_one<2>(o[2], vb, pa0, pa1, pa2, pa3); pv_one<3>(o[3], vb, pa0, pa1, pa2, pa3);
}
__device__ __forceinline__ void attn_qkt(f32x16& p0, f32x16& p1, const LAS unsigned char* Ks, const bf16x8 (&qr)[8], int r32, int hi) {
    p0 = (f32x16){}; p1 = (f32x16){};
#pragma unroll
    for (int d0 = 0; d0 < 8; ++d0) { const int cb = (d0 * 16 + hi * 8) * 2;
        const bf16x8 b0 = *(const LAS bf16x8*)(Ks + KSWZ(r32, cb)), b1 = *(const LAS bf16x8*)(Ks + KSWZ(32 + r32, cb));
        p0 = __builtin_amdgcn_mfma_f32_32x32x16_bf16(b0, qr[d0], p0, 0, 0, 0);
        p1 = __builtin_amdgcn_mfma_f32_32x32x16_bf16(b1, qr[d0], p1, 0, 0, 0); }
}
struct KVStage { v4u k0, k1, v0, v1; };
__device__ __forceinline__ void kv_load(KVStage& st, const bf16* Kp, const bf16* Vp, int row0, int sr, int sc) {
    st.k0 = *(const GAS v4u*)(Kp + (size_t)(row0 + sr) * PW + sc); st.k1 = *(const GAS v4u*)(Kp + (size_t)(row0 + 32 + sr) * PW + sc);
    st.v0 = *(const GAS v4u*)(Vp + (size_t)(row0 + sr) * PW + sc); st.v1 = *(const GAS v4u*)(Vp + (size_t)(row0 + 32 + sr) * PW + sc);
}
__device__ __forceinline__ void kv_write(const KVStage& st, LAS unsigned char* Kb, LAS unsigned char* Vb, int sr, int sc) {
    *(LAS v4u*)(Kb + KSWZ(sr, sc * 2)) = st.k0; *(LAS v4u*)(Kb + KSWZ(32 + sr, sc * 2)) = st.k1;
    *(LAS v4u*)(Vb + v_st(sr, sc)) = st.v0; *(LAS v4u*)(Vb + v_st(32 + sr, sc)) = st.v1;
}
__device__ __forceinline__ void attn_store(const f32x16 (&o)[4], float l_reg, LAS float* li_l, bf16* Yrow0  , int r32, int hi) {
    if (hi == 0) li_l[r32] = l_reg;
    asm volatile("s_waitcnt lgkmcnt(0)" ::: "memory");
#pragma unroll
    for (int r = 0; r < 16; ++r) { const int orow = crow(r, hi); const float rl = frcp(li_l[orow]);
#pragma unroll
        for (int d0 = 0; d0 < 4; ++d0) ((GAS bf16*)Yrow0)[(unsigned)(orow * DM + d0 * 32 + r32)] = (bf16)f2bf(o[d0][r] * rl); }
    asm volatile("s_waitcnt lgkmcnt(0)" ::: "memory");
}
__device__ __forceinline__ void mixA_mfma(Frame& F, const bf16* P, bf16* Y, const float* tab, const float* sink, int Ts) {
    const int lane = lane_id(), w = F.wave, tid = w * 64 + lane, r32 = lane & 31, hi = lane >> 5, sr = tid >> 4, sc = (tid & 15) * 8;
    LAS unsigned char* const L = F.lds + RING_OFF;
    LAS float* const TB = (LAS float*)(L + AT_TAB);
    LAS float* const wsf = (LAS float*)(L + AT_WS) + w * 64;
    const int nqb = Ts >> 7, nitems = (MS >> 7) * 4;
    for (int item = blockIdx.x; item < nitems; item += F.G) {
        const int hp = item & 1, kvh = (item >> 1) & 1, qblk = item >> 2, n = qblk & (nqb - 1), rb = (qblk - n) << 7;
        const int h = kvh * 4 + hp * 2 + (w >> 2), q0 = 128 * n + 32 * (w & 3);
        __syncthreads();
        for (int e = tid; e < 2 * 448; e += 512) { const int hl = e / 448, idx = e % 448 - 96; TB[e] = (idx >= 0 && idx <= 256) ? tab[TAB_T5 + (kvh * 4 + hp * 2 + hl) * 260 + idx] : -1e30f; }
        bf16x8 qr[8];
        { const bf16* qp = P + (size_t)(rb + q0 + r32) * PW + O_AQ + h * 128 + hi * 8;
#pragma unroll
          for (int d0 = 0; d0 < 8; ++d0) qr[d0] = *(const GAS bf16x8*)(qp + d0 * 16); }
        f32x16 o[4] = {}; float m_reg = sink[h] * LOG2E, l_reg = 1.0f;
        const int kt0 = n == 0 ? 0 : 2 * n - 2, kt1 = (n == nqb - 1) ? 2 * n + 2 : 2 * n + 4;
        const bf16* Kp = P + (size_t)rb * PW + O_AK + kvh * 128; const bf16* Vp = P + (size_t)rb * PW + O_AV + kvh * 128;
        KVStage st0, st1; kv_load(st0, Kp, Vp, 64 * kt0, sr, sc);
        if (kt0 + 1 < kt1) kv_load(st1, Kp, Vp, 64 * (kt0 + 1), sr, sc);
        kv_write(st0, L + AT_K, L + AT_V, sr, sc);
        __syncthreads();
        const LAS float* tbh = TB + (w >> 2) * 448;
#define MIXA_STEP(kt, STN, STW) do { const int b = ((kt) - kt0) & 1; \
            if ((kt) + 2 < kt1) kv_load(STN, Kp, Vp, 64 * ((kt) + 2), sr, sc); \
            const int k0 = 64 * (kt); \
            if (k0 + 63 >= q0 - 128 && k0 <= q0 + 31 + 128) { \
                f32x16 p0, p1; attn_qkt(p0, p1, L + AT_K + b * AT_KV, qr, r32, hi); \
                const LAS float* tl = tbh + (k0 - q0 - r32 + 4 * hi + 224); \
                _Pragma("unroll") for (int r = 0; r < 16; ++r) { p0[r] += tl[(r & 3) + 8 * (r >> 2)]; p1[r] += tl[32 + (r & 3) + 8 * (r >> 2)]; } \
                attn_tile_update(p0, p1, o, m_reg, l_reg, (int)(uintptr_t)(L + AT_V + b * AT_KV) + v_rd_base(lane), wsf, r32, hi); } \
            if ((kt) + 1 < kt1) kv_write(STW, L + AT_K + (b ^ 1) * AT_KV, L + AT_V + (b ^ 1) * AT_KV, sr, sc); \
            __syncthreads(); } while (0)
        for (int kt = kt0; kt < kt1; kt += 2) {
            MIXA_STEP(kt, st0, st1);
            MIXA_STEP(kt + 1, st1, st0);
        }
#undef MIXA_STEP
        { bf16* Yq = Y; asm volatile("" : "+s"(Yq)); attn_store(o, l_reg, wsf, Yq + (size_t)(rb + q0) * DM + h * 128, r32, hi); }
    }
    __syncthreads();
}
__device__ __forceinline__ void mixB_mfma(Frame& F, const bf16* P, bf16* Y, const float* nab, int Ts) {
    const int lane = lane_id(), w = F.wave, tid = w * 64 + lane, r32 = lane & 31, hi = lane >> 5, sr = tid >> 4, sc = (tid & 15) * 8;
    LAS unsigned char* const L = F.lds + RING_OFF;
    LAS float* const TB = (LAS float*)(L + AT_TAB);
    LAS float* const wsf = (LAS float*)(L + AT_WS) + w * 64;
    const int rows = Ts >> 6, ngrp = rows >> 2, nitems = (MS >> 8) * 4;
    for (int item = blockIdx.x; item < nitems; item += F.G) {
        const int h = item & 3, g = item >> 2, gi = g & (ngrp - 1), rb = (g - gi) << 8, r0 = 4 * gi, r = r0 + (w >> 1), c = 32 * (w & 1) + r32;
        __syncthreads();
        for (int e = tid; e < 15 * 128; e += 512) { const int dr = e >> 7, dci = (e & 127) - 48; TB[e] = (dci >= 0 && dci <= 30) ? nab[(h * 15 + dr) * 31 + dci] * LOG2E : -1e30f; }
        bf16x8 qr[8];
        { const bf16* qp = P + (size_t)(rb + r * 64 + c) * PW + O_BQ + h * 128 + hi * 8;
#pragma unroll
          for (int d0 = 0; d0 < 8; ++d0) qr[d0] = *(const GAS bf16x8*)(qp + d0 * 16); }
        f32x16 o[4] = {}; float m_reg = -1e30f, l_reg = 0.0f;
        int rs = r - 4; rs = rs < 0 ? 0 : (rs > rows - 8 ? rows - 8 : rs);
        int t0 = r0 - 4; t0 = t0 < 0 ? 0 : (t0 > rows - 8 ? rows - 8 : t0);
        int t1 = r0 + 3 - 4; t1 = (t1 < 0 ? 0 : (t1 > rows - 8 ? rows - 8 : t1)) + 8;
        int cs = c - 8; cs = cs < 0 ? 0 : (cs > 48 ? 48 : cs);
        const unsigned long long vm = (0xFFFFull << cs) >> (4 * hi);
        const unsigned mlo = (unsigned)vm, mhi = (unsigned)(vm >> 32);
        const bf16* Kp = P + (size_t)rb * PW + O_BK + h * 128; const bf16* Vp = P + (size_t)rb * PW + O_BV + h * 128;
        KVStage st0, st1; kv_load(st0, Kp, Vp, 64 * t0, sr, sc);
        if (t0 + 1 < t1) kv_load(st1, Kp, Vp, 64 * (t0 + 1), sr, sc);
        kv_write(st0, L + AT_K, L + AT_V, sr, sc);
        __syncthreads();
#define MIXB_STEP(kr, STN, STW) do { const int b = ((kr) - t0) & 1; \
            if ((kr) + 2 < t1) kv_load(STN, Kp, Vp, 64 * ((kr) + 2), sr, sc); \
            if ((kr) >= rs && (kr) < rs + 8) { \
                f32x16 p0, p1; attn_qkt(p0, p1, L + AT_K + b * AT_KV, qr, r32, hi); \
                const LAS float* tl = TB + ((kr) - r + 7) * 128 + (4 * hi - c + 63); \
                _Pragma("unroll") for (int q = 0; q < 16; ++q) { const int kc = (q & 3) + 8 * (q >> 2); \
                    p0[q] = ((mlo >> kc) & 1u) ? p0[q] + tl[kc] : -1e30f; p1[q] = ((mhi >> kc) & 1u) ? p1[q] + tl[32 + kc] : -1e30f; } \
                attn_tile_update(p0, p1, o, m_reg, l_reg, (int)(uintptr_t)(L + AT_V + b * AT_KV) + v_rd_base(lane), wsf, r32, hi); } \
            if ((kr) + 1 < t1) kv_write(STW, L + AT_K + (b ^ 1) * AT_KV, L + AT_V + (b ^ 1) * AT_KV, sr, sc); \
            __syncthreads(); } while (0)
        for (int kr = t0; kr < t1; kr += 2) {
            MIXB_STEP(kr, st0, st1);
            if (kr + 1 < t1) MIXB_STEP(kr + 1, st1, st0);
        }
#undef MIXB_STEP
        { bf16* Yq = Y; asm volatile("" : "+s"(Yq)); attn_store(o, l_reg, wsf, Yq + (size_t)(rb + r * 64 + 32 * (w & 1)) * DM + 1024 + h * 128, r32, hi); }
    }
    __syncthreads();
}

typedef float f32x4v __attribute__((ext_vector_type(4)));
constexpr int HG_VS = 288;
constexpr int HG_KL = 272;
constexpr int ST_ITEM = 2 * 128 * 128;
template <int SH> __device__ __forceinline__ float dpp_shr(float v) { return __builtin_bit_cast(float, __builtin_amdgcn_update_dpp(0, __builtin_bit_cast(int, v), 0x110 + SH, 0xf, 0xf, true)); }
template <int SH> __device__ __forceinline__ float dpp_shl(float v) { return __builtin_bit_cast(float, __builtin_amdgcn_update_dpp(0, __builtin_bit_cast(int, v), 0x100 + SH, 0xf, 0xf, true)); }
__device__ __forceinline__ float row_scan(float v, int dir) {
    if (dir == 0) { v += dpp_shr<1>(v); v += dpp_shr<2>(v); v += dpp_shr<4>(v); v += dpp_shr<8>(v); }
    else          { v += dpp_shl<1>(v); v += dpp_shl<2>(v); v += dpp_shl<4>(v); v += dpp_shl<8>(v); }
    return v;
}
__device__ __forceinline__ void ld32bf(const bf16* p, float (&o)[32]) {
#pragma unroll
    for (int m = 0; m < 4; ++m) { const v4u w = *(const GAS v4u*)(p + 8 * m);
        o[8 * m + 0] = bflo(w.x); o[8 * m + 1] = bfhi(w.x); o[8 * m + 2] = bflo(w.y); o[8 * m + 3] = bfhi(w.y); o[8 * m + 4] = bflo(w.z); o[8 * m + 5] = bfhi(w.z); o[8 * m + 6] = bflo(w.w); o[8 * m + 7] = bfhi(w.w); }
}
#define HG_PREP(VS_OFF, TOT_OFF) \
    const int lane = lane_id(), tl = lane & 15, kq = lane >> 4, w = F.wave, dir = w >> 2, i = w & 3, tid = w * 64 + lane; \
    LAS unsigned char* const vs = F.lds + RING_OFF + (VS_OFF); LAS float* const TOT = (LAS float*)(F.lds + RING_OFF + (TOT_OFF));
constexpr int HG_TS = 144;
__device__ __forceinline__ void hg_h1(Frame& F, const bf16* P, bf16* ST, float* DEC) {
    const int lane = lane_id(), tl = lane & 15, kq = lane >> 4, w = F.wave, dir = w >> 2, i = w & 3, tid = w * 64 + lane;
    LAS unsigned char* const KT = F.lds + RING_OFF;
    LAS unsigned char* const VT = F.lds + RING_OFF + 36864;
    LAS float* const TOT = (LAS float*)(F.lds + RING_OFF + 55296);
    for (int item = blockIdx.x; item < MS / 64 * 4; item += F.G) {
        const int chunk = item >> 2, h = item & 3, r0 = chunk * 64;
        __syncthreads();
#pragma unroll
        for (int k2 = 0; k2 < 2; ++k2) { const int idx = tid + 512 * k2, row = idx >> 4, c16 = idx & 15;
            const v4u vv = *(const GAS v4u*)(P + (size_t)(r0 + row) * PW + O_CI + h * 128 + 8 * c16);
            LAS unsigned char* vp = VT + (8 * c16) * HG_TS + 2 * row;
            *(LAS unsigned short*)(vp) = (unsigned short)vv.x; *(LAS unsigned short*)(vp + HG_TS) = (unsigned short)(vv.x >> 16);
            *(LAS unsigned short*)(vp + 2 * HG_TS) = (unsigned short)vv.y; *(LAS unsigned short*)(vp + 3 * HG_TS) = (unsigned short)(vv.y >> 16);
            *(LAS unsigned short*)(vp + 4 * HG_TS) = (unsigned short)vv.z; *(LAS unsigned short*)(vp + 5 * HG_TS) = (unsigned short)(vv.z >> 16);
            *(LAS unsigned short*)(vp + 6 * HG_TS) = (unsigned short)vv.w; *(LAS unsigned short*)(vp + 7 * HG_TS) = (unsigned short)(vv.w >> 16); }
        float g[32];
        ld32bf(P + (size_t)(r0 + 16 * i + tl) * PW + O_CFF + dir * 512 + h * 128 + 32 * kq, g);
        float kl[32];
#pragma unroll
        for (int s = 0; s < 32; ++s) { const float c = row_scan(g[s], dir), rc = row_scan(g[s], 1 - dir) - g[s];
            if (tl == (dir == 0 ? 15 : 0)) TOT[(dir * 4 + i) * 128 + 32 * kq + s] = c;
            kl[s] = (1.0f - fexp2(g[s])) * fexp2(rc); if ((s & 3) == 3) asm volatile("" ::: "memory"); }
        __syncthreads();
#pragma unroll
        for (int s4 = 0; s4 < 8; ++s4) {
            f32x4v tv[4];
#pragma unroll
            for (int m = 0; m < 4; ++m) tv[m] = *(const LAS f32x4v*)(TOT + (dir * 4 + m) * 128 + 32 * kq + 4 * s4);
            f32x4v a = (f32x4v){0.f, 0.f, 0.f, 0.f};
#pragma unroll
            for (int m = 0; m < 4; ++m) if (dir == 0 ? m > i : m < i) a += tv[m];
            LAS unsigned char* kp = KT + (dir * 128 + 32 * kq + 4 * s4) * HG_TS + 2 * (16 * i + tl);
#pragma unroll
            for (int k = 0; k < 4; ++k) *(LAS unsigned short*)(kp + k * HG_TS) = (unsigned short)f2bf(kl[4 * s4 + k] * fexp2(a[k]));
            if (i == 0 && tl == 0) { const f32x4v all = (tv[0] + tv[1]) + (tv[2] + tv[3]);
                *(GAS f32x4v*)(DEC + ((size_t)item * 2 + dir) * 128 + 32 * kq + 4 * s4) = (f32x4v){fexp2(all[0]), fexp2(all[1]), fexp2(all[2]), fexp2(all[3])}; }
            asm volatile("" ::: "memory");
        }
        __syncthreads();
        f32x4v acc[2][8];
#pragma unroll
        for (int a = 0; a < 2; ++a)
#pragma unroll
            for (int T = 0; T < 8; ++T) acc[a][T] = (f32x4v){0.f, 0.f, 0.f, 0.f};
#pragma unroll
        for (int m = 0; m < 2; ++m) {
            const bf16x8 a0 = *(const LAS bf16x8*)(KT + (dir * 128 + 32 * i + tl) * HG_TS + 64 * m + 16 * kq), a1 = *(const LAS bf16x8*)(KT + (dir * 128 + 32 * i + 16 + tl) * HG_TS + 64 * m + 16 * kq);
#pragma unroll
            for (int T = 0; T < 8; ++T) { const bf16x8 bv = *(const LAS bf16x8*)(VT + (16 * T + tl) * HG_TS + 64 * m + 16 * kq);
                acc[0][T] = __builtin_amdgcn_mfma_f32_16x16x32_bf16(a0, bv, acc[0][T], 0, 0, 0); acc[1][T] = __builtin_amdgcn_mfma_f32_16x16x32_bf16(a1, bv, acc[1][T], 0, 0, 0); }
        }
        bf16* sp = ST + (size_t)item * ST_ITEM + (size_t)dir * 16384;
#pragma unroll
        for (int a = 0; a < 2; ++a)
#pragma unroll
            for (int T = 0; T < 8; ++T) { v2u wv; wv.x = pk2(acc[a][T][0], acc[a][T][1]); wv.y = pk2(acc[a][T][2], acc[a][T][3]);
                *(GAS v2u*)(sp + (size_t)(16 * T + tl) * 128 + 32 * i + 16 * a + 4 * kq) = wv; }
    }
    __syncthreads();
}
__device__ __forceinline__ void hg_scan(Frame& F, bf16* ST, const float* DEC, int nseq, int nchunk) {
    const int gt = blockIdx.x * 512 + F.wave * 64 + lane_id(), NT = F.G * 512, total = nseq * 16384;
    for (int idx = gt; idx < total; idx += NT) {
        const int d8 = idx & 15, e = (idx >> 4) & 127, dir = (idx >> 11) & 1, h = (idx >> 12) & 3, sq = idx >> 14;
        float S[8];
#pragma unroll
        for (int k = 0; k < 8; ++k) S[k] = 0.f;
#pragma unroll 8
        for (int st = 0; st < nchunk; ++st) {
            const int c = dir == 0 ? st : nchunk - 1 - st; const size_t it2 = ((size_t)(sq * nchunk + c) * 4 + h) * 2 + dir;
            GAS v4u* p = (GAS v4u*)(ST + it2 * 16384 + (size_t)e * 128 + 8 * d8);
            const v4u dl = *p; const f32x4 dc0 = *(const GAS f32x4*)(DEC + it2 * 128 + 8 * d8), dc1 = *(const GAS f32x4*)(DEC + it2 * 128 + 8 * d8 + 4);
            v4u wv; wv.x = pk2(S[0], S[1]); wv.y = pk2(S[2], S[3]); wv.z = pk2(S[4], S[5]); wv.w = pk2(S[6], S[7]);
            *p = wv;
            float df[8]; v8(dl, df);
            S[0] = S[0] * dc0[0] + df[0]; S[1] = S[1] * dc0[1] + df[1]; S[2] = S[2] * dc0[2] + df[2]; S[3] = S[3] * dc0[3] + df[3];
            S[4] = S[4] * dc1[0] + df[4]; S[5] = S[5] * dc1[1] + df[5]; S[6] = S[6] * dc1[2] + df[6]; S[7] = S[7] * dc1[3] + df[7];
        }
    }
}
__device__ __forceinline__ void hg_h3(Frame& F, const bf16* P, const bf16* ST, bf16* Y, const float* gain) {
    HG_PREP(34816, 53248)
    LAS unsigned char* const KL = F.lds + RING_OFF;
    LAS float* const TR = (LAS float*)(F.lds + RING_OFF + 57344) + w * 320;
    LAS float* const OX = (LAS float*)(F.lds + RING_OFF);
    for (int item = blockIdx.x; item < MS / 64 * 4; item += F.G) {
        const int chunk = item >> 2, h = item & 3, r0 = chunk * 64, row = r0 + 16 * i + tl;
        const bf16* sp = ST + (size_t)item * ST_ITEM + (size_t)dir * 16384 + (size_t)(8 * tl) * 128 + 32 * kq;
        v4u sa[8], sb[8];
#define HG_LDS(buf, m_) do { _Pragma("unroll") for (int T_ = 0; T_ < 8; ++T_) buf[T_] = *(const GAS v4u*)(sp + T_ * 128 + 8 * (m_)); } while (0)
#define HG_MMS(buf, m_) do { v4u aw_; aw_.x = pg8::cvt_pk_bf16(qd[8 * (m_)], qd[8 * (m_) + 1]); aw_.y = pg8::cvt_pk_bf16(qd[8 * (m_) + 2], qd[8 * (m_) + 3]); \
        aw_.z = pg8::cvt_pk_bf16(qd[8 * (m_) + 4], qd[8 * (m_) + 5]); aw_.w = pg8::cvt_pk_bf16(qd[8 * (m_) + 6], qd[8 * (m_) + 7]); const bf16x8 af_ = __builtin_bit_cast(bf16x8, aw_); \
        _Pragma("unroll") for (int T_ = 0; T_ < 8; ++T_) o[T_] = __builtin_amdgcn_mfma_f32_16x16x32_bf16(af_, __builtin_bit_cast(bf16x8, buf[T_]), o[T_], 0, 0, 0); } while (0)
        HG_LDS(sa, 0); HG_LDS(sb, 1);
        __syncthreads();
#pragma unroll
        for (int k2 = 0; k2 < 2; ++k2) { const int idx = tid + 512 * k2, rw = idx >> 4, c16 = idx & 15;
            *(LAS v4u*)(vs + rw * HG_VS + c16 * 16) = *(const GAS v4u*)(P + (size_t)(r0 + rw) * PW + O_CI + h * 128 + 8 * c16); }
        float qd[32]; bf16x8 kdp[4];
        { float g[32];
          ld32bf(P + (size_t)row * PW + O_CFF + dir * 512 + h * 128 + 32 * kq, g);
          ld32bf(P + (size_t)row * PW + O_CQ + h * 128 + 32 * kq, qd);
#pragma unroll
          for (int m = 0; m < 4; ++m) { float kd8[8];
#pragma unroll
              for (int j = 0; j < 8; ++j) { const int s = 8 * m + j;
                  const float c = row_scan(g[s], dir), rc = row_scan(g[s], 1 - dir) - g[s];
                  if (tl == (dir == 0 ? 15 : 0)) TOT[(dir * 4 + i) * 128 + 32 * kq + s] = c;
                  const float k = 1.0f - fexp2(g[s]);
                  g[s] = k * fexp2(rc);
                  qd[s] *= fexp2(c); kd8[j] = k * fexp2(fminf(-c, 120.0f)); }
              v4u wv; wv.x = pg8::cvt_pk_bf16(g[8 * m], g[8 * m + 1]); wv.y = pg8::cvt_pk_bf16(g[8 * m + 2], g[8 * m + 3]); wv.z = pg8::cvt_pk_bf16(g[8 * m + 4], g[8 * m + 5]); wv.w = pg8::cvt_pk_bf16(g[8 * m + 6], g[8 * m + 7]);
              *(LAS v4u*)(KL + (dir * 64 + 16 * i + tl) * HG_KL + (32 * kq + 8 * m) * 2) = wv;
              v4u kv; kv.x = pg8::cvt_pk_bf16(kd8[0], kd8[1]); kv.y = pg8::cvt_pk_bf16(kd8[2], kd8[3]); kv.z = pg8::cvt_pk_bf16(kd8[4], kd8[5]); kv.w = pg8::cvt_pk_bf16(kd8[6], kd8[7]);
              kdp[m] = __builtin_bit_cast(bf16x8, kv);
              asm volatile("" ::: "memory"); } }
        __syncthreads();
        f32x4v o[8];
#pragma unroll
        for (int T = 0; T < 8; ++T) o[T] = (f32x4v){0.f, 0.f, 0.f, 0.f};
#define HG_PACK8(x, m_) __builtin_bit_cast(bf16x8, (v4u){pg8::cvt_pk_bf16(x[8 * (m_)], x[8 * (m_) + 1]), pg8::cvt_pk_bf16(x[8 * (m_) + 2], x[8 * (m_) + 3]), pg8::cvt_pk_bf16(x[8 * (m_) + 4], x[8 * (m_) + 5]), pg8::cvt_pk_bf16(x[8 * (m_) + 6], x[8 * (m_) + 7])})
        { f32x4v a4 = (f32x4v){0.f, 0.f, 0.f, 0.f};
#pragma unroll
          for (int m = 0; m < 4; ++m) a4 = __builtin_amdgcn_mfma_f32_16x16x32_bf16(HG_PACK8(qd, m), kdp[m], a4, 0, 0, 0);
#pragma unroll
          for (int r = 0; r < 4; ++r) { const int t = 4 * kq + r; const bool keep = dir == 0 ? (tl <= t) : (tl >= t); TR[t * 20 + tl] = keep ? a4[r] : 0.f; }
          LDS_WAIT(); asm volatile("" ::: "memory");
#pragma unroll
          for (int m = 0; m < 4; ++m) { const float a = TR[tl * 20 + 4 * m + kq]; float vf[8]; v8(*(const LAS v4u*)(vs + (16 * i + 4 * m + kq) * HG_VS + tl * 16), vf);
#pragma unroll
              for (int T = 0; T < 8; ++T) o[T] = __builtin_amdgcn_mfma_f32_16x16x4f32(a, vf[T], o[T], 0, 0, 0); }
          LDS_WAIT(); asm volatile("" ::: "memory"); }
        const int nblk = dir == 0 ? i : 3 - i;
        for (int jj = 1; jj <= nblk; ++jj) {
            const int j = dir == 0 ? i - jj : i + jj;
            if (jj >= 2) { const LAS float* tp = TOT + (dir * 4 + (dir == 0 ? j + 1 : j - 1)) * 128 + 32 * kq;
#pragma unroll
                for (int s4 = 0; s4 < 8; ++s4) { const f32x4v t4 = *(const LAS f32x4v*)(tp + 4 * s4); qd[4 * s4] *= fexp2(t4[0]); qd[4 * s4 + 1] *= fexp2(t4[1]); qd[4 * s4 + 2] *= fexp2(t4[2]); qd[4 * s4 + 3] *= fexp2(t4[3]); } }
            f32x4v a4 = (f32x4v){0.f, 0.f, 0.f, 0.f};
            { const LAS unsigned char* kp = KL + (dir * 64 + 16 * j + tl) * HG_KL + 64 * kq;
#pragma unroll
              for (int m = 0; m < 4; ++m) a4 = __builtin_amdgcn_mfma_f32_16x16x32_bf16(HG_PACK8(qd, m), *(const LAS bf16x8*)(kp + 16 * m), a4, 0, 0, 0); }
#pragma unroll
            for (int r = 0; r < 4; ++r) TR[(4 * kq + r) * 20 + tl] = a4[r];
            LDS_WAIT(); asm volatile("" ::: "memory");
#pragma unroll
            for (int m = 0; m < 4; ++m) { const float a = TR[tl * 20 + 4 * m + kq]; float vf[8]; v8(*(const LAS v4u*)(vs + (16 * j + 4 * m + kq) * HG_VS + tl * 16), vf);
#pragma unroll
                for (int T = 0; T < 8; ++T) o[T] = __builtin_amdgcn_mfma_f32_16x16x4f32(a, vf[T], o[T], 0, 0, 0); }
            LDS_WAIT(); asm volatile("" ::: "memory");
        }
        if (nblk >= 1) { const LAS float* tp = TOT + (dir * 4 + (dir == 0 ? 0 : 3)) * 128 + 32 * kq;
#pragma unroll
            for (int s4 = 0; s4 < 8; ++s4) { const f32x4v t4 = *(const LAS f32x4v*)(tp + 4 * s4); qd[4 * s4] *= fexp2(t4[0]); qd[4 * s4 + 1] *= fexp2(t4[1]); qd[4 * s4 + 2] *= fexp2(t4[2]); qd[4 * s4 + 3] *= fexp2(t4[3]); } }
        HG_MMS(sa, 0); HG_LDS(sa, 2); HG_MMS(sb, 1); HG_LDS(sb, 3); HG_MMS(sa, 2); HG_MMS(sb, 3);
#undef HG_LDS
#undef HG_MMS
#undef HG_PACK8
        __syncthreads();
        if (dir == 1) {
#pragma unroll
            for (int r = 0; r < 4; ++r) { LAS float* q = OX + (i * 16 + 4 * kq + r) * 128 + 8 * tl;
                *(LAS f32x4v*)q = (f32x4v){o[0][r], o[1][r], o[2][r], o[3][r]}; *(LAS f32x4v*)(q + 4) = (f32x4v){o[4][r], o[5][r], o[6][r], o[7][r]}; } }
        __syncthreads();
        if (dir == 0) {
            const f32x4v g0 = *(const GAS f32x4v*)(gain + h * 128 + 8 * tl), g1 = *(const GAS f32x4v*)(gain + h * 128 + 8 * tl + 4);
#pragma unroll
            for (int r = 0; r < 4; ++r) { const LAS float* q = OX + (i * 16 + 4 * kq + r) * 128 + 8 * tl;
                const f32x4v x0 = *(const LAS f32x4v*)q, x1 = *(const LAS f32x4v*)(q + 4);
                float v[8] = {o[0][r] + x0[0], o[1][r] + x0[1], o[2][r] + x0[2], o[3][r] + x0[3], o[4][r] + x1[0], o[5][r] + x1[1], o[6][r] + x1[2], o[7][r] + x1[3]};
                float ss = 0.f;
#pragma unroll
                for (int T = 0; T < 8; ++T) ss += v[T] * v[T];
                ss += __shfl_xor(ss, 1); ss += __shfl_xor(ss, 2); ss += __shfl_xor(ss, 4); ss += __shfl_xor(ss, 8);
                const float rstd = 1.0f / sqrtf(ss * (1.0f / 128.0f) + EPS);
                const size_t orow = (size_t)(r0 + 16 * i + 4 * kq + r);
                float sg[8]; v8(*(const GAS v4u*)(P + orow * PW + O_CG + h * 128 + 8 * tl), sg);
                v4u wv; wv.x = pk2(v[0] * rstd * g0[0] * sg[0], v[1] * rstd * g0[1] * sg[1]); wv.y = pk2(v[2] * rstd * g0[2] * sg[2], v[3] * rstd * g0[3] * sg[3]);
                wv.z = pk2(v[4] * rstd * g1[0] * sg[4], v[5] * rstd * g1[1] * sg[5]); wv.w = pk2(v[6] * rstd * g1[2] * sg[6], v[7] * rstd * g1[3] * sg[7]);
                *(GAS v4u*)(Y + orow * DM + 1536 + h * 128 + 8 * tl) = wv; }
        }
    }
    __syncthreads();
}

constexpr int RS_OFF = MISC_OFF + 128;
static_assert(RS_OFF + 13 * 256 * 4 <= LDS_BYTES, "rstd table");
template <class Sched> __device__ __forceinline__ void rstd_prepass(Frame& F, const Sched& S, const float* ssq, int ubase = 0, const float* rowscale = nullptr) {
    const int lane = lane_id(), tid = F.wave * 64 + lane, row = tid >> 1, half = tid & 1;
    LAS float* RS = (LAS float*)(F.lds + RS_OFF) + ubase * 256;
    pg8::Unit u;
    for (int i = 0; S.next(i, u); ++i) {
        const float* p = ssq + (size_t)(u.pm * 256 + row) * 32 + 16 * half;
        const f32x4 a = *(const GAS f32x4*)p, b = *(const GAS f32x4*)(p + 4), c = *(const GAS f32x4*)(p + 8), d = *(const GAS f32x4*)(p + 12);
        float s = (((a[0] + a[1]) + (a[2] + a[3])) + ((b[0] + b[1]) + (b[2] + b[3]))) + (((c[0] + c[1]) + (c[2] + c[3])) + ((d[0] + d[1]) + (d[2] + d[3])));
        s += __shfl_xor(s, 1);
        if (half == 0) RS[i * 256 + row] = (1.0f / sqrtf(s * (1.0f / 2048.0f) + EPS)) * (rowscale ? rowscale[u.pm * 256 + row] : 1.0f);
    }
    __syncthreads();
}
constexpr int NPH = 12;
typedef const __attribute__((address_space(4))) Args* ArgP;
__device__ __forceinline__ ArgP argp() { ArgP p = (ArgP)__builtin_amdgcn_kernarg_segment_ptr(); asm volatile("" : "+s"(p)); return p; }
#define PH_BEGIN const ArgP A = argp(); const int lq = opq_s(l), sq = opq_s(s); unsigned char* const ws = A->ws; \
    const bf16* const Wl = (const bf16*)(ws + WS_W) + (size_t)lq * E_LAYER; float* const xs = A->out + (size_t)sq * MS * DM; \
    bf16* const XN = (bf16*)(ws + WS_XN); bf16* const PROJ = (bf16*)(ws + WS_PROJ); bf16* const ACT = (bf16*)(ws + WS_PROJ); bf16* const Y = (bf16*)(ws + WS_Y); \
    float* const OC = (float*)(ws + WS_OC); const float* const tab = (const float*)(ws + WS_TAB); const int Ts = sq == 0 ? 8192 : 2048; \
    bf16* const MG = (bf16*)(ws + WS_MG); float* const SSQ = (float*)(ws + WS_SSQ); \
    (void)Wl; (void)xs; (void)XN; (void)PROJ; (void)ACT; (void)Y; (void)OC; (void)tab; (void)Ts; (void)MG; (void)SSQ;
__global__ void __launch_bounds__(512, 2) fwd(Args args_unused) {
    extern __shared__ __attribute__((aligned(16))) unsigned char lds[];
    Frame F;
    F.lds = (LAS unsigned char*)lds;
    F.wave = __builtin_amdgcn_readfirstlane(threadIdx.x >> 6);
    F.G = gridDim.x; F.gw = blockIdx.x * 8 + F.wave; F.NGW = F.G * 8;
    volatile LAS unsigned* MISC = (volatile LAS unsigned*)(F.lds + MISC_OFF);
    for (int u = F.wave * 64 + lane_id(); u < (LDS_BYTES - LDSCTL_OFF) / 4; u += 512) ((LAS unsigned*)(F.lds + LDSCTL_OFF))[u] = 0u;
    __syncthreads();
    const ArgP A0 = argp();
    const int use_bar = A0->use_bar;
    XcdBarrier bar; bar.bar = (unsigned*)(A0->ws + WS_CTL) + CW_BAR; bar.x = 0; bar.st = nullptr;
    if (use_bar) bar = xcd_barrier_post((unsigned*)(A0->ws + WS_CTL) + CW_BAR, MISC + 8, F.wave == 0 && lane_id() == 0);
#define GRID_BAR() do { if (opq_s(use_bar)) xcd_barrier(bar, F.wave == 0 && lane_id() == 0); } while (0)
    LAS unsigned char* ring = F.lds + RING_OFF;

    if (A0->do_pro) { prologue(F, A0); GRID_BAR(); quant_gate_weights(F, A0); GRID_BAR(); }

    const int plo = A0->ph_lo, phi = A0->ph_hi, l_lo = A0->l_lo, l_hi = A0->l_hi, s_hi = A0->s_hi;
#define IN(k) (opq_s(plo) <= (k) && (k) < opq_s(phi))
    for (int s = A0->s_lo; s < s_hi; ++s) {
        for (int l = l_lo; l < l_hi; ++l) {
            if (IN(0)) { PH_BEGIN if (lq == 0) { const float* xin = sq == 0 ? A->in[I_XP] : A->in[I_XS] + (size_t)(sq - 1) * MS * DM; cast_rows(F, xin, XN, SSQ, MS); GRID_BAR(); } }
            if (IN(1)) { PH_BEGIN
                if (lq == 0) { quant_rows(F, XN, ws + WS_OC, (float*)(ws + WS_OC + XQ_SCALE), MS); GRID_BAR(); }
                const unsigned char* wq = (const unsigned char*)(Wl + EO_WGU1);
                pg8::Gemm g{(const pg8::bf16_t*)(ws + WS_OC), (const pg8::bf16_t*)wq, MS, 2 * DFF, DM / 2, DM / 2, DM / 2}; pg8::StaticOrder S; S.init(MS, 2 * DFF, F.G, (int)blockIdx.x);
                rstd_prepass(F, S, SSQ, 0, (const float*)(ws + WS_OC + XQ_SCALE)); pg8::EpiSwiGLUQ E{ACT, DFF, (const float*)(wq + WGUQ_SCALE), (const LAS float*)(F.lds + RS_OFF)};
                pg8::gemm_phase<pg8::EpiSwiGLUQ, pg8::StaticOrder, true, true, false, true>(ring, g, S, E, F.wave); GRID_BAR(); }
            if (IN(2)) { PH_BEGIN pg8::Gemm g{ACT, Wl + EO_WD1, MS, DM, DFF, DFF, DFF}; pg8::StaticOrder S; S.init(MS, DM, F.G, (int)blockIdx.x);
                if (F.wave == 0 && lane_id() == 0) MISC[11] += 1u; __syncthreads(); const unsigned ptgt = 8u * (unsigned)__builtin_amdgcn_readfirstlane((int)MISC[11]);
                pg8::EpiResid E{XN, DM, 0.5f, SSQ, (unsigned*)(ws + WS_CTL), ptgt, ws + WS_OC, (float*)(ws + WS_OC + XQ_SCALE), (LAS unsigned*)(F.lds + RS_OFF)}; pg8::gemm_phase<pg8::EpiResid, pg8::StaticOrder, true, true>(ring, g, S, E, F.wave); GRID_BAR(); }
            if (IN(3)) {
                for (int st = 0; st < 2; ++st) {
                    const int which = __builtin_amdgcn_readfirstlane((st + (int)(blockIdx.x & 1u)) & 1);
                    if (which == 0) { PH_BEGIN
                        pg8::Gemm g{XN, Wl + EO_WIN, MS, O_GA, DM, DM, DM}; pg8::StaticOrder S; S.init(MS, O_GA, F.G, (int)blockIdx.x);
                        rstd_prepass(F, S, SSQ); pg8::EpiProj E{PROJ, PW, tab + TAB_LB + (0 * NLAYER + lq) * 512, tab + TAB_LB + (1 * NLAYER + lq) * 512, (const LAS float*)(F.lds + RS_OFF)};
                        pg8::gemm_phase<pg8::EpiProj, pg8::StaticOrder, true, true>(ring, g, S, E, F.wave);
                    } else { PH_BEGIN
                        const unsigned char* wq = ws + WS_WQ + (size_t)lq * WQ_LAYER;
                        pg8::Gemm g{(const pg8::bf16_t*)(ws + WS_OC), (const pg8::bf16_t*)wq, MS, 3 * DM, DM / 2, DM / 2, DM / 2}; pg8::GateOrder S; S.init(MS, 3 * DM, F.G, (int)blockIdx.x);
                        rstd_prepass(F, S, SSQ, 6, (const float*)(ws + WS_OC + XQ_SCALE));
                        pg8::EpiGateQ E{(unsigned char*)(PROJ + O_GA), PW * 2, (const float*)(wq + WQ_SCALE), (const LAS float*)(F.lds + RS_OFF) + 6 * 256};
                        pg8::gemm_phase<pg8::EpiGateQ, pg8::GateOrder, true, true, false, true>(ring, g, S, E, F.wave);
                    }
                    __syncthreads();
                }
                GRID_BAR(); }
            if (IN(4)) { PH_BEGIN
                for (int st = 0; st < 3; ++st) {
                    const int which = __builtin_amdgcn_readfirstlane((st + (int)(blockIdx.x & 1u)) % 3);
                    if (which == 0) hg_h1(F, PROJ, (bf16*)OC, (float*)(ws + WS_MG));
                    else if (which == 1) mixA_mfma(F, PROJ, Y, tab, A->in[I_SINK] + lq * 8, Ts);
                    else mixB_mfma(F, PROJ, Y, A->in[I_NAB] + (size_t)lq * 4 * 15 * 31, Ts);
                }
                GRID_BAR(); }
            if (IN(5)) { PH_BEGIN hg_scan(F, (bf16*)OC, (const float*)(ws + WS_MG), MS / Ts, Ts / 64); GRID_BAR(); }
            if (IN(6)) { PH_BEGIN hg_h3(F, PROJ, (const bf16*)OC, Y, A->in[I_HN] + lq * 512); GRID_BAR(); }
            if (IN(7)) { PH_BEGIN pg8::SubOrder S; S.init(MS, DM, F.G, (int)blockIdx.x);
                pg8::Gemm g{Y, Wl + EO_WBR, MS, DM, DM, DM, DM}; pg8::EpiMerged E{PROJ, PW, MG, DM};
                pg8::gemm_phase<pg8::EpiMerged, pg8::SubOrder, true, true, true>(ring, g, S, E, F.wave); GRID_BAR(); }
            if (IN(8)) { PH_BEGIN pg8::Gemm g{MG, Wl + EO_WOUT, MS, DM, DM, DM, DM}; pg8::StaticOrder S; S.init(MS, DM, F.G, (int)blockIdx.x);
                if (F.wave == 0 && lane_id() == 0) MISC[11] += 1u; __syncthreads(); const unsigned ptgt = 8u * (unsigned)__builtin_amdgcn_readfirstlane((int)MISC[11]);
                pg8::EpiResid E{XN, DM, 1.0f, SSQ, (unsigned*)(ws + WS_CTL), ptgt, ws + WS_OC, (float*)(ws + WS_OC + XQ_SCALE), (LAS unsigned*)(F.lds + RS_OFF)}; pg8::gemm_phase<pg8::EpiResid, pg8::StaticOrder, true, true>(ring, g, S, E, F.wave); GRID_BAR(); }
            if (IN(9)) { PH_BEGIN
                const unsigned char* wq = (const unsigned char*)(Wl + EO_WGU2);
                pg8::Gemm g{(const pg8::bf16_t*)(ws + WS_OC), (const pg8::bf16_t*)wq, MS, 2 * DFF, DM / 2, DM / 2, DM / 2}; pg8::StaticOrder S; S.init(MS, 2 * DFF, F.G, (int)blockIdx.x);
                rstd_prepass(F, S, SSQ, 0, (const float*)(ws + WS_OC + XQ_SCALE)); pg8::EpiSwiGLUQ E{ACT, DFF, (const float*)(wq + WGUQ_SCALE), (const LAS float*)(F.lds + RS_OFF)};
                pg8::gemm_phase<pg8::EpiSwiGLUQ, pg8::StaticOrder, true, true, false, true>(ring, g, S, E, F.wave); GRID_BAR(); }
            if (IN(10)) { PH_BEGIN pg8::Gemm g{ACT, Wl + EO_WD2, MS, DM, DFF, DFF, DFF}; pg8::StaticOrder S; S.init(MS, DM, F.G, (int)blockIdx.x);
                if (F.wave == 0 && lane_id() == 0) MISC[11] += 1u; __syncthreads(); const unsigned ptgt = 8u * (unsigned)__builtin_amdgcn_readfirstlane((int)MISC[11]);
                pg8::EpiResid E{XN, DM, 0.5f, SSQ, (unsigned*)(ws + WS_CTL), ptgt, ws + WS_OC, (float*)(ws + WS_OC + XQ_SCALE), (LAS unsigned*)(F.lds + RS_OFF)}; pg8::gemm_phase<pg8::EpiResid, pg8::StaticOrder, true, true>(ring, g, S, E, F.wave); GRID_BAR(); }
            if (IN(11)) { PH_BEGIN if (lq == NLAYER - 1) { final_rows(F, XN, A->in[I_FN], xs, MS); GRID_BAR(); } }
        }
    }
#undef IN
}

extern "C" void kernel_launch(void* const* d_in, const int* in_sizes, int n_in, void* d_out, int out_size, void* d_ws, size_t ws_size, hipStream_t stream) {
    static int grid = 0;
    if (grid == 0) {
        if (n_in != 22 || out_size != MTOT * DM || ws_size < WS_END) { fprintf(stderr, "kernel_launch: unexpected shapes (n_in %d out %d ws %zu, need ws >= %zu)\n", n_in, out_size, ws_size, (size_t)WS_END); grid = -1; return; }
        int dev = 0, cus = 0, per_cu = 0;
        if (hipGetDevice(&dev) != hipSuccess || hipDeviceGetAttribute(&cus, hipDeviceAttributeMultiprocessorCount, dev) != hipSuccess) { grid = -1; return; }
        if (hipFuncSetAttribute((const void*)fwd, hipFuncAttributeMaxDynamicSharedMemorySize, LDS_BYTES) != hipSuccess) { fprintf(stderr, "kernel_launch: hipFuncSetAttribute failed\n"); grid = -1; return; }
        if (hipOccupancyMaxActiveBlocksPerMultiprocessor(&per_cu, (const void*)fwd, 512, LDS_BYTES) != hipSuccess || per_cu < 1) fprintf(stderr, "kernel_launch: occupancy query reports %d\n", per_cu);
        (void)hipGetLastError();
        grid = cus;
    }
    if (grid < 0) return;
    (void)hipMemsetAsync((char*)d_ws + WS_CTL, 0, CTL_ZERO_BYTES, stream);
    Args a{};
    for (int i = 0; i < 22; ++i) a.in[i] = (const float*)d_in[i];
    a.out = (float*)d_out; a.ws = (unsigned char*)d_ws;
#if MK_ONE_LAUNCH
    a.l_lo = 0; a.l_hi = NLAYER; a.s_lo = 0; a.s_hi = NSLICE; a.ph_lo = 0; a.ph_hi = NPH; a.do_pro = 1; a.do_fin = 1; a.use_bar = 1;
    hipLaunchKernelGGL(fwd, dim3(grid), dim3(512), LDS_BYTES, stream, a);
#else
    a.use_bar = 0;
    a.do_pro = 1; a.do_fin = 0; a.l_lo = a.l_hi = 0; a.s_lo = a.s_hi = 0; a.ph_lo = a.ph_hi = 0;
    hipLaunchKernelGGL(fwd, dim3(grid), dim3(512), LDS_BYTES, stream, a);
    a.do_pro = 0;
    for (int s = 0; s < NSLICE; ++s) for (int l = 0; l < NLAYER; ++l) for (int p = 0; p < NPH; ++p) {
        a.l_lo = l; a.l_hi = l + 1; a.s_lo = s; a.s_hi = s + 1; a.ph_lo = p; a.ph_hi = p + 1;
        hipLaunchKernelGGL(fwd, dim3(grid), dim3(512), LDS_BYTES, stream, a);
    }
    a.do_fin = 1; a.l_lo = a.l_hi = 0; a.s_lo = a.s_hi = 0; a.ph_lo = a.ph_hi = 0;
    hipLaunchKernelGGL(fwd, dim3(grid), dim3(512), LDS_BYTES, stream, a);
#endif
    const hipError_t le = hipPeekAtLastError();
    if (le != hipSuccess) fprintf(stderr, "kernel_launch: launch failed: %s\n", hipGetErrorName(le));
}
```
